# Optimizing an MI355X kernel written in HIP

```python
import math
import jax, jax.numpy as jnp
from jax import lax
import numpy as np

D_MODEL = 2048
BATCH = 1
SEQ = 8192
DEPTH = 2

N_MEM = 256
S5_WIDTH = 1024
S5_GROUP = 16
S5_GROUPS = S5_WIDTH // S5_GROUP
S5_STATE = 64
S5_DT_MIN = 1e-3
S5_DT_MAX = 1e-1
MLA_HEADS = 16
MLA_Q_RANK = 448
MLA_KV_RANK = 512
MLA_NOPE = 128
MLA_ROPE = 64
MLA_QK = MLA_NOPE + MLA_ROPE
MLA_V = 128
ROPE_THETA = 10000.0
Q_BLOCK = 128
MEM_HEADS = 4
MEM_HEAD_DIM = 256
MEM_WIDTH = MEM_HEADS * MEM_HEAD_DIM
N_BRANCH = 3
S5_END = S5_WIDTH
CQ_END = S5_END + MLA_Q_RANK
CKV_END = CQ_END + MLA_KV_RANK
KR_END = CKV_END + MLA_ROPE
MQ_END = KR_END + MEM_WIDTH
IN_COLS = MQ_END + N_BRANCH * D_MODEL
D_FF = 7168
N_EXPERTS = 8
TOP_K = 2
D_FF_EXPERT = 7168
N_DENSE = (DEPTH + 1) // 2
N_MOE = DEPTH // 2
EPS = 1e-6
NEG_INF = -1e30

kernel_name = 'hybrid_s5_mla_memory_moe_trunk'


def rms_norm(x, g):
    xf = x.astype(jnp.float32)
    y = xf * lax.rsqrt(jnp.mean(xf * xf, axis=-1, keepdims=True) + EPS)
    return (y * g.astype(jnp.float32)).astype(x.dtype)


def rope_tables(positions):
    inv_freq = ROPE_THETA ** (-jnp.arange(0, MLA_ROPE, 2, dtype=jnp.float32) / MLA_ROPE)
    ang = positions.astype(jnp.float32)[..., None] * inv_freq
    return jnp.cos(ang)[:, :, None, :], jnp.sin(ang)[:, :, None, :]


def rope_tail(x, cos, sin):
    x_n, x_r = jnp.split(x, [MLA_NOPE], axis=-1)
    xr = x_r.astype(jnp.float32)
    x1, x2 = jnp.split(xr, 2, axis=-1)
    rot = jnp.concatenate([x1 * cos - x2 * sin, x2 * cos + x1 * sin], axis=-1)
    return jnp.concatenate([x_n, rot.astype(x.dtype)], axis=-1)


def complex_linear_combine(e1, e2):
    a1r, a1i, b1r, b1i = e1
    a2r, a2i, b2r, b2i = e2
    return (a2r * a1r - a2i * a1i,
            a2r * a1i + a2i * a1r,
            a2r * b1r - a2i * b1i + b2r,
            a2r * b1i + a2i * b1r + b2i)


def s5_branch(u, a_re, a_im, log_dt, b_re, b_im, c_re, c_im, d, w_glu):
    bsz, L, _ = u.shape
    f32 = jnp.float32
    uf = u.astype(f32).reshape(bsz, L, S5_GROUPS, S5_GROUP)
    a_re = a_re.astype(f32)
    a_im = a_im.astype(f32)
    b_re = b_re.astype(f32)
    b_im = b_im.astype(f32)
    dt = jnp.exp(log_dt.astype(f32))[:, None]
    mag = jnp.exp(dt * a_re)
    lam_re = mag * jnp.cos(dt * a_im)
    lam_im = mag * jnp.sin(dt * a_im)
    den = a_re * a_re + a_im * a_im
    n_re = lam_re - 1.0
    n_im = lam_im
    f_re = ((n_re * a_re + n_im * a_im) / den)[..., None]
    f_im = ((n_im * a_re - n_re * a_im) / den)[..., None]
    bb_re = f_re * b_re - f_im * b_im
    bb_im = f_re * b_im + f_im * b_re
    bu_re = jnp.einsum('gph,blgh->blgp', bb_re, uf)
    bu_im = jnp.einsum('gph,blgh->blgp', bb_im, uf)
    lr = jnp.broadcast_to(lam_re, bu_re.shape)
    li = jnp.broadcast_to(lam_im, bu_re.shape)
    _, _, s_re, s_im = lax.associative_scan(complex_linear_combine, (lr, li, bu_re, bu_im), axis=1)
    y = (jnp.einsum('ghp,blgp->blgh', c_re.astype(f32), s_re)
         - jnp.einsum('ghp,blgp->blgh', c_im.astype(f32), s_im)
         + d.astype(f32) * uf)
    y = jax.nn.gelu(y.reshape(bsz, L, S5_WIDTH)).astype(u.dtype)
    ga, gb = jnp.split(y @ w_glu, 2, axis=-1)
    return ga * jax.nn.sigmoid(gb)


def causal_block_attention(q, k, v, positions):
    bsz, L, H, dq = q.shape
    nb = L // Q_BLOCK
    scale = dq ** -0.5
    qb = q.reshape(bsz, nb, Q_BLOCK, H, dq).transpose(1, 0, 2, 3, 4)
    pb = positions.reshape(bsz, nb, Q_BLOCK).transpose(1, 0, 2)

    def one_block(args):
        q_blk, p_blk = args
        s = jnp.einsum('bqhd,bkhd->bhqk', q_blk, k).astype(jnp.float32) * scale
        mask = positions[:, None, None, :] <= p_blk[:, None, :, None]
        s = jnp.where(mask, s, NEG_INF)
        p = jax.nn.softmax(s, axis=-1).astype(v.dtype)
        return jnp.einsum('bhqk,bkhd->bqhd', p, v)

    o = lax.map(one_block, (qb, pb))
    return o.transpose(1, 0, 2, 3, 4).reshape(bsz, L, H, v.shape[-1])


def mla_branch(c_q, c_kv, k_rope, positions, cos, sin, q_a_norm, w_q_b, kv_norm,
               w_kv_b, q_norm, k_norm, w_o):
    bsz, L, _ = c_q.shape
    q = (rms_norm(c_q, q_a_norm) @ w_q_b).reshape(bsz, L, MLA_HEADS, MLA_QK)
    kv = (rms_norm(c_kv, kv_norm) @ w_kv_b).reshape(bsz, L, MLA_HEADS, MLA_NOPE + MLA_V)
    k_nope, v = jnp.split(kv, [MLA_NOPE], axis=-1)
    k_r = jnp.broadcast_to(k_rope[:, :, None, :], (bsz, L, MLA_HEADS, MLA_ROPE))
    k = jnp.concatenate([k_nope, k_r], axis=-1)
    q = rope_tail(rms_norm(q, q_norm), cos, sin)
    k = rope_tail(rms_norm(k, k_norm), cos, sin)
    o = causal_block_attention(q, k, v, positions)
    return o.reshape(bsz, L, MLA_HEADS * MLA_V) @ w_o


def memory_branch(q_mem, mem, mem_norm_g, w_kv, q_norm, k_norm, w_o):
    bsz, L, _ = q_mem.shape
    m_len = mem.shape[1]
    m = rms_norm(mem, mem_norm_g)
    k, v = jnp.split(m @ w_kv, 2, axis=-1)
    k = rms_norm(k.reshape(bsz, m_len, MEM_HEADS, MEM_HEAD_DIM), k_norm)
    v = v.reshape(bsz, m_len, MEM_HEADS, MEM_HEAD_DIM)
    q = rms_norm(q_mem.reshape(bsz, L, MEM_HEADS, MEM_HEAD_DIM), q_norm)
    s = jnp.einsum('blhd,bmhd->bhlm', q, k).astype(jnp.float32) * (MEM_HEAD_DIM ** -0.5)
    p = jax.nn.softmax(s, axis=-1).astype(v.dtype)
    o = jnp.einsum('bhlm,bmhd->blhd', p, v).reshape(bsz, L, MEM_WIDTH)
    return o @ w_o


def swiglu(h, w_gate_up, w_down):
    g, u = jnp.split(h @ w_gate_up, 2, axis=-1)
    return (jax.nn.silu(g) * u) @ w_down


def moe_ffn(h, router, router_b, w_gate_up, w_down):
    bsz, L, D = h.shape
    t = h.reshape(bsz * L, D)
    logits = (t @ router).astype(jnp.float32) + router_b.astype(jnp.float32)
    top_v, top_i = lax.top_k(logits, TOP_K)
    top_w = jax.nn.softmax(top_v, axis=-1)
    out = jnp.zeros_like(t)
    for e in range(N_EXPERTS):
        w_e = jnp.sum(jnp.where(top_i == e, top_w, 0.0), axis=-1).astype(t.dtype)
        out = out + w_e[:, None] * swiglu(t, w_gate_up[e], w_down[e])
    return out.reshape(bsz, L, D)


def setup_inputs(seed: int = 0) -> dict:
    key = jax.random.key(seed)
    ks = iter(jax.random.split(key, 40))
    f32 = jnp.float32

    def nrm(shape, fan_in):
        return jax.random.normal(next(ks), shape, f32) * (fan_in ** -0.5)

    def gain(shape):
        return 1.0 + 0.02 * jax.random.normal(next(ks), shape, f32)

    x = jax.random.normal(next(ks), (BATCH, SEQ, D_MODEL), f32)
    mem = jax.random.normal(next(ks), (BATCH, N_MEM, D_MODEL), f32)
    offset = jax.random.randint(next(ks), (BATCH, 1), 0, 4096, jnp.int32)
    positions = offset + jnp.arange(SEQ, dtype=jnp.int32)[None, :]
    n_idx = jnp.arange(S5_STATE, dtype=f32)
    gp = (DEPTH, S5_GROUPS, S5_STATE)
    return {
        'x': x,
        'mem': mem,
        'positions': positions,
        'norm_mix': gain((DEPTH, D_MODEL)),
        'w_in': nrm((DEPTH, D_MODEL, IN_COLS), D_MODEL),
        's5_a_re': -0.5 + 0.01 * jax.random.normal(next(ks), gp, f32),
        's5_a_im': math.pi * n_idx + 0.01 * jax.random.normal(next(ks), gp, f32),
        's5_log_dt': jax.random.uniform(next(ks), (DEPTH, S5_GROUPS), f32,
                                        math.log(S5_DT_MIN), math.log(S5_DT_MAX)),
        's5_b_re': nrm((DEPTH, S5_GROUPS, S5_STATE, S5_GROUP), 2 * S5_GROUP),
        's5_b_im': nrm((DEPTH, S5_GROUPS, S5_STATE, S5_GROUP), 2 * S5_GROUP),
        's5_c_re': nrm((DEPTH, S5_GROUPS, S5_GROUP, S5_STATE), S5_STATE),
        's5_c_im': nrm((DEPTH, S5_GROUPS, S5_GROUP, S5_STATE), S5_STATE),
        's5_d': jax.random.normal(next(ks), (DEPTH, S5_GROUPS, S5_GROUP), f32),
        's5_w_glu': nrm((DEPTH, S5_WIDTH, 2 * D_MODEL), S5_WIDTH),
        'mla_q_a_norm': gain((DEPTH, MLA_Q_RANK)),
        'mla_w_q_b': nrm((DEPTH, MLA_Q_RANK, MLA_HEADS * MLA_QK), MLA_Q_RANK),
        'mla_kv_norm': gain((DEPTH, MLA_KV_RANK)),
        'mla_w_kv_b': nrm((DEPTH, MLA_KV_RANK, MLA_HEADS * (MLA_NOPE + MLA_V)), MLA_KV_RANK),
        'mla_q_norm': gain((DEPTH, MLA_QK)),
        'mla_k_norm': gain((DEPTH, MLA_QK)),
        'mla_w_o': nrm((DEPTH, MLA_HEADS * MLA_V, D_MODEL), MLA_HEADS * MLA_V),
        'mem_norm': gain((DEPTH, D_MODEL)),
        'mem_w_kv': nrm((DEPTH, D_MODEL, 2 * MEM_WIDTH), D_MODEL),
        'mem_q_norm': gain((DEPTH, MEM_HEAD_DIM)),
        'mem_k_norm': gain((DEPTH, MEM_HEAD_DIM)),
        'mem_w_o': nrm((DEPTH, MEM_WIDTH, D_MODEL), MEM_WIDTH),
        'w_out': nrm((DEPTH, D_MODEL, D_MODEL), D_MODEL),
        'norm_ffn': gain((DEPTH, D_MODEL)),
        'ffn_w_gate_up': nrm((N_DENSE, D_MODEL, 2 * D_FF), D_MODEL),
        'ffn_w_down': nrm((N_DENSE, D_FF, D_MODEL), D_FF),
        'moe_router': nrm((N_MOE, D_MODEL, N_EXPERTS), D_MODEL),
        'moe_router_b': 0.01 * jax.random.normal(next(ks), (N_MOE, N_EXPERTS), f32),
        'moe_w_gate_up': nrm((N_MOE, N_EXPERTS, D_MODEL, 2 * D_FF_EXPERT), D_MODEL),
        'moe_w_down': nrm((N_MOE, N_EXPERTS, D_FF_EXPERT, D_MODEL), D_FF_EXPERT),
    }


def reference(x, mem, positions, norm_mix, w_in, s5_a_re, s5_a_im, s5_log_dt, s5_b_re,
              s5_b_im, s5_c_re, s5_c_im, s5_d, s5_w_glu, mla_q_a_norm, mla_w_q_b,
              mla_kv_norm, mla_w_kv_b, mla_q_norm, mla_k_norm, mla_w_o, mem_norm,
              mem_w_kv, mem_q_norm, mem_k_norm, mem_w_o, w_out, norm_ffn,
              ffn_w_gate_up, ffn_w_down, moe_router, moe_router_b, moe_w_gate_up,
              moe_w_down):
    bsz, L, D = x.shape
    cos, sin = rope_tables(positions)
    for l in range(DEPTH):
        h = rms_norm(x, norm_mix[l])
        proj = h @ w_in[l]
        u, c_q, c_kv, k_rope, q_mem, gate_logits = jnp.split(
            proj, [S5_END, CQ_END, CKV_END, KR_END, MQ_END], axis=-1)
        y_s5 = s5_branch(u, s5_a_re[l], s5_a_im[l], s5_log_dt[l], s5_b_re[l], s5_b_im[l],
                         s5_c_re[l], s5_c_im[l], s5_d[l], s5_w_glu[l])
        y_mla = mla_branch(c_q, c_kv, k_rope, positions, cos, sin, mla_q_a_norm[l],
                           mla_w_q_b[l], mla_kv_norm[l], mla_w_kv_b[l], mla_q_norm[l],
                           mla_k_norm[l], mla_w_o[l])
        y_mem = memory_branch(q_mem, mem, mem_norm[l], mem_w_kv[l], mem_q_norm[l],
                              mem_k_norm[l], mem_w_o[l])
        g = jax.nn.sigmoid(gate_logits.astype(jnp.float32)).astype(x.dtype)
        g = g.reshape(bsz, L, N_BRANCH, D)
        merged = g[:, :, 0, :] * y_s5 + g[:, :, 1, :] * y_mla + g[:, :, 2, :] * y_mem
        x = x + merged @ w_out[l]
        h = rms_norm(x, norm_ffn[l])
        if l % 2 == 0:
            x = x + swiglu(h, ffn_w_gate_up[l // 2], ffn_w_down[l // 2])
        else:
            x = x + moe_ffn(h, moe_router[l // 2], moe_router_b[l // 2],
                            moe_w_gate_up[l // 2], moe_w_down[l // 2])
    return x
```

```cpp
#include <hip/hip_runtime.h>
#include <cstdio>
#include <cstdint>

#ifndef MK_PER_PHASE
#define MK_PER_PHASE 1
#endif
#ifndef MK_CHECK
#define MK_CHECK 0
#endif

constexpr int SEQ = 8192, DM = 2048, DEPTH = 2, NMEM = 256;
constexpr int S5W = 1024, S5G = 64, S5H = 16, S5P = 64;
constexpr int NH = 16, QRANK = 448, KVRANK = 512, DNOPE = 128, DROPE = 64, DQK = 192, DV = 128;
constexpr int MEMH = 4, MEMD = 256, MEMW = 1024;
constexpr int DFF = 7168, NE = 8;
constexpr int INP = 9472;
constexpr int IN_COLS = 9216;
constexpr float EPS = 1e-6f;
constexpr float LOG2E = 1.4426950408889634f;
constexpr int ACT_ROWS = 2 * SEQ + NE * 256;
constexpr int KSPLIT = 2;

typedef unsigned short bf16;
typedef short bf16x8 __attribute__((ext_vector_type(8)));
typedef short s16x4 __attribute__((ext_vector_type(4)));
typedef float f32x4 __attribute__((ext_vector_type(4)));
typedef float f32x2 __attribute__((ext_vector_type(2)));
typedef float f32x16 __attribute__((ext_vector_type(16)));
typedef unsigned u32x4 __attribute__((ext_vector_type(4)));
typedef unsigned u32x2 __attribute__((ext_vector_type(2)));
#define GAS __attribute__((address_space(1)))
#define LAS __attribute__((address_space(3)))
typedef GAS unsigned gu32;
#define RLX_AGENT __ATOMIC_RELAXED, __HIP_MEMORY_SCOPE_AGENT
#define LDS_WAIT() asm volatile("s_waitcnt lgkmcnt(0)" ::: "memory")
#define VM_WAIT() asm volatile("s_waitcnt vmcnt(0)" ::: "memory")
#define SBAR() __builtin_amdgcn_sched_barrier(0)

typedef __bf16 bf16x2_t __attribute__((ext_vector_type(2)));
__device__ __forceinline__ unsigned cvt_pk_bf16(float lo, float hi) { f32x2 v = {lo, hi}; bf16x2_t b = __builtin_convertvector(v, bf16x2_t); return __builtin_bit_cast(unsigned, b); }
__device__ __forceinline__ unsigned f2bf(float f) { unsigned u = __builtin_bit_cast(unsigned, f); return (u + 0x7fffu + ((u >> 16) & 1u)) >> 16; }
__device__ __forceinline__ unsigned pk2(float lo, float hi) { return f2bf(lo) | (f2bf(hi) << 16); }
__device__ __forceinline__ float bf2f(unsigned short b) { return __builtin_bit_cast(float, ((unsigned)b) << 16); }
__device__ __forceinline__ float bflo(unsigned w) { return __builtin_bit_cast(float, w << 16); }
__device__ __forceinline__ float bfhi(unsigned w) { return __builtin_bit_cast(float, w & 0xffff0000u); }
__device__ __forceinline__ float sigmoidf_(float x) { return __builtin_amdgcn_rcpf(1.f + __builtin_amdgcn_exp2f(-x * LOG2E)); }
__device__ __forceinline__ int fresh_tid() { int t = threadIdx.x; asm volatile("" : "+v"(t)); return t; }
template <int N> __device__ __forceinline__ float sum_slots(const float* p) { f32x4 a = *(const f32x4*)p;
#pragma unroll
    for (int i = 1; i < N / 4; ++i) a = a + *(const f32x4*)(p + 4 * i);
    return (a[0] + a[1]) + (a[2] + a[3]); }
__device__ __forceinline__ float wave_sum(float v) {
#pragma unroll
    for (int o = 1; o < 64; o <<= 1) v += __shfl_xor(v, o);
    return v;
}

constexpr size_t al256(size_t x) { return (x + 255) & ~(size_t)255; }
constexpr size_t CTL_BYTES = 2u << 20;
constexpr int CW_TMO = 0, CW_CODE = 1;
constexpr int CW_BAR = 4096;
constexpr int CW_CNT = 8192;
constexpr int CW_CHK = 12288;
constexpr int SS_X = 0;
constexpr int SS_CQ = 4 * SEQ * 32;
constexpr int SS_CKV = SS_CQ + 2 * SEQ * 8;
constexpr int SS_KR = SS_CKV + 2 * SEQ * 8;
constexpr int SS_FLOATS = SS_KR + 2 * SEQ * 4;

struct WsMap {
    size_t w_in[2], w_glu[2], w_qb[2], w_kvb[2], w_mo[2], w_mkv[2], w_mwo[2], w_out[2], w_gu, w_dn, w_egu, w_edn;
    size_t xb, u, cq, ckv, kr, qm, gt, q, kk, vv, oa, om, ys, es, mf, mb, act, ym, kmem, vmem, memb, ropec, ropes;
    size_t lam[2], bb[2], cp[2], list, toke, toks, tokw, tmm, ssp, end;
};
constexpr WsMap make_map() {
    WsMap m{}; size_t o = CTL_BYTES;
    auto take = [&](size_t bytes) { size_t r = o; o = al256(o + bytes); return r; };
    for (int l = 0; l < 2; ++l) {
        m.w_in[l] = take((size_t)INP * DM * 2); m.w_glu[l] = take((size_t)4096 * S5W * 2); m.w_qb[l] = take((size_t)4096 * 512 * 2); m.w_kvb[l] = take((size_t)4096 * 512 * 2);
        m.w_mo[l] = take((size_t)DM * DM * 2); m.w_mkv[l] = take((size_t)DM * DM * 2); m.w_mwo[l] = take((size_t)DM * MEMW * 2); m.w_out[l] = take((size_t)DM * DM * 2);
        m.lam[l] = take((size_t)S5G * S5P * 8); m.bb[l] = take((size_t)S5G * 128 * 16 * 2); m.cp[l] = take((size_t)S5G * 16 * 128 * 2);
    }
    m.w_gu = take((size_t)2 * DFF * DM * 2); m.w_dn = take((size_t)DM * DFF * 2);
    m.w_egu = take((size_t)NE * 2 * DFF * DM * 2); m.w_edn = take((size_t)NE * DM * DFF * 2);
    m.xb = take((size_t)SEQ * DM * 2); m.u = take((size_t)SEQ * S5W * 2); m.cq = take((size_t)SEQ * 512 * 2); m.ckv = take((size_t)SEQ * 512 * 2);
    m.kr = take((size_t)SEQ * 64 * 4); m.qm = take((size_t)SEQ * MEMW * 2); m.gt = take((size_t)SEQ * 3 * DM * 2);
    m.q = take((size_t)NH * SEQ * DQK * 2); m.kk = take((size_t)NH * SEQ * DQK * 2); m.vv = take((size_t)NH * SEQ * DV * 2);
    m.oa = take((size_t)SEQ * DM * 2); m.om = take((size_t)SEQ * MEMW * 2); m.ys = take((size_t)SEQ * S5W * 2); m.es = take((size_t)S5G * 128 * 128 * 4);
    m.mf = take((size_t)SEQ * DM * 4); m.mb = take((size_t)SEQ * DM * 2);
    m.act = take((size_t)ACT_ROWS * DFF * 2); m.ym = take((size_t)KSPLIT * ACT_ROWS * DM * 2);
    m.kmem = take((size_t)2 * MEMH * NMEM * MEMD * 2); m.vmem = take((size_t)2 * MEMH * NMEM * MEMD * 2); m.memb = take((size_t)NMEM * DM * 2);
    m.ropec = take((size_t)SEQ * 32 * 4); m.ropes = take((size_t)SEQ * 32 * 4);
    m.list = take((size_t)NE * SEQ * 4); m.toke = take((size_t)SEQ * 2 * 4); m.toks = take((size_t)SEQ * 2 * 4); m.tokw = take((size_t)SEQ * 2 * 4); m.tmm = take(2 * 128 * 4); m.ssp = take((size_t)SS_FLOATS * 4);
    m.end = o; return m;
}
constexpr WsMap WS = make_map();

constexpr int RING_BYTES = 131072;
constexpr int XT_OFF = RING_BYTES;
constexpr int RK_OFF = XT_OFF + 4096;
constexpr int MISC_OFF = RK_OFF + 1024;
constexpr int LDS_BYTES = 147456;
static_assert(MISC_OFF + 256 <= LDS_BYTES, "LDS map");

#define XB_TMO      128
#define XB_XCNT(j)  (256  + 64 * (j))
#define XB_XSUB(j)  (1280 + 64 * (j))
#define XB_XGEN(j)  (2304 + 64 * (j))
#define XB_TOP      3328
#define XB_TOPGEN   3392
#define XCD_BAR_WORDS 3456
#define XB_SPIN_CAP (1u << 18)
__device__ __forceinline__ unsigned xb_ld(unsigned* p)              { return __hip_atomic_load(p, __ATOMIC_RELAXED, __HIP_MEMORY_SCOPE_AGENT); }
__device__ __forceinline__ unsigned xb_add(unsigned* p, unsigned v) { return __hip_atomic_fetch_add(p, v, __ATOMIC_RELAXED, __HIP_MEMORY_SCOPE_AGENT); }
__device__ __forceinline__ unsigned xb_xcc_id() { return (unsigned)__builtin_amdgcn_s_getreg((3 << 11) | 20) & 0xFu; }
#define XB_SPIN(cond, bar) do { unsigned _sp = 0; while (cond) { __builtin_amdgcn_s_sleep(1); \
    if ((++_sp & 255u) == 0u) { if (xb_ld(&(bar)[XB_TMO])) break; if (_sp > XB_SPIN_CAP) { atomicAdd(&(bar)[XB_TMO], 1u); break; } } } } while (0)
struct XcdBarrier { unsigned* bar; unsigned x; volatile LAS unsigned* st; };
__device__ __forceinline__ XcdBarrier xcd_barrier_post(unsigned* bar, volatile LAS unsigned* st) {
    XcdBarrier b; b.bar = bar; b.x = xb_xcc_id(); b.st = st;
    if (threadIdx.x == 0) (void)xb_add(&bar[XB_XCNT(b.x)], 1u);
    return b;
}
__device__ __forceinline__ void xcd_barrier_complete(unsigned* bar, unsigned x, unsigned& nloc, unsigned& nx) {
    const unsigned G = gridDim.x * gridDim.y * gridDim.z;
    unsigned sum, cnt, mine, sp = 0u;
    for (;;) {
        sum = 0u; cnt = 0u; mine = 0u;
#pragma unroll
        for (unsigned j = 0; j < 16; ++j) { const unsigned c = xb_ld(&bar[XB_XCNT(j)]); sum += c; cnt += (c > 0u) ? 1u : 0u; mine = (j == x) ? c : mine; }
        if (sum == G) break;
        __builtin_amdgcn_s_sleep(1);
        if ((++sp & 255u) == 0u) { if (xb_ld(&bar[XB_TMO])) break; if (sp > XB_SPIN_CAP) { atomicAdd(&bar[XB_TMO], 1u); break; } }
    }
    nloc = mine > 0u ? mine : 1u; nx = cnt > 0u ? cnt : 1u;
}
__device__ __forceinline__ void xcd_barrier(const XcdBarrier& b) {
    asm volatile("s_waitcnt vmcnt(0)" ::: "memory");
    __syncthreads();
    if (threadIdx.x == 0) {
        unsigned* bar = b.bar;
        __builtin_amdgcn_s_waitcnt(0);
        unsigned nloc = b.st[0], nx = b.st[1];
        if (nloc == 0u) { xcd_barrier_complete(bar, b.x, nloc, nx); b.st[0] = nloc; b.st[1] = nx; }
        const unsigned old = xb_add(&bar[XB_XSUB(b.x)], 1u);
        const unsigned gen = old / nloc;
        if (old + 1u == (gen + 1u) * nloc) {
            __builtin_amdgcn_fence(__ATOMIC_RELEASE, "agent");
            asm volatile("s_waitcnt vmcnt(0)" ::: "memory");
            const unsigned og = xb_add(&bar[XB_TOP], 1u);
            const unsigned tg = og / nx;
            if (og + 1u == (tg + 1u) * nx) xb_add(&bar[XB_TOPGEN], 1u);
            else XB_SPIN(xb_ld(&bar[XB_TOPGEN]) == tg, bar);
            __builtin_amdgcn_fence(__ATOMIC_ACQUIRE, "agent");
            xb_add(&bar[XB_XGEN(b.x)], 1u);
            asm volatile("s_waitcnt vmcnt(0)" ::: "memory");
        } else {
            XB_SPIN(xb_ld(&bar[XB_XGEN(b.x)]) == gen, bar);
            __builtin_amdgcn_fence(__ATOMIC_ACQUIRE, "agent");
            asm volatile("s_waitcnt vmcnt(0)" ::: "memory");
        }
    }
    __syncthreads();
}
namespace pg8 {
constexpr int BM = 256, BK = 64, HALF = 128, HTB = HALF * BK * 2, STAGE_BYTES = 8 * HTB, NXCD = 8, WGM = 8;
__host__ __device__ __forceinline__ int lds_byte(int r, int c) { const int st = (r >> 4) * 2 + (c >> 5), rr = r & 15, cc = c & 31, ob = rr * 64 + cc * 2; return st * 1024 + (ob ^ (((ob >> 9) & 1) << 5)); }
__host__ __device__ __forceinline__ void stage_rc(int b, int& R, int& C) { const int st = b / 1024, sb = b % 1024, swz = sb ^ (((sb >> 9) & 1) << 5); R = (st >> 1) * 16 + swz / 64; C = (st & 1) * 32 + (swz % 64) / 2; }
__host__ __device__ __forceinline__ int perm32(int rho) { const int n = rho >> 4, i = rho & 15; return 8 * (i >> 2) + 4 * n + (i & 3); }

struct Unit { int pm, pn, e, ks, p0, cnt; };
struct Gemm { const bf16* A; const bf16* Bt; int lda, ldb, K; };

__device__ __forceinline__ bool static_unit(int L, int nM, int nN, Unit& u) {
    const int nwg = nM * nN; if (L >= nwg) return false;
    int wgid = L; { const int q = nwg / NXCD, r = nwg % NXCD, xcd = wgid % NXCD, off = wgid / NXCD; wgid = (xcd < r ? xcd * (q + 1) : r * (q + 1) + (xcd - r) * q) + off; }
    const int nig = WGM * nN, gid = wgid / nig, fm = gid * WGM, gsz = (nM - fm) < WGM ? (nM - fm) : WGM;
    u.pm = fm + ((wgid % nig) % gsz); u.pn = (wgid % nig) / gsz; return true;
}
struct StaticOrder {
    static constexpr bool GATHER = false;
    int nM, nN, G, c;
    __device__ void init(int nM_, int nN_, int G_, int c_) { nM = nM_; nN = nN_; G = G_; c = c_; }
    __device__ bool next(int i, Unit& u) const { u.e = 0; u.ks = 0; u.p0 = 0; u.cnt = 0; return static_unit(i * G + c, nM, nN, u); }
    __device__ __forceinline__ const char* abase(const Gemm& g, const Unit& u) const { return (const char*)g.A + (size_t)u.pm * BM * g.lda * 2; }
    __device__ __forceinline__ const char* bbase(const Gemm& g, const Unit& u) const { return (const char*)g.Bt + (size_t)u.pn * BM * g.ldb * 2; }
    __device__ __forceinline__ unsigned tok(const Unit&, int) const { return 0u; }
};
struct GluOrder : StaticOrder {
    __device__ bool next(int i, Unit& u) const { u.e = 0; u.ks = 0; u.p0 = 0; u.cnt = 0; if (!static_unit((i >> 1) * G + c, nM, nN, u)) return false; u.pn = 2 * u.pn + (i & 1); return true; }
};
struct MemKvOrder {
    static constexpr bool GATHER = false;
    int G, c;
    __device__ bool next(int i, Unit& u) const { const int L = i * G + c; if (L >= 16) return false; u.pm = 0; u.pn = L & 7; u.e = L >> 3; u.ks = 0; u.p0 = 0; u.cnt = 0; return true; }
    __device__ __forceinline__ const char* abase(const Gemm& g, const Unit&) const { return (const char*)g.A; }
    __device__ __forceinline__ const char* bbase(const Gemm& g, const Unit& u) const { return (const char*)g.Bt + ((size_t)u.e * (WS.w_mkv[1] - WS.w_mkv[0])) + (size_t)u.pn * BM * g.ldb * 2; }
    __device__ __forceinline__ unsigned tok(const Unit&, int) const { return 0u; }
};
template <bool GATHER_, int NKS> struct MoeOrder {
    static constexpr bool GATHER = GATHER_;
    const LAS int* tab; const int* list; int nN, G, c; size_t bstride;
    __device__ bool next(int i, Unit& u) const {
        const int P = tab[8]; int L = i * G + c; if (L >= P * nN * NKS) return false;
        u.ks = L % NKS; L /= NKS;
        static_unit(L, P, nN, u);
        int e = 0;
#pragma unroll
        for (int j = 1; j < 8; ++j) e += (u.pm >= tab[j]) ? 1 : 0;
        u.e = e; u.p0 = tab[e]; u.cnt = tab[16 + e]; return true;
    }
    __device__ __forceinline__ const char* abase(const Gemm& g, const Unit& u) const { return GATHER_ ? (const char*)g.A : (const char*)g.A + ((size_t)u.pm * BM * g.lda + (size_t)u.ks * g.K) * 2; }
    __device__ __forceinline__ const char* bbase(const Gemm& g, const Unit& u) const { return (const char*)g.Bt + (size_t)u.e * bstride + ((size_t)u.pn * BM * g.ldb + (size_t)u.ks * g.K) * 2; }
    __device__ __forceinline__ unsigned tok(const Unit& u, int r) const { const int slot = (u.pm - u.p0) * BM + r; return slot < u.cnt ? (unsigned)list[u.e * SEQ + slot] : 0u; }
};

typedef f32x4 Acc[2][2][4][2];

template <class Epi, class Sched>
__device__ __forceinline__ void gemm_phase(LAS unsigned char* lds, const Gemm g, const Sched& S, const Epi& E) {
    const int tid = fresh_tid(), wid = __builtin_amdgcn_readfirstlane(tid >> 6), lane = tid & 63, wr = wid >> 2, wc = wid & 3, fr = lane & 15, fq = lane >> 4;
    const int K = g.K, nt = K / BK;
    unsigned voffA[2], voffB[2]; int RA[2], CA[2];
#pragma unroll
    for (int i = 0; i < 2; ++i) { int R, C; stage_rc(tid * 16 + i * 8192, R, C); const int Rb = Epi::PERM ? ((R & ~31) + perm32(R & 31)) : R;
        RA[i] = R; CA[i] = C; voffA[i] = (unsigned)(R * g.lda + C) * 2u; voffB[i] = (unsigned)(Rb * g.ldb + C) * 2u; }
    const size_t kstep = (size_t)(BK * 2);
    const size_t hstepA = (size_t)HALF * g.lda * 2, hstepB = (size_t)HALF * g.ldb * 2;
    const unsigned ldsw = (unsigned)wid * 1024u;
    const int aoff = lds_byte(wr * 64 + fr, fq * 8), boff = lds_byte(wc * 32 + fr, fq * 8);
    const char* const gA = (const char*)g.A;
#define PG8_SA(b, h) (((b) * 2 + (h)) * HTB)
#define PG8_SB(b, h) ((4 + (b) * 2 + (h)) * HTB)
#define PG8_STAGE(bufoff, gbase, voff) do { _Pragma("unroll") for (int _i = 0; _i < 2; ++_i) \
        __builtin_amdgcn_global_load_lds((const unsigned*)((const char*)(gbase) + (voff)[_i]), (LAS unsigned*)(lds + (bufoff) + ldsw + _i * 8192), 16, 0, 0); } while (0)
#define PG8_STA1(bufoff, h) do { if constexpr (Sched::GATHER) PG8_STAGE(bufoff, gA + ka1, vc[h]); else PG8_STAGE(bufoff, a1 + (h) * hstepA, voffA); } while (0)
#define PG8_STA2(bufoff, h) do { if constexpr (Sched::GATHER) PG8_STAGE(bufoff, gA + ka2, w2[h]); else PG8_STAGE(bufoff, a2 + (h) * hstepA, voffA); } while (0)
#define PG8_STA3(bufoff, h) do { if constexpr (Sched::GATHER) PG8_STAGE(bufoff, gA + ka2 + kstep, w2[h]); else PG8_STAGE(bufoff, a3 + (h) * hstepA, voffA); } while (0)
#define PG8_LDA(dst, b, h) do { _Pragma("unroll") for (int m = 0; m < 4; ++m) _Pragma("unroll") for (int k = 0; k < 2; ++k) dst[m][k] = *(const LAS bf16x8*)(lds + PG8_SA(b, h) + aoff + m * 2048 + k * 1024); } while (0)
#define PG8_LDB(dst, b, h) do { _Pragma("unroll") for (int n = 0; n < 2; ++n) _Pragma("unroll") for (int k = 0; k < 2; ++k) dst[n][k] = *(const LAS bf16x8*)(lds + PG8_SB(b, h) + boff + n * 2048 + k * 1024); } while (0)
#define PG8_MMA(ai, bj, At, Bt) do { __builtin_amdgcn_s_setprio(1); _Pragma("unroll") for (int m = 0; m < 4; ++m) _Pragma("unroll") for (int n = 0; n < 2; ++n) _Pragma("unroll") for (int k = 0; k < 2; ++k) \
        acc[ai][bj][m][n] = __builtin_amdgcn_mfma_f32_16x16x32_bf16(Bt[n][k], At[m][k], acc[ai][bj][m][n], 0, 0, 0); __builtin_amdgcn_s_setprio(0); } while (0)
#define PG8_WAIT_V(n) asm volatile("s_waitcnt vmcnt(" #n ")" ::: "memory")
#define PG8_WAIT_L(n) asm volatile("s_waitcnt lgkmcnt(" #n ")" ::: "memory")
#define PG8_BAR __builtin_amdgcn_s_barrier()
#define PG8_SCHED __builtin_amdgcn_sched_barrier(0)
#define PG8_GOFF(dst, u) do { _Pragma("unroll") for (int _h = 0; _h < 2; ++_h) _Pragma("unroll") for (int _i = 0; _i < 2; ++_i) \
        dst[_h][_i] = S.tok(u, _h * HALF + RA[_i]) * (unsigned)(g.lda * 2) + (unsigned)(CA[_i] * 2); } while (0)
    Unit cur, nxt; int ui = 0;
    if (!S.next(0, cur)) return;
    Acc acc;
#pragma unroll
    for (int a = 0; a < 2; ++a)
#pragma unroll
        for (int b = 0; b < 2; ++b)
#pragma unroll
            for (int m = 0; m < 4; ++m)
#pragma unroll
                for (int n = 0; n < 2; ++n) acc[a][b][m][n] = (f32x4){0.f, 0.f, 0.f, 0.f};
    bf16x8 At[4][2], B0[2][2], B1[2][2];
    const char* cA = S.abase(g, cur); const char* cB = S.bbase(g, cur);
    unsigned vc[2][2] = {{0u, 0u}, {0u, 0u}}, vn[2][2] = {{0u, 0u}, {0u, 0u}};
    if constexpr (Sched::GATHER) PG8_GOFF(vc, cur);
    {
        const char* a1 = cA; const size_t ka1 = 0;
        PG8_STAGE(PG8_SB(0, 0), cB, voffB); PG8_STAGE(PG8_SB(0, 1), cB + hstepB, voffB); PG8_STA1(PG8_SA(0, 0), 0); PG8_STA1(PG8_SA(0, 1), 1);
        if (wr == 1) PG8_BAR;
        PG8_WAIT_V(2); PG8_BAR;
    }
    {
        const char* a1 = cA + kstep; const size_t ka1 = kstep;
        PG8_STAGE(PG8_SB(1, 0), cB + kstep, voffB); PG8_STA1(PG8_SA(1, 0), 0); PG8_STAGE(PG8_SB(1, 1), cB + hstepB + kstep, voffB);
        PG8_WAIT_V(6); PG8_BAR;
    }
    for (;;) {
        const bool has_next = S.next(ui + 1, nxt);
        const char* nA = has_next ? S.abase(g, nxt) : cA; const char* nB = has_next ? S.bbase(g, nxt) : cB;
        if constexpr (Sched::GATHER) { if (has_next) PG8_GOFF(vn, nxt); else {
#pragma unroll
            for (int _h = 0; _h < 2; ++_h) { vn[_h][0] = vc[_h][0]; vn[_h][1] = vc[_h][1]; } } }
        for (int t = 0; t < nt; t += 2) {
            const bool last = (t == nt - 2);
            const char* a1 = cA + (size_t)(t + 1) * kstep; const size_t ka1 = (size_t)(t + 1) * kstep;
            const char* a2 = last ? nA : cA + (size_t)(t + 2) * kstep; const char* b2 = last ? nB : cB + (size_t)(t + 2) * kstep;
            const size_t ka2 = last ? (size_t)0 : (size_t)(t + 2) * kstep;
            const char* a3 = a2 + kstep; const char* b3 = b2 + kstep;
            unsigned w2[2][2];
#pragma unroll
            for (int _h = 0; _h < 2; ++_h) { w2[_h][0] = last ? vn[_h][0] : vc[_h][0]; w2[_h][1] = last ? vn[_h][1] : vc[_h][1]; }
            PG8_LDB(B0, 0, 0); PG8_LDB(B1, 0, 1); PG8_SCHED; PG8_LDA(At, 0, 0); PG8_STA1(PG8_SA(1, 1), 1);
            PG8_WAIT_V(8); PG8_WAIT_L(0); PG8_BAR; PG8_MMA(0, 0, At, B0); PG8_MMA(0, 1, At, B1); PG8_BAR; PG8_SCHED;
            PG8_LDA(At, 0, 1); PG8_STAGE(PG8_SB(0, 0), b2, voffB); PG8_STAGE(PG8_SB(0, 1), b2 + hstepB, voffB); PG8_STA2(PG8_SA(0, 0), 0);
            PG8_WAIT_V(8); PG8_WAIT_L(0); PG8_BAR; PG8_MMA(1, 0, At, B0); PG8_MMA(1, 1, At, B1); PG8_BAR; PG8_SCHED;
            PG8_LDB(B0, 1, 0); PG8_LDB(B1, 1, 1); PG8_SCHED; PG8_LDA(At, 1, 0); PG8_STA2(PG8_SA(0, 1), 1);
            PG8_WAIT_V(8); PG8_WAIT_L(0); PG8_BAR; PG8_MMA(0, 0, At, B0); PG8_MMA(0, 1, At, B1); PG8_BAR; PG8_SCHED;
            PG8_LDA(At, 1, 1); PG8_STAGE(PG8_SB(1, 0), b3, voffB); PG8_STAGE(PG8_SB(1, 1), b3 + hstepB, voffB); PG8_STA3(PG8_SA(1, 0), 0);
            PG8_WAIT_V(8); PG8_WAIT_L(0); PG8_BAR; PG8_MMA(1, 0, At, B0); PG8_MMA(1, 1, At, B1); PG8_BAR; PG8_SCHED;
        }
        if (wr == 0) PG8_BAR;
        E(acc, cur, wr, wc, fr, fq, lds, tid);
        if (!has_next) break;
#pragma unroll
        for (int a = 0; a < 2; ++a)
#pragma unroll
            for (int b = 0; b < 2; ++b)
#pragma unroll
                for (int m = 0; m < 4; ++m)
#pragma unroll
                    for (int n = 0; n < 2; ++n) acc[a][b][m][n] = (f32x4){0.f, 0.f, 0.f, 0.f};
        cur = nxt; cA = nA; cB = nB; ++ui;
#pragma unroll
        for (int _h = 0; _h < 2; ++_h) { vc[_h][0] = vn[_h][0]; vc[_h][1] = vn[_h][1]; }
        if (wr == 1) PG8_BAR;
    }
    PG8_WAIT_V(0);
    PG8_BAR;
#undef PG8_SA
#undef PG8_SB
#undef PG8_STAGE
#undef PG8_STA1
#undef PG8_STA2
#undef PG8_STA3
#undef PG8_LDA
#undef PG8_LDB
#undef PG8_MMA
#undef PG8_WAIT_V
#undef PG8_WAIT_L
#undef PG8_BAR
#undef PG8_SCHED
#undef PG8_GOFF
}

#define EPI_BAR() do { asm volatile("s_waitcnt lgkmcnt(0)" ::: "memory"); __builtin_amdgcn_s_barrier(); asm volatile("" ::: "memory"); } while (0)
__device__ __forceinline__ void rows_allreduce(float (&part)[2][4], LAS unsigned char* lds, int wr, int wc, int fr, int fq) {
    LAS float* XT = (LAS float*)(lds + XT_OFF);
#pragma unroll
    for (int ai = 0; ai < 2; ++ai)
#pragma unroll
        for (int m = 0; m < 4; ++m) { float s = part[ai][m]; s += __shfl_xor(s, 16); s += __shfl_xor(s, 32);
            if (fq == 0) XT[(ai * HALF + wr * 64 + m * 16 + fr) * 4 + wc] = s; }
    EPI_BAR();
#pragma unroll
    for (int ai = 0; ai < 2; ++ai)
#pragma unroll
        for (int m = 0; m < 4; ++m) { const f32x4 v = *(const LAS f32x4*)(XT + (ai * HALF + wr * 64 + m * 16 + fr) * 4); part[ai][m] = (v[0] + v[1]) + (v[2] + v[3]); }
}
template <int NS> __device__ __forceinline__ void rows_slots(float (&part)[2][4], float* ssp, int row0, int fq, int slot) {
#pragma unroll
    for (int ai = 0; ai < 2; ++ai)
#pragma unroll
        for (int m = 0; m < 4; ++m) { float s = part[ai][m]; s += __shfl_xor(s, 16); s += __shfl_xor(s, 32);
            if (fq == 0) ssp[(size_t)(row0 + ai * HALF + m * 16) * NS + slot] = s; }
}
__device__ __forceinline__ float sq4(f32x4 v) { return (v[0] * v[0] + v[1] * v[1]) + (v[2] * v[2] + v[3] * v[3]); }
__device__ __forceinline__ u32x4 pack8(f32x4 a, f32x4 b) { u32x4 w; w.x = cvt_pk_bf16(a[0], a[1]); w.y = cvt_pk_bf16(a[2], a[3]); w.z = cvt_pk_bf16(b[0], b[1]); w.w = cvt_pk_bf16(b[2], b[3]); return w; }
__device__ __forceinline__ u32x2 pack4(f32x4 a) { u32x2 w; w.x = cvt_pk_bf16(a[0], a[1]); w.y = cvt_pk_bf16(a[2], a[3]); return w; }
__device__ __forceinline__ f32x4 unpack4(u32x2 w) { return (f32x4){bflo(w.x), bfhi(w.x), bflo(w.y), bfhi(w.y)}; }

struct EpiInProj {
    static constexpr bool PERM = true;
    const float* ssx; bf16 *U, *CQ, *CKV, *QM, *GT; float* KR; float *ss_cq, *ss_ckv, *ss_kr; const float* qm_gain;
    __device__ __forceinline__ void operator()(Acc& acc, const Unit& u, int wr, int wc, int fr, int fq, LAS unsigned char* lds, int tid) const {
        asm volatile("" : "+v"(fr), "+v"(fq), "+v"(tid));
        const int pn = u.pn, row0 = u.pm * BM + wr * 64 + fr, cl = wc * 32 + 8 * fq;
        float rs[2][4];
#pragma unroll
        for (int ai = 0; ai < 2; ++ai)
#pragma unroll
            for (int m = 0; m < 4; ++m) rs[ai][m] = 1.0f / sqrtf(sum_slots<32>(ssx + (size_t)(row0 + ai * HALF + m * 16) * 32) * (1.0f / DM) + EPS);
#pragma unroll
        for (int ai = 0; ai < 2; ++ai)
#pragma unroll
            for (int bj = 0; bj < 2; ++bj)
#pragma unroll
                for (int m = 0; m < 4; ++m)
#pragma unroll
                    for (int n = 0; n < 2; ++n) acc[ai][bj][m][n] = acc[ai][bj][m][n] * rs[ai][m];
        if (pn < 4 || (pn >= 4 && pn < 8)) {
            bf16* dst; int ld, c0; float* ss = nullptr; int tl = 0;
            if (pn < 4) { dst = U; ld = S5W; c0 = pn * 256; } else if (pn < 6) { dst = CQ; ld = 512; c0 = (pn - 4) * 256; ss = ss_cq; tl = pn - 4; } else { dst = CKV; ld = 512; c0 = (pn - 6) * 256; ss = ss_ckv; tl = pn - 6; }
            float part[2][4];
#pragma unroll
            for (int ai = 0; ai < 2; ++ai)
#pragma unroll
                for (int m = 0; m < 4; ++m) { bf16* rp = dst + (size_t)(row0 + ai * HALF + m * 16) * ld + c0 + cl; float s = 0.f;
#pragma unroll
                    for (int bj = 0; bj < 2; ++bj) { *(u32x4*)(rp + bj * HALF) = pack8(acc[ai][bj][m][0], acc[ai][bj][m][1]); s += sq4(acc[ai][bj][m][0]) + sq4(acc[ai][bj][m][1]); }
                    part[ai][m] = s; }
            if (ss) rows_slots<8>(part, ss, row0, fq, tl * 4 + wc);
        } else if (pn == 8) {
            float part[2][4];
#pragma unroll
            for (int ai = 0; ai < 2; ++ai)
#pragma unroll
                for (int m = 0; m < 4; ++m) { float s = 0.f;
                    if (wc < 2) { float* rp = KR + (size_t)(row0 + ai * HALF + m * 16) * 64 + cl; *(f32x4*)rp = acc[ai][0][m][0]; *(f32x4*)(rp + 4) = acc[ai][0][m][1]; s = sq4(acc[ai][0][m][0]) + sq4(acc[ai][0][m][1]); }
                    part[ai][m] = s; }
            rows_slots<4>(part, ss_kr, row0, fq, wc);
        } else if (pn < 13) {
            float part[2][4];
#pragma unroll
            for (int ai = 0; ai < 2; ++ai)
#pragma unroll
                for (int m = 0; m < 4; ++m) { float s = 0.f;
#pragma unroll
                    for (int bj = 0; bj < 2; ++bj) s += sq4(acc[ai][bj][m][0]) + sq4(acc[ai][bj][m][1]);
                    part[ai][m] = s; }
            rows_allreduce(part, lds, wr, wc, fr, fq);
            f32x4 gn[2][2];
#pragma unroll
            for (int bj = 0; bj < 2; ++bj)
#pragma unroll
                for (int n = 0; n < 2; ++n) gn[bj][n] = *(const f32x4*)(qm_gain + bj * HALF + cl + 4 * n) * (0.0625f * LOG2E);
#pragma unroll
            for (int ai = 0; ai < 2; ++ai)
#pragma unroll
                for (int m = 0; m < 4; ++m) { const float rq = 1.0f / sqrtf(part[ai][m] * (1.0f / MEMD) + EPS); bf16* rp = QM + (size_t)(row0 + ai * HALF + m * 16) * MEMW + (pn - 9) * 256 + cl;
#pragma unroll
                    for (int bj = 0; bj < 2; ++bj) *(u32x4*)(rp + bj * HALF) = pack8(acc[ai][bj][m][0] * gn[bj][0] * rq, acc[ai][bj][m][1] * gn[bj][1] * rq); }
        } else {
#pragma unroll
            for (int ai = 0; ai < 2; ++ai)
#pragma unroll
                for (int m = 0; m < 4; ++m) { bf16* rp = GT + (size_t)(row0 + ai * HALF + m * 16) * (3 * DM) + (pn - 13) * 256 + cl;
#pragma unroll
                    for (int bj = 0; bj < 2; ++bj) { f32x4 a = acc[ai][bj][m][0], b = acc[ai][bj][m][1];
#pragma unroll
                        for (int e = 0; e < 4; ++e) { a[e] = sigmoidf_(a[e]); b[e] = sigmoidf_(b[e]); }
                        *(u32x4*)(rp + bj * HALF) = pack8(a, b); } }
        }
    }
};

struct EpiQ {
    static constexpr bool PERM = true;
    const float* ss_cq; const float* qn; const float* ropec; const float* ropes; bf16* Q;
    __device__ __forceinline__ void operator()(Acc& acc, const Unit& u, int wr, int wc, int fr, int fq, LAS unsigned char* lds, int tid) const {
        asm volatile("" : "+v"(fr), "+v"(fq), "+v"(tid));
        const int row0 = u.pm * BM + wr * 64 + fr, cl = wc * 32 + 8 * fq;
        float part[2][4];
#pragma unroll
        for (int ai = 0; ai < 2; ++ai)
#pragma unroll
            for (int m = 0; m < 4; ++m) { const float a = 1.0f / sqrtf(sum_slots<8>(ss_cq + (size_t)(row0 + ai * HALF + m * 16) * 8) * (1.0f / QRANK) + EPS); float s = 0.f;
#pragma unroll
                for (int bj = 0; bj < 2; ++bj)
#pragma unroll
                    for (int n = 0; n < 2; ++n) { acc[ai][bj][m][n] = acc[ai][bj][m][n] * a; s += sq4(acc[ai][bj][m][n]); }
                part[ai][m] = s; }
        rows_allreduce(part, lds, wr, wc, fr, fq);
        const float SC = 0.07216878364870322f * LOG2E;
        { f32x4 g0 = *(const f32x4*)(qn + cl), g1 = *(const f32x4*)(qn + cl + 4);
#pragma unroll
          for (int ai = 0; ai < 2; ++ai)
#pragma unroll
            for (int m = 0; m < 4; ++m) { const float rq = SC / sqrtf(part[ai][m] * (1.0f / DQK) + EPS); bf16* rp = Q + ((size_t)u.pn * SEQ + row0 + ai * HALF + m * 16) * DQK + cl;
                *(u32x4*)rp = pack8(acc[ai][0][m][0] * g0 * rq, acc[ai][0][m][1] * g1 * rq); } }
        if (wc < 2) {
            const int i0 = cl >> 1; float g1v[4], g2v[4];
#pragma unroll
            for (int j = 0; j < 4; ++j) { g1v[j] = qn[128 + i0 + j]; g2v[j] = qn[160 + i0 + j]; }
#pragma unroll
            for (int ai = 0; ai < 2; ++ai)
#pragma unroll
                for (int m = 0; m < 4; ++m) { const int row = row0 + ai * HALF + m * 16; const float rq = SC / sqrtf(part[ai][m] * (1.0f / DQK) + EPS);
                    const f32x4 cs = *(const f32x4*)(ropec + (size_t)row * 32 + i0), sn = *(const f32x4*)(ropes + (size_t)row * 32 + i0);
                    f32x4 o0, o1;
                    { const float x1 = acc[ai][1][m][0][0] * g1v[0] * rq, x2 = acc[ai][1][m][0][1] * g2v[0] * rq; o0[0] = x1 * cs[0] - x2 * sn[0]; o0[1] = x2 * cs[0] + x1 * sn[0]; }
                    { const float x1 = acc[ai][1][m][0][2] * g1v[1] * rq, x2 = acc[ai][1][m][0][3] * g2v[1] * rq; o0[2] = x1 * cs[1] - x2 * sn[1]; o0[3] = x2 * cs[1] + x1 * sn[1]; }
                    { const float x1 = acc[ai][1][m][1][0] * g1v[2] * rq, x2 = acc[ai][1][m][1][1] * g2v[2] * rq; o1[0] = x1 * cs[2] - x2 * sn[2]; o1[1] = x2 * cs[2] + x1 * sn[2]; }
                    { const float x1 = acc[ai][1][m][1][2] * g1v[3] * rq, x2 = acc[ai][1][m][1][3] * g2v[3] * rq; o1[2] = x1 * cs[3] - x2 * sn[3]; o1[3] = x2 * cs[3] + x1 * sn[3]; }
                    *(u32x4*)(Q + ((size_t)u.pn * SEQ + row) * DQK + 128 + cl) = pack8(o0, o1); }
        }
    }
};

struct EpiKV {
    static constexpr bool PERM = true;
    const float* ss_ckv; const float* ss_kr; const float* kn; const float* KR; const float* ropec; const float* ropes; bf16* Kc; bf16* Vc;
    __device__ __forceinline__ void operator()(Acc& acc, const Unit& u, int wr, int wc, int fr, int fq, LAS unsigned char* lds, int tid) const {
        asm volatile("" : "+v"(fr), "+v"(fq), "+v"(tid));
        const int row0 = u.pm * BM + wr * 64 + fr, cl = wc * 32 + 8 * fq;
        float part[2][4];
#pragma unroll
        for (int ai = 0; ai < 2; ++ai)
#pragma unroll
            for (int m = 0; m < 4; ++m) { const float a = 1.0f / sqrtf(sum_slots<8>(ss_ckv + (size_t)(row0 + ai * HALF + m * 16) * 8) * (1.0f / KVRANK) + EPS);
#pragma unroll
                for (int bj = 0; bj < 2; ++bj)
#pragma unroll
                    for (int n = 0; n < 2; ++n) acc[ai][bj][m][n] = acc[ai][bj][m][n] * a;
                part[ai][m] = sq4(acc[ai][0][m][0]) + sq4(acc[ai][0][m][1]); }
        rows_allreduce(part, lds, wr, wc, fr, fq);
        LAS float* RKt = (LAS float*)(lds + RK_OFF);
        const f32x4 g0 = *(const f32x4*)(kn + cl), g1 = *(const f32x4*)(kn + cl + 4);
#pragma unroll
        for (int ai = 0; ai < 2; ++ai)
#pragma unroll
            for (int m = 0; m < 4; ++m) { const int row = row0 + ai * HALF + m * 16; const float rk = 1.0f / sqrtf((part[ai][m] + sum_slots<4>(ss_kr + (size_t)row * 4)) * (1.0f / DQK) + EPS);
                *(u32x4*)(Kc + ((size_t)u.pn * SEQ + row) * DQK + cl) = pack8(acc[ai][0][m][0] * g0 * rk, acc[ai][0][m][1] * g1 * rk);
                *(u32x4*)(Vc + ((size_t)u.pn * SEQ + row) * DV + cl) = pack8(acc[ai][1][m][0], acc[ai][1][m][1]);
                if (wc == 0 && fq == 0) RKt[ai * HALF + wr * 64 + m * 16 + fr] = rk; }
        EPI_BAR();
        {
            const int rl = tid >> 1, i0 = (tid & 1) * 16, row = u.pm * BM + rl; const float rk = RKt[rl];
            const float* kr = KR + (size_t)row * 64; bf16* dst = Kc + ((size_t)u.pn * SEQ + row) * DQK + 128 + 2 * i0;
#pragma unroll
            for (int j4 = 0; j4 < 4; ++j4) { const int i = i0 + 4 * j4;
                const f32x4 x1 = *(const f32x4*)(kr + i) * *(const f32x4*)(kn + 128 + i) * rk, x2 = *(const f32x4*)(kr + 32 + i) * *(const f32x4*)(kn + 160 + i) * rk;
                const f32x4 cs = *(const f32x4*)(ropec + (size_t)row * 32 + i), sn = *(const f32x4*)(ropes + (size_t)row * 32 + i);
                const f32x4 a = x1 * cs - x2 * sn, b = x2 * cs + x1 * sn;
                *(u32x4*)(dst + 8 * j4) = pack8((f32x4){a[0], b[0], a[1], b[1]}, (f32x4){a[2], b[2], a[3], b[3]}); }
        }
    }
};

struct EpiMemKV {
    static constexpr bool PERM = true;
    const float* kng[2]; bf16* KM; bf16* VM;
    __device__ __forceinline__ void operator()(Acc& acc, const Unit& u, int wr, int wc, int fr, int fq, LAS unsigned char* lds, int tid) const {
        asm volatile("" : "+v"(fr), "+v"(fq), "+v"(tid));
        const int rl0 = wr * 64 + fr, cl = wc * 32 + 8 * fq;
        float part[2][4];
#pragma unroll
        for (int ai = 0; ai < 2; ++ai)
#pragma unroll
            for (int m = 0; m < 4; ++m) { float s = 0.f;
#pragma unroll
                for (int bj = 0; bj < 2; ++bj) s += sq4(acc[ai][bj][m][0]) + sq4(acc[ai][bj][m][1]);
                part[ai][m] = s; }
        rows_allreduce(part, lds, wr, wc, fr, fq);
        const bool isk = u.pn < 4; const float* kg = u.e ? kng[1] : kng[0];
        bf16* dst = (isk ? KM : VM) + ((size_t)u.e * MEMH + (u.pn & 3)) * NMEM * MEMD;
#pragma unroll
        for (int ai = 0; ai < 2; ++ai)
#pragma unroll
            for (int m = 0; m < 4; ++m) { const float rk = isk ? 1.0f / sqrtf(part[ai][m] * (1.0f / MEMD) + EPS) : 1.0f;
#pragma unroll
                for (int bj = 0; bj < 2; ++bj) { f32x4 g0 = (f32x4){1.f, 1.f, 1.f, 1.f}, g1 = g0; if (isk) { g0 = *(const f32x4*)(kg + bj * HALF + cl); g1 = *(const f32x4*)(kg + bj * HALF + cl + 4); }
                    *(u32x4*)(dst + (size_t)(rl0 + ai * HALF + m * 16) * MEMD + bj * HALF + cl) = pack8(acc[ai][bj][m][0] * g0 * rk, acc[ai][bj][m][1] * g1 * rk); } }
    }
};

template <int MODE> struct EpiMerge {
    static constexpr bool PERM = false;
    const bf16* GT; float* MF;
    __device__ __forceinline__ void operator()(Acc& acc, const Unit& u, int wr, int wc, int fr, int fq, LAS unsigned char* lds, int tid) const {
        asm volatile("" : "+v"(fr), "+v"(fq), "+v"(tid));
        const int row0 = u.pm * BM + wr * 64 + fr, col0 = u.pn * BM + wc * 32 + 4 * fq;
#pragma unroll
        for (int ai = 0; ai < 2; ++ai)
#pragma unroll
            for (int m = 0; m < 4; ++m) { const size_t row = row0 + ai * HALF + m * 16;
#pragma unroll
                for (int bj = 0; bj < 2; ++bj)
#pragma unroll
                    for (int n = 0; n < 2; ++n) { const int c = col0 + bj * HALF + n * 16; const f32x4 gg = unpack4(*(const u32x2*)(GT + row * (3 * DM) + MODE * DM + c));
                        float* p = MF + row * DM + c; f32x4 v = acc[ai][bj][m][n] * gg; if (MODE == 2) v = v + *(const f32x4*)p; *(f32x4*)p = v; } }
    }
};
struct EpiGlu {
    static constexpr bool PERM = false;
    const bf16* GT; const float* MF; bf16* MB;
    __device__ __forceinline__ void operator()(Acc& acc, const Unit& u, int wr, int wc, int fr, int fq, LAS unsigned char* lds, int tid) const {
        asm volatile("" : "+v"(fr), "+v"(fq), "+v"(tid));
        const int row0 = u.pm * BM + wr * 64 + fr, col0 = u.pn * HALF + wc * 32 + 4 * fq;
#pragma unroll
        for (int ai = 0; ai < 2; ++ai)
#pragma unroll
            for (int m = 0; m < 4; ++m) { const size_t row = row0 + ai * HALF + m * 16;
#pragma unroll
                for (int n = 0; n < 2; ++n) { const int c = col0 + n * 16; const f32x4 gg = unpack4(*(const u32x2*)(GT + row * (3 * DM) + c));
                    const f32x4 ga = acc[ai][0][m][n], gb = acc[ai][1][m][n]; f32x4 v = *(const f32x4*)(MF + row * DM + c);
#pragma unroll
                    for (int e = 0; e < 4; ++e) v[e] += gg[e] * ga[e] * sigmoidf_(gb[e]);
                    *(u32x2*)(MB + row * DM + c) = pack4(v); } }
    }
};
struct EpiResid {
    static constexpr bool PERM = false;
    const float* base; float* OUT; bf16* XBo; float* ss;
    __device__ __forceinline__ void operator()(Acc& acc, const Unit& u, int wr, int wc, int fr, int fq, LAS unsigned char* lds, int tid) const {
        asm volatile("" : "+v"(fr), "+v"(fq), "+v"(tid));
        const int row0 = u.pm * BM + wr * 64 + fr, col0 = u.pn * BM + wc * 32 + 4 * fq;
        float part[2][4];
#pragma unroll
        for (int ai = 0; ai < 2; ++ai)
#pragma unroll
            for (int m = 0; m < 4; ++m) { const size_t row = row0 + ai * HALF + m * 16; float s = 0.f;
#pragma unroll
                for (int bj = 0; bj < 2; ++bj)
#pragma unroll
                    for (int n = 0; n < 2; ++n) { const int c = col0 + bj * HALF + n * 16; const f32x4 v = acc[ai][bj][m][n] + *(const f32x4*)(base + row * DM + c);
                        *(f32x4*)(OUT + row * DM + c) = v; if (XBo) *(u32x2*)(XBo + row * DM + c) = pack4(v); s += sq4(v); }
                part[ai][m] = s; }
        if (ss) rows_slots<32>(part, ss, row0, fq, u.pn * 4 + wc);
    }
};
template <class Sched> struct EpiSwiGLU {
    static constexpr bool PERM = true;
    const float* ssx; bf16* ACT; const Sched* S; bool moe;
    __device__ __forceinline__ void operator()(Acc& acc, const Unit& u, int wr, int wc, int fr, int fq, LAS unsigned char* lds, int tid) const {
        asm volatile("" : "+v"(fr), "+v"(fq), "+v"(tid));
        const int rl0 = wr * 64 + fr, cl = wc * 32 + 8 * fq;
#pragma unroll
        for (int ai = 0; ai < 2; ++ai)
#pragma unroll
            for (int m = 0; m < 4; ++m) { const int rl = rl0 + ai * HALF + m * 16; const unsigned tk = moe ? S->tok(u, rl) : (unsigned)(u.pm * BM + rl);
                const float rs = 1.0f / sqrtf(sum_slots<32>(ssx + (size_t)tk * 32) * (1.0f / DM) + EPS);
                f32x4 o[2];
#pragma unroll
                for (int n = 0; n < 2; ++n) { const f32x4 gg = acc[ai][0][m][n] * rs, uu = acc[ai][1][m][n] * rs;
#pragma unroll
                    for (int e = 0; e < 4; ++e) o[n][e] = gg[e] * sigmoidf_(gg[e]) * uu[e]; }
                *(u32x4*)(ACT + (size_t)(u.pm * BM + rl) * DFF + u.pn * HALF + cl) = pack8(o[0], o[1]); }
    }
};
struct EpiMoeDown {
    static constexpr bool PERM = true;
    bf16* YM;
    __device__ __forceinline__ void operator()(Acc& acc, const Unit& u, int wr, int wc, int fr, int fq, LAS unsigned char* lds, int tid) const {
        asm volatile("" : "+v"(fr), "+v"(fq), "+v"(tid));
        const int rl0 = wr * 64 + fr, cl = wc * 32 + 8 * fq;
        bf16* dst = YM + (size_t)u.ks * ACT_ROWS * DM;
#pragma unroll
        for (int ai = 0; ai < 2; ++ai)
#pragma unroll
            for (int m = 0; m < 4; ++m) { bf16* rp = dst + (size_t)(u.pm * BM + rl0 + ai * HALF + m * 16) * DM + u.pn * BM + cl;
#pragma unroll
                for (int bj = 0; bj < 2; ++bj) *(u32x4*)(rp + bj * HALF) = pack8(acc[ai][bj][m][0], acc[ai][bj][m][1]); }
    }
};
}
namespace attn {
constexpr int A_KOFF = 0, A_VOFF = 65536, A_WS = 98304, A_POSK = 100352, A_LIST = 100864;
__device__ __forceinline__ int v_st(int k, int c) { const int kk = (k & ~0xC) | ((k & 4) << 1) | ((k & 8) >> 1); return ((kk >> 3) * 4 + (c >> 5)) * 512 + ((kk & 7) * 32 + (c & 31)) * 2; }
__device__ __forceinline__ int v_rd_base(int lane) { return ((lane & 3) << 3) | (((lane >> 2) & 3) << 6) | (((lane >> 4) & 1) << 5) | (((lane >> 5) & 1) << 8); }
constexpr int v_rd_off(int d0, int ks, int half) { return d0 * 512 + ks * 4096 + half * 2048; }
__device__ __forceinline__ int crow(int r, int hi) { return (r & 3) + 8 * (r >> 2) + 4 * hi; }

template <int VBOFF>
__device__ __forceinline__ void pv_tile(f32x16* o, int vb0, bf16x8 pa0, bf16x8 pa1, bf16x8 pa2, bf16x8 pa3) {
#define TRRD(dst, off) asm volatile("ds_read_b64_tr_b16 %0, %1 offset:%2" : "=&v"(dst) : "v"(vb0), "i"(off) : "memory")
#define PV_D0(d0) do { s16x4 l0, l1, l2, l3, h0, h1, h2, h3; constexpr int b_ = VBOFF + v_rd_off(d0, 0, 0); \
        TRRD(l0, b_); TRRD(h0, b_ + 2048); TRRD(l1, b_ + 4096); TRRD(h1, b_ + 6144); TRRD(l2, b_ + 8192); TRRD(h2, b_ + 10240); TRRD(l3, b_ + 12288); TRRD(h3, b_ + 14336); \
        asm volatile("s_waitcnt lgkmcnt(0)" ::: "memory"); SBAR(); \
        o[d0] = __builtin_amdgcn_mfma_f32_32x32x16_bf16(pa0, (bf16x8){l0[0], l0[1], l0[2], l0[3], h0[0], h0[1], h0[2], h0[3]}, o[d0], 0, 0, 0);   \
        o[d0] = __builtin_amdgcn_mfma_f32_32x32x16_bf16(pa1, (bf16x8){l1[0], l1[1], l1[2], l1[3], h1[0], h1[1], h1[2], h1[3]}, o[d0], 0, 0, 0);   \
        o[d0] = __builtin_amdgcn_mfma_f32_32x32x16_bf16(pa2, (bf16x8){l2[0], l2[1], l2[2], l2[3], h2[0], h2[1], h2[2], h2[3]}, o[d0], 0, 0, 0);   \
        o[d0] = __builtin_amdgcn_mfma_f32_32x32x16_bf16(pa3, (bf16x8){l3[0], l3[1], l3[2], l3[3], h3[0], h3[1], h3[2], h3[3]}, o[d0], 0, 0, 0); } while (0)
    PV_D0(0); PV_D0(1); PV_D0(2); PV_D0(3);
#undef PV_D0
#undef TRRD
}

template <int DQ, bool CAUSAL, int qstride, int vstride, int ostride, bool QREG>
__device__ __forceinline__ void attn_item(char* lds, LAS unsigned char* ldsl, const bf16* Qb, const bf16* Kh, const bf16* Vh, bf16* Ob,
                                          const int* pos, int q0, int nkt, const int* tmin, const int* tmax) {
    constexpr int KSTR = DQ * 2, KBYTES = 64 * KSTR, NCH = DQ / 64, CPR = DQ / 8, ND0 = DQ / 16;
    const int tid = fresh_tid(), wid = __builtin_amdgcn_readfirstlane(tid >> 6), lane = tid & 63, r32 = lane & 31, hi = lane >> 5;
    char* K_lds = lds + A_KOFF; char* V_lds = lds + A_VOFF;
    float* wsf = (float*)(lds + A_WS) + wid * 64; float* li_l = wsf; float* al_l = wsf + 32;
    int* posk = (int*)(lds + A_POSK); int* tlist = (int*)(lds + A_LIST);
    int NT = nkt;
    if constexpr (CAUSAL) {
        if (wid == 0) {
            const int qt = q0 >> 6; int qmax = tmax[qt]; qmax = max(qmax, tmax[qt + 1]); qmax = max(qmax, tmax[qt + 2]); qmax = max(qmax, tmax[qt + 3]);
            const bool n0 = lane < nkt && tmin[lane] <= qmax, n1 = lane + 64 < nkt && tmin[lane + 64] <= qmax;
            const unsigned long long b0 = __ballot(n0), b1 = __ballot(n1); const int c0 = __popcll(b0);
            const unsigned long long below = (lane == 0) ? 0ull : (~0ull >> (64 - lane));
            if (n0) tlist[__popcll(b0 & below)] = lane;
            if (n1) tlist[c0 + __popcll(b1 & below)] = lane + 64;
            if (lane == 0) tlist[128] = c0 + __popcll(b1);
        }
        __syncthreads();
        NT = tlist[128];
    }
#define TILE(t) (CAUSAL ? tlist[t] : (t))
    int ksrc[NCH], vsrc[2];
#pragma unroll
    for (int jj = 0; jj < NCH; ++jj) { const int p = jj * 512 + tid, row = p / CPR, cs = p % CPR, cc = (cs & ~7) | ((cs & 7) ^ (row & 7)); ksrc[jj] = row * DQ + cc * 8; }
#pragma unroll
    for (int jj = 0; jj < 2; ++jj) { const int p = jj * 512 + tid, kk = (p >> 7) * 8 + ((p & 31) >> 2), k = (kk & ~0xC) | ((kk & 4) << 1) | ((kk & 8) >> 1), cv = ((p >> 5) & 3) * 32 + (p & 3) * 8; vsrc[jj] = k * vstride + cv; }
    int stP = 0;
#define A_STAGE(tile_, bf) do { const int kb_ = (tile_) * 64; \
        _Pragma("unroll") for (int jj = 0; jj < NCH; ++jj) __builtin_amdgcn_global_load_lds((const unsigned*)(Kh + (size_t)kb_ * DQ + ksrc[jj]), (LAS unsigned*)(ldsl + A_KOFF + (bf) * KBYTES + jj * 8192 + wid * 1024), 16, 0, 0); \
        _Pragma("unroll") for (int jj = 0; jj < 2; ++jj) __builtin_amdgcn_global_load_lds((const unsigned*)(Vh + (size_t)kb_ * vstride + vsrc[jj]), (LAS unsigned*)(ldsl + A_VOFF + (bf) * 16384 + jj * 8192 + wid * 1024), 16, 0, 0); \
        if (CAUSAL && tid < 64) stP = pos[kb_ + tid]; } while (0)
#define A_POSW(bf) do { if (CAUSAL && tid < 64) posk[(bf) * 64 + tid] = stP; } while (0)
    A_STAGE(TILE(0), 0);
    bf16x8 qr[QREG ? ND0 : 1];
    if constexpr (QREG) {
#pragma unroll
        for (int d0 = 0; d0 < ND0; ++d0) qr[d0] = *(const bf16x8*)(Qb + (size_t)(wid * 32 + r32) * qstride + d0 * 16 + hi * 8); }
    int posq = 0, wminq = 0;
    if constexpr (CAUSAL) { posq = pos[q0 + wid * 32 + r32]; int v = posq;
#pragma unroll
        for (int o_ = 1; o_ < 32; o_ <<= 1) v = min(v, __shfl_xor(v, o_));
        wminq = __builtin_amdgcn_readfirstlane(v); }
    A_POSW(0);
    __syncthreads();
    float m_reg = -1e30f, l_reg = 0.f; f32x16 o[4] = {};
    const int vb0 = (int)(uintptr_t)V_lds + v_rd_base(lane);
    int kbv[4];
#pragma unroll
    for (int dd = 0; dd < 4; ++dd) kbv[dd] = r32 * KSTR + (((dd * 2 + hi) ^ (r32 & 7)) << 4);
    for (int t = 0; t < NT; ++t) {
        const int buf = t & 1; const int tile = TILE(t);
        if (t + 1 < NT) { if (buf == 0) A_STAGE(TILE(t + 1), 1); else A_STAGE(TILE(t + 1), 0); }
        SBAR();
        f32x16 p0 = {}, p1 = {};
        { const char* kb_ = K_lds + buf * KBYTES; int qo = (wid * 32 + r32) * qstride + hi * 8; if (!QREG) asm volatile("" : "+v"(qo));
#pragma unroll
          for (int d0 = 0; d0 < ND0; ++d0) { const char* a = kb_ + kbv[d0 & 3] + (d0 >> 2) * 128;
              const bf16x8 b0 = *(const bf16x8*)a, b1 = *(const bf16x8*)(a + 32 * KSTR);
              bf16x8 qf; if constexpr (QREG) qf = qr[d0]; else qf = *(const bf16x8*)(Qb + qo + d0 * 16);
              p0 = __builtin_amdgcn_mfma_f32_32x32x16_bf16(b0, qf, p0, 0, 0, 0);
              p1 = __builtin_amdgcn_mfma_f32_32x32x16_bf16(b1, qf, p1, 0, 0, 0); } }
        if constexpr (CAUSAL) {
            if (tmax[tile] > wminq) {
                const float NEG = -__builtin_inff(); const int* pk = posk + buf * 64 + 4 * hi;
#pragma unroll
                for (int g = 0; g < 4; ++g) { const int4 k0 = *(const int4*)(pk + 8 * g), k1 = *(const int4*)(pk + 32 + 8 * g);
                    if (k0.x > posq) p0[4 * g + 0] = NEG; if (k0.y > posq) p0[4 * g + 1] = NEG; if (k0.z > posq) p0[4 * g + 2] = NEG; if (k0.w > posq) p0[4 * g + 3] = NEG;
                    if (k1.x > posq) p1[4 * g + 0] = NEG; if (k1.y > posq) p1[4 * g + 1] = NEG; if (k1.z > posq) p1[4 * g + 2] = NEG; if (k1.w > posq) p1[4 * g + 3] = NEG; }
            }
        }
        float pmax = p0[0];
#pragma unroll
        for (int r = 1; r < 16; ++r) pmax = fmaxf(pmax, p0[r]);
#pragma unroll
        for (int r = 0; r < 16; ++r) pmax = fmaxf(pmax, p1[r]);
        { auto rr = __builtin_amdgcn_permlane32_swap(__float_as_uint(pmax), __float_as_uint(pmax), false, false); pmax = fmaxf(__uint_as_float(rr[0]), __uint_as_float(rr[1])); }
        const float mn = fmaxf(m_reg, pmax); const float alpha = __builtin_amdgcn_exp2f(m_reg - mn); m_reg = mn;
        float ps = 0.f;
#pragma unroll
        for (int r = 0; r < 16; ++r) { p0[r] = __builtin_amdgcn_exp2f(p0[r] - mn); ps += p0[r]; }
#pragma unroll
        for (int r = 0; r < 16; ++r) { p1[r] = __builtin_amdgcn_exp2f(p1[r] - mn); ps += p1[r]; }
        { auto rr = __builtin_amdgcn_permlane32_swap(__float_as_uint(ps), __float_as_uint(ps), false, false); ps = __uint_as_float(rr[0]) + __uint_as_float(rr[1]); }
        l_reg = l_reg * alpha + ps;
        bf16x8 pa0, pa1, pa2, pa3;
#define PK4(P, B_, OUT) do { unsigned a0 = cvt_pk_bf16(P[B_+0], P[B_+1]), a1 = cvt_pk_bf16(P[B_+2], P[B_+3]); \
        unsigned b0 = cvt_pk_bf16(P[B_+4], P[B_+5]), b1 = cvt_pk_bf16(P[B_+6], P[B_+7]); \
        auto r0 = __builtin_amdgcn_permlane32_swap(a0, b0, false, false); auto r1 = __builtin_amdgcn_permlane32_swap(a1, b1, false, false); \
        u32x4 w = {r0[0], r1[0], r0[1], r1[1]}; OUT = *reinterpret_cast<bf16x8*>(&w); } while (0)
        PK4(p0, 0, pa0); PK4(p0, 8, pa1); PK4(p1, 0, pa2); PK4(p1, 8, pa3);
#undef PK4
        if (__any(alpha < 1.f)) { if (hi == 0) al_l[r32] = alpha; asm volatile("s_waitcnt lgkmcnt(0)" ::: "memory");
#pragma unroll
            for (int r = 0; r < 16; ++r) { const float a = al_l[crow(r, hi)];
#pragma unroll
                for (int d_ = 0; d_ < 4; ++d_) o[d_][r] *= a; } }
        SBAR();
        if (buf == 0) pv_tile<0>(o, vb0, pa0, pa1, pa2, pa3); else pv_tile<16384>(o, vb0, pa0, pa1, pa2, pa3);
        SBAR();
        if (t + 1 < NT) { if (buf == 0) A_POSW(1); else A_POSW(0); }
        __syncthreads();
    }
    if (hi == 0) li_l[r32] = l_reg; asm volatile("s_waitcnt lgkmcnt(0)" ::: "memory");
    int oofs = (wid * 32 + 4 * hi) * ostride + r32; asm volatile("" : "+v"(oofs));
    bf16* Ow = Ob + oofs;
#pragma unroll
    for (int r = 0; r < 16; ++r) { constexpr int dummy = 0; (void)dummy; const int orow = crow(r, hi); const float rl = __builtin_amdgcn_rcpf(li_l[orow]);
#pragma unroll
        for (int d0 = 0; d0 < 4; ++d0) { const float v = o[d0][r] * rl; const float vn = __shfl_xor(v, 1);
            if ((r32 & 1) == 0) *(unsigned*)(Ow + ((r & 3) + 8 * (r >> 2)) * ostride + d0 * 32) = cvt_pk_bf16(v, vn); } }
    __syncthreads();
#undef A_STAGE
#undef A_POSW
#undef TILE
}
}
namespace s5 {
constexpr int TROW = 136;
constexpr int WAVE_LDS = 32 * TROW * 2;
__device__ __forceinline__ void cmul(float ar, float ai, float br, float bi, float& cr, float& ci) { cr = ar * br - ai * bi; ci = ar * bi + ai * br; }
__device__ __forceinline__ float gelu_tanh(float x) { const float z = 1.5957691216057308f * (x + 0.044715f * x * x * x); return x * sigmoidf_(z); }

template <int PART>
__device__ __forceinline__ void s5_wave(char* ldsw, int g, int c0, const bf16* U, const f32x2* LAM, const bf16* BB, const bf16* CP, const float* Dd, float* ES, bf16* YS, int lane) {
    const int c = lane & 31, hi = lane >> 5;
    float l1r[2], l1i[2], l2r[2], l2i[2], l3r[2], l3i[2], l4r[2], l4i[2];
    bf16x8 bfrag[2][2];
#pragma unroll
    for (int sb = 0; sb < 2; ++sb) { const f32x2 lm = LAM[g * 64 + 32 * sb + c]; l1r[sb] = lm.x; l1i[sb] = lm.y;
        cmul(l1r[sb], l1i[sb], l1r[sb], l1i[sb], l2r[sb], l2i[sb]); cmul(l2r[sb], l2i[sb], l1r[sb], l1i[sb], l3r[sb], l3i[sb]); cmul(l2r[sb], l2i[sb], l2r[sb], l2i[sb], l4r[sb], l4i[sb]);
#pragma unroll
        for (int ri = 0; ri < 2; ++ri) bfrag[sb][ri] = *(const bf16x8*)(BB + ((size_t)(g * 128 + 64 * ri + 32 * sb + c)) * 16 + 8 * hi); }
    float sr[2] = {0.f, 0.f}, si[2] = {0.f, 0.f};
    bf16x8 cpf[8];
    if constexpr (PART == 2) {
        float l64r[2], l64i[2];
#pragma unroll
        for (int sb = 0; sb < 2; ++sb) { float ar = l4r[sb], ai = l4i[sb];
#pragma unroll
            for (int k = 0; k < 4; ++k) { float tr, ti; cmul(ar, ai, ar, ai, tr, ti); ar = tr; ai = ti; }
            l64r[sb] = ar; l64i[sb] = ai; }
        for (int cc = 0; cc < c0; ++cc) { const float* e = ES + ((size_t)g * 128 + cc) * 128;
#pragma unroll
            for (int sb = 0; sb < 2; ++sb) { const float er = e[32 * sb + c], ei = e[64 + 32 * sb + c]; float tr, ti; cmul(l64r[sb], l64i[sb], sr[sb], si[sb], tr, ti); sr[sb] = tr + er; si[sb] = ti + ei; } }
#pragma unroll
        for (int ks = 0; ks < 8; ++ks) { cpf[ks] = (bf16x8){0, 0, 0, 0, 0, 0, 0, 0}; if (c < 16) cpf[ks] = *(const bf16x8*)(CP + ((size_t)(g * 16 + c)) * 128 + 16 * ks + 8 * hi); }
    }
    bf16* T = (bf16*)ldsw;
    for (int blk = 0; blk < 8; ++blk) {
        const int t0 = (c0 * 2 + blk) * 32;
        if (PART == 1 && (blk & 1) == 0) { sr[0] = 0.f; si[0] = 0.f; sr[1] = 0.f; si[1] = 0.f; }
        const bf16x8 af = *(const bf16x8*)(U + (size_t)(t0 + c) * S5W + g * 16 + 8 * hi);
#pragma unroll
        for (int sb = 0; sb < 2; ++sb) {
            f32x16 br = {}, bi = {};
            br = __builtin_amdgcn_mfma_f32_32x32x16_bf16(af, bfrag[sb][0], br, 0, 0, 0);
            bi = __builtin_amdgcn_mfma_f32_32x32x16_bf16(af, bfrag[sb][1], bi, 0, 0, 0);
#pragma unroll
            for (int q4 = 0; q4 < 4; ++q4)
#pragma unroll
                for (int k = 1; k < 4; ++k) { const int r = 4 * q4 + k; float tr, ti; cmul(l1r[sb], l1i[sb], br[r - 1], bi[r - 1], tr, ti); br[r] += tr; bi[r] += ti; }
            float per[4], pei[4];
#pragma unroll
            for (int q4 = 0; q4 < 4; ++q4) { per[q4] = __shfl_xor(br[4 * q4 + 3], 32); pei[q4] = __shfl_xor(bi[4 * q4 + 3], 32); }
            float cr = sr[sb], ci = si[sb], cinr[4], cini[4];
#pragma unroll
            for (int q = 0; q < 8; ++q) { const bool own = ((q & 1) == hi); const int q4 = q >> 1;
                if ((q & 1) == 0) { if (hi == 0) { cinr[q4] = cr; cini[q4] = ci; } } else { if (hi == 1) { cinr[q4] = cr; cini[q4] = ci; } }
                const float er = own ? br[4 * q4 + 3] : per[q4], ei = own ? bi[4 * q4 + 3] : pei[q4];
                float tr, ti; cmul(l4r[sb], l4i[sb], cr, ci, tr, ti); cr = tr + er; ci = ti + ei; }
            sr[sb] = cr; si[sb] = ci;
            if constexpr (PART == 2) {
#pragma unroll
                for (int q4 = 0; q4 < 4; ++q4) { float tr, ti;
                    cmul(l1r[sb], l1i[sb], cinr[q4], cini[q4], tr, ti); br[4 * q4 + 0] += tr; bi[4 * q4 + 0] += ti;
                    cmul(l2r[sb], l2i[sb], cinr[q4], cini[q4], tr, ti); br[4 * q4 + 1] += tr; bi[4 * q4 + 1] += ti;
                    cmul(l3r[sb], l3i[sb], cinr[q4], cini[q4], tr, ti); br[4 * q4 + 2] += tr; bi[4 * q4 + 2] += ti;
                    cmul(l4r[sb], l4i[sb], cinr[q4], cini[q4], tr, ti); br[4 * q4 + 3] += tr; bi[4 * q4 + 3] += ti; }
#pragma unroll
                for (int r = 0; r < 16; ++r) { const int tok = (r & 3) + 8 * (r >> 2) + 4 * hi;
                    T[tok * TROW + 32 * sb + c] = (bf16)f2bf(br[r]); T[tok * TROW + 64 + 32 * sb + c] = (bf16)f2bf(bi[r]); }
            }
        }
        if constexpr (PART == 1) {
            if ((blk & 1) == 1 && hi == 0) { float* e = ES + ((size_t)g * 128 + c0 + (blk >> 1)) * 128;
#pragma unroll
                for (int sb = 0; sb < 2; ++sb) { e[32 * sb + c] = sr[sb]; e[64 + 32 * sb + c] = si[sb]; } }
        } else {
            asm volatile("s_waitcnt lgkmcnt(0)" ::: "memory"); __builtin_amdgcn_wave_barrier(); asm volatile("" ::: "memory");
            f32x16 acc = {};
#pragma unroll
            for (int ks = 0; ks < 8; ++ks) { const bf16x8 sfrag = *(const bf16x8*)(T + c * TROW + 16 * ks + 8 * hi);
                acc = __builtin_amdgcn_mfma_f32_32x32x16_bf16(cpf[ks], sfrag, acc, 0, 0, 0); }
            const size_t ro = (size_t)(t0 + c) * S5W + g * 16;
            const f32x4 ua = pg8::unpack4(*(const u32x2*)(U + ro + 4 * hi)), ub = pg8::unpack4(*(const u32x2*)(U + ro + 8 + 4 * hi));
            const f32x4 da = *(const f32x4*)(Dd + g * 16 + 4 * hi), db = *(const f32x4*)(Dd + g * 16 + 8 + 4 * hi);
            f32x4 ya, yb;
#pragma unroll
            for (int e = 0; e < 4; ++e) { ya[e] = gelu_tanh(acc[e] + da[e] * ua[e]); yb[e] = gelu_tanh(acc[4 + e] + db[e] * ub[e]); }
            *(u32x2*)(YS + ro + 4 * hi) = pg8::pack4(ya); *(u32x2*)(YS + ro + 8 + 4 * hi) = pg8::pack4(yb);
            asm volatile("" ::: "memory"); __builtin_amdgcn_wave_barrier();
        }
    }
}
}
struct MapId   { __device__ __forceinline__ int operator()(int n) const { return n; } };
struct MapInProj { __device__ __forceinline__ int operator()(int n) const { return n < 1472 ? n : (n < 1536 ? -1 : (n < 2112 ? n - 64 : (n < 2304 ? -1 : n - 256))); } };
struct MapGlu  { int half; __device__ __forceinline__ int operator()(int n) const { const int j = n >> 8, r = n & 255; return r < 128 ? 128 * j + r : half + 128 * j + (r - 128); } };
struct MapQB   { __device__ __forceinline__ int operator()(int n) const { const int h = n >> 8, j = n & 255; if (j < 128) return 192 * h + j; if (j >= 192) return -1; const int jj = j - 128; return 192 * h + 128 + 32 * (jj & 1) + (jj >> 1); } };

template <class Map>
__device__ __forceinline__ void transpose_item(const float* W, int N, int K, bf16* WT, int Kd, const float* gain, const Map& map, LAS float* scr, int kb, int nb, int lane) {
    const int k0 = 64 * kb, n0 = 64 * nb; const int scol = map(n0 + lane);
    const bool kin = k0 < K;
#pragma unroll 8
    for (int kk = 0; kk < 64; ++kk) { float v = 0.f; if (kin && scol >= 0) { v = W[(size_t)(k0 + kk) * N + scol]; if (gain) v *= gain[k0 + kk]; } scr[kk * 65 + lane] = v; }
    LDS_WAIT(); asm volatile("" ::: "memory");
    const int c = lane & 7;
#pragma unroll
    for (int j = 0; j < 8; ++j) { const int n = (lane >> 3) + 8 * j; const LAS float* s = scr + (8 * c) * 65 + n;
        u32x4 o; o.x = pk2(s[0 * 65], s[1 * 65]); o.y = pk2(s[2 * 65], s[3 * 65]); o.z = pk2(s[4 * 65], s[5 * 65]); o.w = pk2(s[6 * 65], s[7 * 65]);
        *(GAS u32x4*)(WT + (size_t)(n0 + n) * Kd + k0 + 8 * c) = o; }
    LDS_WAIT(); asm volatile("" ::: "memory");
}
template <class Map>
__device__ __forceinline__ void transpose_job(const float* W, size_t wstride, int N, int K, bf16* WT, size_t wtstride, int Kd, int Nd, const float* gain, int gstride, int ninst, const Map& map,
                                              LAS float* scr, int gw, int NGW, int lane) {
    const int nkb = Kd / 64, nnb = Nd / 64, per = nkb * nnb;
    for (int it = gw; it < per * ninst; it += NGW) { const int inst = it / per, r = it - inst * per, nb = r / nkb, kb = r - nb * nkb;
        transpose_item(W + (size_t)inst * wstride, N, K, WT + (size_t)inst * wtstride, Kd, gain ? gain + (size_t)inst * gstride : nullptr, map, scr, kb, nb, lane); }
}
__device__ __forceinline__ float row_to_bf16(const float* xrow, bf16* orow, bool normalize, int lane) {
    const GAS f32x4* xr = (const GAS f32x4*)xrow + lane;
    f32x4 v[8]; float s = 0.f;
#pragma unroll
    for (int j = 0; j < 8; ++j) { v[j] = xr[64 * j]; s += pg8::sq4(v[j]); }
    s = wave_sum(s);
    const float sc = normalize ? 1.0f / sqrtf(s * (1.0f / DM) + EPS) : 1.0f;
    GAS u32x2* o8 = (GAS u32x2*)orow + lane;
#pragma unroll
    for (int j = 0; j < 8; ++j) o8[64 * j] = pg8::pack4(v[j] * sc);
    return s;
}
__device__ __forceinline__ void router_token(const float* xrow, const float* gain, const float* R, const float* rb, int tok, unsigned* cnt, int* list, int* toke, int* toks, float* tokw, int lane) {
    float lg[8] = {0.f, 0.f, 0.f, 0.f, 0.f, 0.f, 0.f, 0.f}; float ssq = 0.f;
#pragma unroll
    for (int j = 0; j < 8; ++j) { const int k0 = 256 * j + 4 * lane; const f32x4 xv = *(const f32x4*)(xrow + k0), gv = *(const f32x4*)(gain + k0); ssq += pg8::sq4(xv);
#pragma unroll
        for (int e = 0; e < 4; ++e) { const float h = xv[e] * gv[e]; const f32x4 r0 = *(const f32x4*)(R + (size_t)(k0 + e) * 8), r1 = *(const f32x4*)(R + (size_t)(k0 + e) * 8 + 4);
            lg[0] += h * r0[0]; lg[1] += h * r0[1]; lg[2] += h * r0[2]; lg[3] += h * r0[3]; lg[4] += h * r1[0]; lg[5] += h * r1[1]; lg[6] += h * r1[2]; lg[7] += h * r1[3]; } }
    ssq = wave_sum(ssq); const float rstd = 1.0f / sqrtf(ssq * (1.0f / DM) + EPS);
#pragma unroll
    for (int e = 0; e < 8; ++e) lg[e] = wave_sum(lg[e]) * rstd + rb[e];
    if (lane == 0) {
        int i1 = 0; float v1 = lg[0];
#pragma unroll
        for (int e = 1; e < 8; ++e) if (lg[e] > v1) { v1 = lg[e]; i1 = e; }
        int i2 = -1; float v2 = -3.0e38f;
#pragma unroll
        for (int e = 0; e < 8; ++e) if (e != i1 && lg[e] > v2) { v2 = lg[e]; i2 = e; }
        const float w1 = 1.0f / (1.0f + expf(v2 - v1)), w2 = 1.0f - w1;
        const int s1 = (int)atomicAdd(cnt + 64 * i1, 1u), s2 = (int)atomicAdd(cnt + 64 * i2, 1u);
        list[i1 * SEQ + s1] = tok; list[i2 * SEQ + s2] = tok;
        toke[2 * tok] = i1; toke[2 * tok + 1] = i2; toks[2 * tok] = s1; toks[2 * tok + 1] = s2; tokw[2 * tok] = w1; tokw[2 * tok + 1] = w2;
    }
}
#ifndef MK_PHMASK
#define MK_PHMASK 0xFFFFFFFFu
#endif
#define PH_ON(id) (((MK_PHMASK) >> (id)) & 1u)
constexpr int NWAVES = 8;
constexpr int NPH = 17;
struct Args { const void* in[34]; float* out; unsigned char* ws; int ph_lo, ph_hi; };
static_assert(sizeof(Args) == 34 * 8 + 8 + 8 + 8, "Args has no padding");


__global__ void __launch_bounds__(NWAVES * 64, 2) fwd(Args args) {
    extern __shared__ __attribute__((aligned(16))) unsigned char lds_raw[];
    LAS unsigned char* lds = (LAS unsigned char*)lds_raw;
    volatile LAS unsigned* MISC = (volatile LAS unsigned*)(lds + MISC_OFF);
    const int tid = threadIdx.x, lane = tid & 63, wave = __builtin_amdgcn_readfirstlane(tid >> 6);
    const int G = gridDim.x, bid = blockIdx.x, vcu = (G % 8 == 0) ? (bid % 8) * (G / 8) + bid / 8 : bid;
    const int gw = vcu * NWAVES + wave, NGW = G * NWAVES;
    unsigned char* ws = args.ws;
    gu32* ctl = (gu32*)ws;
    float* SS = (float*)(ws + WS.ssp);
    for (int i = tid; i < 64; i += NWAVES * 64) MISC[i] = 0u;
    __syncthreads();
    XcdBarrier bar; bar.bar = (unsigned*)ctl + CW_BAR; bar.x = 0; bar.st = nullptr;
#if !MK_PER_PHASE
    bar = xcd_barrier_post((unsigned*)ctl + CW_BAR, MISC + 8);
#define GRID_BAR() xcd_barrier(bar)
#else
#define GRID_BAR() do { } while (0)
#endif
    const int lo = args.ph_lo, hi = args.ph_hi;
#define IN(k) (lo <= (k) && (k) < hi)
#define BOTH(k) (IN(k) && IN((k) + 1))
    const float* x_in = (const float*)args.in[0]; const float* mem_in = (const float*)args.in[1]; const int* pos = (const int*)args.in[2];
    const float* norm_mix = (const float*)args.in[3]; const float* w_in = (const float*)args.in[4];
    const float* s5_a_re = (const float*)args.in[5]; const float* s5_a_im = (const float*)args.in[6]; const float* s5_log_dt = (const float*)args.in[7];
    const float* s5_b_re = (const float*)args.in[8]; const float* s5_b_im = (const float*)args.in[9]; const float* s5_c_re = (const float*)args.in[10]; const float* s5_c_im = (const float*)args.in[11];
    const float* s5_d = (const float*)args.in[12]; const float* s5_w_glu = (const float*)args.in[13];
    const float* q_a_norm = (const float*)args.in[14]; const float* w_q_b = (const float*)args.in[15]; const float* kv_norm = (const float*)args.in[16]; const float* w_kv_b = (const float*)args.in[17];
    const float* q_norm = (const float*)args.in[18]; const float* k_norm = (const float*)args.in[19]; const float* mla_w_o = (const float*)args.in[20];
    const float* mem_norm = (const float*)args.in[21]; const float* mem_w_kv = (const float*)args.in[22]; const float* mem_q_norm = (const float*)args.in[23]; const float* mem_k_norm = (const float*)args.in[24];
    const float* mem_w_o = (const float*)args.in[25]; const float* w_out = (const float*)args.in[26]; const float* norm_ffn = (const float*)args.in[27];
    const float* ffn_gu = (const float*)args.in[28]; const float* ffn_dn = (const float*)args.in[29]; const float* moe_router = (const float*)args.in[30]; const float* moe_rb = (const float*)args.in[31];
    const float* moe_gu = (const float*)args.in[32]; const float* moe_dn = (const float*)args.in[33];
    float* OUT = args.out;
    bf16* XB = (bf16*)(ws + WS.xb); bf16* Ub = (bf16*)(ws + WS.u); bf16* CQ = (bf16*)(ws + WS.cq); bf16* CKV = (bf16*)(ws + WS.ckv); float* KR = (float*)(ws + WS.kr);
    bf16* QM = (bf16*)(ws + WS.qm); bf16* GT = (bf16*)(ws + WS.gt); bf16* Qh = (bf16*)(ws + WS.q); bf16* Kh = (bf16*)(ws + WS.kk); bf16* Vh = (bf16*)(ws + WS.vv);
    bf16* OA = (bf16*)(ws + WS.oa); bf16* OM = (bf16*)(ws + WS.om); bf16* YS = (bf16*)(ws + WS.ys); float* ES = (float*)(ws + WS.es); float* MF = (float*)(ws + WS.mf); bf16* MB = (bf16*)(ws + WS.mb);
    bf16* ACT = (bf16*)(ws + WS.act); bf16* YM = (bf16*)(ws + WS.ym); bf16* KMEM = (bf16*)(ws + WS.kmem); bf16* VMEM = (bf16*)(ws + WS.vmem); bf16* MEMB = (bf16*)(ws + WS.memb);
    float* ROPEC = (float*)(ws + WS.ropec); float* ROPES = (float*)(ws + WS.ropes);
    int* LIST = (int*)(ws + WS.list); int* TOKE = (int*)(ws + WS.toke); int* TOKS = (int*)(ws + WS.toks); float* TOKW = (float*)(ws + WS.tokw); int* TMIN = (int*)(ws + WS.tmm); int* TMAX = TMIN + 128;
    unsigned* CNT = (unsigned*)ctl + CW_CNT;

    if (PH_ON(0) && IN(0)) {
        const int lane = fresh_tid() & 63;
        LAS float* scr = (LAS float*)(lds + wave * 16640);
        transpose_job(w_in, (size_t)DM * IN_COLS, IN_COLS, DM, (bf16*)(ws + WS.w_in[0]), (WS.w_in[1] - WS.w_in[0]) / 2, DM, INP, norm_mix, DM, 2, MapInProj{}, scr, gw, NGW, lane);
        transpose_job(s5_w_glu, (size_t)S5W * 4096, 4096, S5W, (bf16*)(ws + WS.w_glu[0]), (WS.w_glu[1] - WS.w_glu[0]) / 2, S5W, 4096, nullptr, 0, 2, MapGlu{2048}, scr, gw, NGW, lane);
        transpose_job(w_q_b, (size_t)QRANK * 3072, 3072, QRANK, (bf16*)(ws + WS.w_qb[0]), (WS.w_qb[1] - WS.w_qb[0]) / 2, 512, 4096, q_a_norm, QRANK, 2, MapQB{}, scr, gw, NGW, lane);
        transpose_job(w_kv_b, (size_t)KVRANK * 4096, 4096, KVRANK, (bf16*)(ws + WS.w_kvb[0]), (WS.w_kvb[1] - WS.w_kvb[0]) / 2, 512, 4096, kv_norm, KVRANK, 2, MapId{}, scr, gw, NGW, lane);
        transpose_job(mla_w_o, (size_t)DM * DM, DM, DM, (bf16*)(ws + WS.w_mo[0]), (WS.w_mo[1] - WS.w_mo[0]) / 2, DM, DM, nullptr, 0, 2, MapId{}, scr, gw, NGW, lane);
        transpose_job(mem_w_kv, (size_t)DM * DM, DM, DM, (bf16*)(ws + WS.w_mkv[0]), (WS.w_mkv[1] - WS.w_mkv[0]) / 2, DM, DM, mem_norm, DM, 2, MapId{}, scr, gw, NGW, lane);
        transpose_job(mem_w_o, (size_t)MEMW * DM, DM, MEMW, (bf16*)(ws + WS.w_mwo[0]), (WS.w_mwo[1] - WS.w_mwo[0]) / 2, MEMW, DM, nullptr, 0, 2, MapId{}, scr, gw, NGW, lane);
        transpose_job(w_out, (size_t)DM * DM, DM, DM, (bf16*)(ws + WS.w_out[0]), (WS.w_out[1] - WS.w_out[0]) / 2, DM, DM, nullptr, 0, 2, MapId{}, scr, gw, NGW, lane);
        transpose_job(ffn_gu, 0, 2 * DFF, DM, (bf16*)(ws + WS.w_gu), 0, DM, 2 * DFF, norm_ffn, 0, 1, MapGlu{DFF}, scr, gw, NGW, lane);
        transpose_job(ffn_dn, 0, DM, DFF, (bf16*)(ws + WS.w_dn), 0, DFF, DM, nullptr, 0, 1, MapId{}, scr, gw, NGW, lane);
        transpose_job(moe_gu, (size_t)DM * 2 * DFF, 2 * DFF, DM, (bf16*)(ws + WS.w_egu), (size_t)2 * DFF * DM, DM, 2 * DFF, norm_ffn + DM, 0, NE, MapGlu{DFF}, scr, gw, NGW, lane);
        transpose_job(moe_dn, (size_t)DFF * DM, DM, DFF, (bf16*)(ws + WS.w_edn), (size_t)DM * DFF, DFF, DM, nullptr, 0, NE, MapId{}, scr, gw, NGW, lane);
        for (int i = gw * 64 + lane; i < SEQ * 32; i += NGW * 64) { const int t = i >> 5, j = i & 31; const float inv = powf(10000.0f, -(float)(2 * j) / 64.0f); const float ang = (float)pos[t] * inv;
            ROPEC[i] = cosf(ang); ROPES[i] = sinf(ang); }
        for (int t = gw; t < 128; t += NGW) { int v = pos[64 * t + lane], mn = v, mx = v;
#pragma unroll
            for (int o_ = 1; o_ < 64; o_ <<= 1) { mn = min(mn, __shfl_xor(mn, o_)); mx = max(mx, __shfl_xor(mx, o_)); }
            if (lane == 0) { TMIN[t] = mn; TMAX[t] = mx; } }
        for (int i = gw * 64 + lane; i < 2 * S5G * S5P; i += NGW * 64) { const int l = i / (S5G * S5P), gp = i % (S5G * S5P), g = gp / S5P, p = gp % S5P;
            const float are = s5_a_re[i], aim = s5_a_im[i], dt = expf(s5_log_dt[l * S5G + g]);
            const float mag = expf(dt * are), lr = mag * cosf(dt * aim), li = mag * sinf(dt * aim);
            ((f32x2*)(ws + WS.lam[l]))[gp] = (f32x2){lr, li};
            const float den = are * are + aim * aim, nr = lr - 1.0f, ni = li, fr = (nr * are + ni * aim) / den, fi = (ni * are - nr * aim) / den;
            bf16* bbr = (bf16*)(ws + WS.bb[l]) + ((size_t)(g * 128 + p)) * 16; bf16* bbi = bbr + 64 * 16;
            const float* bre = s5_b_re + (size_t)i * S5H; const float* bim = s5_b_im + (size_t)i * S5H;
#pragma unroll
            for (int h = 0; h < S5H; ++h) { bbr[h] = (bf16)f2bf(fr * bre[h] - fi * bim[h]); bbi[h] = (bf16)f2bf(fr * bim[h] + fi * bre[h]); }
            bf16* cp = (bf16*)(ws + WS.cp[l]) + (size_t)g * 16 * 128;
#pragma unroll
            for (int h = 0; h < S5H; ++h) { const size_t ci = ((size_t)(l * S5G + g) * S5H + h) * S5P + p; cp[h * 128 + p] = (bf16)f2bf(s5_c_re[ci]); cp[h * 128 + 64 + p] = (bf16)f2bf(-s5_c_im[ci]); } }
        for (int m = gw; m < SEQ; m += NGW) { const float s = row_to_bf16(x_in + (size_t)m * DM, XB + (size_t)m * DM, false, lane); if (lane < 32) SS[SS_X + (size_t)m * 32 + lane] = lane == 0 ? s : 0.f; }
        for (int m = gw; m < NMEM; m += NGW) (void)row_to_bf16(mem_in + (size_t)m * DM, MEMB + (size_t)m * DM, true, lane);
        if (BOTH(0)) GRID_BAR();
    }

    for (int l = 0; l < DEPTH; ++l) {
        const int pb = 1 + 7 * l;
        const float* ssx_mix = SS + SS_X + (size_t)(2 * l) * SEQ * 32; float* ssx_ffn = SS + SS_X + (size_t)(2 * l + 1) * SEQ * 32;
        if (IN(pb + 0)) {
            if constexpr (PH_ON(1)) { pg8::Gemm g{XB, (const bf16*)(ws + WS.w_in[l]), DM, DM, DM}; pg8::StaticOrder S; S.init(SEQ / 256, INP / 256, G, bid);
              pg8::EpiInProj E{ssx_mix, Ub, CQ, CKV, QM, GT, KR, SS + SS_CQ + (size_t)l * SEQ * 8, SS + SS_CKV + (size_t)l * SEQ * 8, SS + SS_KR + (size_t)l * SEQ * 4, mem_q_norm + l * MEMD};
              pg8::gemm_phase(lds, g, S, E); }
            if constexpr (PH_ON(18)) if (l == 0) { pg8::Gemm g{MEMB, (const bf16*)(ws + WS.w_mkv[0]), DM, DM, DM}; pg8::MemKvOrder S{G, bid};
              pg8::EpiMemKV E{{mem_k_norm, mem_k_norm + MEMD}, KMEM, VMEM};
              pg8::gemm_phase(lds, g, S, E); }
            if (BOTH(pb + 0)) GRID_BAR();
        }
        if (IN(pb + 1)) {
            if constexpr (PH_ON(12)) { pg8::Gemm g{CQ, (const bf16*)(ws + WS.w_qb[l]), 512, 512, 512}; pg8::StaticOrder S; S.init(SEQ / 256, NH, G, bid);
              pg8::EpiQ E{SS + SS_CQ + (size_t)l * SEQ * 8, q_norm + l * DQK, ROPEC, ROPES, Qh};
              pg8::gemm_phase(lds, g, S, E); }
            if constexpr (PH_ON(13)) { pg8::Gemm g{CKV, (const bf16*)(ws + WS.w_kvb[l]), 512, 512, 512}; pg8::StaticOrder S; S.init(SEQ / 256, NH, G, bid);
              pg8::EpiKV E{SS + SS_CKV + (size_t)l * SEQ * 8, SS + SS_KR + (size_t)l * SEQ * 4, k_norm + l * DQK, KR, ROPEC, ROPES, Kh, Vh};
              pg8::gemm_phase(lds, g, S, E); }
            if constexpr (PH_ON(14)) for (int it = gw; it < S5G * 32; it += NGW)
                s5::s5_wave<1>((char*)lds_raw + wave * s5::WAVE_LDS, it >> 5, (it & 31) * 4, Ub, (const f32x2*)(ws + WS.lam[l]), (const bf16*)(ws + WS.bb[l]), (const bf16*)(ws + WS.cp[l]), s5_d + l * S5W, ES, YS, fresh_tid() & 63);
            __syncthreads();
            if constexpr (PH_ON(15)) for (int it = vcu; it < MEMH * 32 * 2; it += G) { const int h = it >> 6, qb = (it & 63) >> 1, dvh = it & 1;
                attn::attn_item<MEMD, false, MEMW, MEMD, MEMW, false>((char*)lds_raw, lds, QM + (size_t)qb * 256 * MEMW + h * MEMD, KMEM + ((size_t)l * MEMH + h) * NMEM * MEMD, VMEM + ((size_t)l * MEMH + h) * NMEM * MEMD + dvh * 128,
                                             OM + (size_t)qb * 256 * MEMW + h * MEMD + dvh * 128, nullptr, qb * 256, NMEM / 64, nullptr, nullptr); }
            if (BOTH(pb + 1)) GRID_BAR();
        }
        if (IN(pb + 2)) {
            if constexpr (PH_ON(16)) for (int it = vcu; it < NH * 16; it += G) { const int h = it >> 4, pr = it & 15;
#pragma unroll 1
                for (int pass = 0; pass < 2; ++pass) { const int qb = pass ? pr : 31 - pr;
                    attn::attn_item<DQK, true, DQK, DV, DM, true>((char*)lds_raw, lds, Qh + ((size_t)h * SEQ + qb * 256) * DQK, Kh + (size_t)h * SEQ * DQK, Vh + (size_t)h * SEQ * DV,
                                               OA + (size_t)qb * 256 * DM + h * DV, pos, qb * 256, SEQ / 64, TMIN, TMAX); } }
            if constexpr (PH_ON(17)) for (int it = gw; it < S5G * 32; it += NGW)
                s5::s5_wave<2>((char*)lds_raw + wave * s5::WAVE_LDS, it >> 5, (it & 31) * 4, Ub, (const f32x2*)(ws + WS.lam[l]), (const bf16*)(ws + WS.bb[l]), (const bf16*)(ws + WS.cp[l]), s5_d + l * S5W, ES, YS, fresh_tid() & 63);
            __syncthreads();
            if (BOTH(pb + 2)) GRID_BAR();
        }
        if (IN(pb + 3)) {
            if constexpr (PH_ON(4)) { pg8::Gemm g{OA, (const bf16*)(ws + WS.w_mo[l]), DM, DM, DM}; pg8::StaticOrder S; S.init(SEQ / 256, DM / 256, G, bid); pg8::EpiMerge<1> E{GT, MF}; pg8::gemm_phase(lds, g, S, E); }
            if constexpr (PH_ON(19)) { pg8::Gemm g{OM, (const bf16*)(ws + WS.w_mwo[l]), MEMW, MEMW, MEMW}; pg8::StaticOrder S; S.init(SEQ / 256, DM / 256, G, bid); pg8::EpiMerge<2> E{GT, MF}; pg8::gemm_phase(lds, g, S, E); }
            if constexpr (PH_ON(20)) { pg8::Gemm g{YS, (const bf16*)(ws + WS.w_glu[l]), S5W, S5W, S5W}; pg8::GluOrder S; S.init(SEQ / 256, DM / 256, G, bid); pg8::EpiGlu E{GT, MF, MB}; pg8::gemm_phase(lds, g, S, E); }
            if (BOTH(pb + 3)) GRID_BAR();
        }
        if (PH_ON(5) && IN(pb + 4)) {
            pg8::Gemm g{MB, (const bf16*)(ws + WS.w_out[l]), DM, DM, DM}; pg8::StaticOrder S; S.init(SEQ / 256, DM / 256, G, bid);
            pg8::EpiResid E{l == 0 ? x_in : OUT, OUT, XB, ssx_ffn}; pg8::gemm_phase(lds, g, S, E);
            if (BOTH(pb + 4)) GRID_BAR();
        }
        if (l == 0) {
            if (PH_ON(6) && IN(pb + 5)) {
                pg8::Gemm g{XB, (const bf16*)(ws + WS.w_gu), DM, DM, DM}; pg8::StaticOrder S; S.init(SEQ / 256, 2 * DFF / 256, G, bid);
                pg8::EpiSwiGLU<pg8::StaticOrder> E{ssx_ffn, ACT, &S, false}; pg8::gemm_phase(lds, g, S, E);
                if (BOTH(pb + 5)) GRID_BAR();
            }
            if (PH_ON(7) && IN(pb + 6)) {
                pg8::Gemm g{ACT, (const bf16*)(ws + WS.w_dn), DFF, DFF, DFF}; pg8::StaticOrder S; S.init(SEQ / 256, DM / 256, G, bid);
                pg8::EpiResid E{OUT, OUT, XB, SS + SS_X + (size_t)2 * SEQ * 32}; pg8::gemm_phase(lds, g, S, E);
                if (BOTH(pb + 6)) GRID_BAR();
            }
        } else {
            LAS int* MT = (LAS int*)(lds + MISC_OFF + 64);
#define MOE_TABLE() do { if (tid == 0) { int p = 0; for (int e = 0; e < NE; ++e) { const int c_ = (int)__hip_atomic_load(CNT + 64 * e, RLX_AGENT); MT[e] = p; MT[16 + e] = c_; p += (c_ + 255) >> 8; } MT[8] = p; } __syncthreads(); } while (0)
            if (PH_ON(8) && IN(pb + 5)) {
                const int lane = fresh_tid() & 63;
                for (int t = gw; t < SEQ; t += NGW) router_token(OUT + (size_t)t * DM, norm_ffn + DM, moe_router, moe_rb, t, CNT, LIST, TOKE, TOKS, TOKW, lane);
                if (BOTH(pb + 5)) GRID_BAR();
            }
            if (PH_ON(9) && IN(pb + 6)) {
                MOE_TABLE();
                typedef pg8::MoeOrder<true, 1> Ord;
                pg8::Gemm g{XB, (const bf16*)(ws + WS.w_egu), DM, DM, DM}; Ord S{MT, LIST, 2 * DFF / 256, G, bid, (size_t)2 * DFF * DM * 2};
                pg8::EpiSwiGLU<Ord> E{ssx_ffn, ACT, &S, true}; pg8::gemm_phase(lds, g, S, E);
                if (BOTH(pb + 6)) GRID_BAR();
            }
            if (PH_ON(10) && IN(pb + 7)) {
                MOE_TABLE();
                typedef pg8::MoeOrder<false, KSPLIT> Ord;
                pg8::Gemm g{ACT, (const bf16*)(ws + WS.w_edn), DFF, DFF, DFF / KSPLIT}; Ord S{MT, LIST, DM / 256, G, bid, (size_t)DM * DFF * 2};
                pg8::EpiMoeDown E{YM}; pg8::gemm_phase(lds, g, S, E);
                if (BOTH(pb + 7)) GRID_BAR();
            }
            if (PH_ON(11) && IN(pb + 8)) {
                MOE_TABLE();
                const int lane = fresh_tid() & 63;
                for (int t = gw; t < SEQ; t += NGW) {
                    const int e1 = TOKE[2 * t], e2 = TOKE[2 * t + 1]; const size_t r1 = (size_t)MT[e1] * 256 + TOKS[2 * t], r2 = (size_t)MT[e2] * 256 + TOKS[2 * t + 1];
                    const float w1 = TOKW[2 * t], w2 = TOKW[2 * t + 1];
#pragma unroll
                    for (int j = 0; j < 4; ++j) { const int c = 512 * j + 8 * lane; float* op = OUT + (size_t)t * DM + c; f32x4 a = *(const f32x4*)op, b = *(const f32x4*)(op + 4);
#pragma unroll
                        for (int ks = 0; ks < KSPLIT; ++ks) { const u32x4 y1 = *(const u32x4*)(YM + ((size_t)ks * ACT_ROWS + r1) * DM + c), y2 = *(const u32x4*)(YM + ((size_t)ks * ACT_ROWS + r2) * DM + c);
                            a[0] += w1 * bflo(y1.x) + w2 * bflo(y2.x); a[1] += w1 * bfhi(y1.x) + w2 * bfhi(y2.x); a[2] += w1 * bflo(y1.y) + w2 * bflo(y2.y); a[3] += w1 * bfhi(y1.y) + w2 * bfhi(y2.y);
                            b[0] += w1 * bflo(y1.z) + w2 * bflo(y2.z); b[1] += w1 * bfhi(y1.z) + w2 * bfhi(y2.z); b[2] += w1 * bflo(y1.w) + w2 * bflo(y2.w); b[3] += w1 * bfhi(y1.w) + w2 * bfhi(y2.w); }
                        *(f32x4*)op = a; *(f32x4*)(op + 4) = b; } }
            }
        }
    }
#undef IN
#undef BOTH
}

extern "C" void kernel_launch(void* const* d_in, const int* in_sizes, int n_in, void* d_out, int out_size, void* d_ws, size_t ws_size, hipStream_t stream) {
    static int grid = 0;
    if (grid == 0) {
        if (n_in != 34 || in_sizes[0] != SEQ * DM || out_size != SEQ * DM || ws_size < WS.end) {
            fprintf(stderr, "kernel_launch: shape mismatch: n_in %d in0 %d out %d ws %zu (need %zu)\n", n_in, n_in > 0 ? in_sizes[0] : -1, out_size, ws_size, (size_t)WS.end); grid = -1; return; }
        int dev = 0, cus = 0;
        if (hipGetDevice(&dev) != hipSuccess || hipDeviceGetAttribute(&cus, hipDeviceAttributeMultiprocessorCount, dev) != hipSuccess) { grid = -1; return; }
        if (hipFuncSetAttribute((const void*)fwd, hipFuncAttributeMaxDynamicSharedMemorySize, LDS_BYTES) != hipSuccess) { fprintf(stderr, "kernel_launch: hipFuncSetAttribute failed\n"); grid = -1; return; }
        int per_cu = 0;
        if (hipOccupancyMaxActiveBlocksPerMultiprocessor(&per_cu, (const void*)fwd, NWAVES * 64, LDS_BYTES) != hipSuccess || per_cu < 1) fprintf(stderr, "kernel_launch: occupancy query says %d\n", per_cu);
        (void)hipGetLastError();
        grid = cus;
    }
    if (grid < 0) return;
    (void)hipMemsetAsync(d_ws, 0, CTL_BYTES, stream);
    Args a{};
    for (int i = 0; i < 34; ++i) a.in[i] = d_in[i];
    a.out = (float*)d_out; a.ws = (unsigned char*)d_ws;
#if MK_PER_PHASE
#if MK_CHECK == 2
    (void)hipMemsetAsync((unsigned char*)d_ws + WS.end, 0, 4096, stream);
    for (int pass = 0; pass < 2; ++pass) {
        if (pass) (void)hipMemsetAsync(d_ws, 0, CTL_BYTES, stream);
        for (int p = 0; p < NPH; ++p) { a.ph_lo = p; a.ph_hi = p + 1; hipLaunchKernelGGL(fwd, dim3(grid), dim3(NWAVES * 64), LDS_BYTES, stream, a); diff_after_phase(pass, p, a, ws_size, stream); }
    }
    hipLaunchKernelGGL(diff_final, dim3(1024), dim3(256), 0, stream, (const float*)((unsigned char*)d_ws + WS.end), (float*)d_out);
#else
    for (int p = 0; p < NPH; ++p) { a.ph_lo = p; a.ph_hi = p + 1;
#if MK_CHECK == 1
        launch_checks_pre(p, a, stream);
#endif
        hipLaunchKernelGGL(fwd, dim3(grid), dim3(NWAVES * 64), LDS_BYTES, stream, a);
#if MK_CHECK == 1
        launch_checks(p, a, stream);
#endif
    }
#if MK_CHECK == 1
    launch_check_final(a, stream);
#endif
#endif
#else
    a.ph_lo = 0; a.ph_hi = NPH; hipLaunchKernelGGL(fwd, dim3(grid), dim3(NWAVES * 64), LDS_BYTES, stream, a);
#endif
    const hipError_t le = hipPeekAtLastError();
    if (le != hipSuccess) fprintf(stderr, "kernel_launch: launch failed: %s\n", hipGetErrorName(le));
}
```

```cpp
#include <hip/hip_runtime.h>
#include <cstdio>
#include <cstdint>

#ifndef MK_PER_PHASE
#define MK_PER_PHASE 0
#endif
#ifndef MK_CHECK
#define MK_CHECK 0
#endif

constexpr int SEQ = 8192, DM = 2048, DEPTH = 2, NMEM = 256;
constexpr int S5W = 1024, S5G = 64, S5H = 16, S5P = 64;
constexpr int NH = 16, QRANK = 448, KVRANK = 512, DNOPE = 128, DROPE = 64, DQK = 192, DV = 128;
constexpr int MEMH = 4, MEMD = 256, MEMW = 1024;
constexpr int DFF = 7168, NE = 8;
constexpr int INP = 9472;
constexpr int IN_COLS = 9216;
constexpr float EPS = 1e-6f;
constexpr float LOG2E = 1.4426950408889634f;
constexpr int ACT_ROWS = 2 * SEQ + NE * 256;
constexpr int KSPLIT = 2;

typedef unsigned short bf16;
typedef short bf16x8 __attribute__((ext_vector_type(8)));
typedef short s16x4 __attribute__((ext_vector_type(4)));
typedef float f32x4 __attribute__((ext_vector_type(4)));
typedef float f32x2 __attribute__((ext_vector_type(2)));
typedef float f32x16 __attribute__((ext_vector_type(16)));
typedef unsigned u32x4 __attribute__((ext_vector_type(4)));
typedef unsigned u32x2 __attribute__((ext_vector_type(2)));
#define GAS __attribute__((address_space(1)))
#define LAS __attribute__((address_space(3)))
typedef GAS unsigned gu32;
#define RLX_AGENT __ATOMIC_RELAXED, __HIP_MEMORY_SCOPE_AGENT
#define LDS_WAIT() asm volatile("s_waitcnt lgkmcnt(0)" ::: "memory")
#define VM_WAIT() asm volatile("s_waitcnt vmcnt(0)" ::: "memory")
#define SBAR() __builtin_amdgcn_sched_barrier(0)

typedef __bf16 bf16x2_t __attribute__((ext_vector_type(2)));
__device__ __forceinline__ unsigned cvt_pk_bf16(float lo, float hi) { f32x2 v = {lo, hi}; bf16x2_t b = __builtin_convertvector(v, bf16x2_t); return __builtin_bit_cast(unsigned, b); }
__device__ __forceinline__ unsigned f2bf(float f) { unsigned u = __builtin_bit_cast(unsigned, f); return (u + 0x7fffu + ((u >> 16) & 1u)) >> 16; }
__device__ __forceinline__ unsigned pk2(float lo, float hi) { return f2bf(lo) | (f2bf(hi) << 16); }
__device__ __forceinline__ float bf2f(unsigned short b) { return __builtin_bit_cast(float, ((unsigned)b) << 16); }
__device__ __forceinline__ float bflo(unsigned w) { return __builtin_bit_cast(float, w << 16); }
__device__ __forceinline__ float bfhi(unsigned w) { return __builtin_bit_cast(float, w & 0xffff0000u); }
__device__ __forceinline__ float sigmoidf_(float x) { return __builtin_amdgcn_rcpf(1.f + __builtin_amdgcn_exp2f(-x * LOG2E)); }
__device__ __forceinline__ int fresh_tid() { int t = threadIdx.x; asm volatile("" : "+v"(t)); return t; }
template <int N> __device__ __forceinline__ float sum_slots(const float* p) { f32x4 a = *(const f32x4*)p;
#pragma unroll
    for (int i = 1; i < N / 4; ++i) a = a + *(const f32x4*)(p + 4 * i);
    return (a[0] + a[1]) + (a[2] + a[3]); }
__device__ __forceinline__ float wave_sum(float v) {
#pragma unroll
    for (int o = 1; o < 64; o <<= 1) v += __shfl_xor(v, o);
    return v;
}

constexpr size_t al256(size_t x) { return (x + 255) & ~(size_t)255; }
constexpr size_t CTL_BYTES = 2u << 20;
constexpr int CW_TMO = 0, CW_CODE = 1;
constexpr int CW_BAR = 4096;
constexpr int CW_CNT = 8192;
constexpr int CW_CHK = 12288;
constexpr int SS_X = 0;
constexpr int SS_CQ = 4 * SEQ * 32;
constexpr int SS_CKV = SS_CQ + 2 * SEQ * 8;
constexpr int SS_KR = SS_CKV + 2 * SEQ * 8;
constexpr int SS_FLOATS = SS_KR + 2 * SEQ * 4;

struct WsMap {
    size_t w_in[2], w_glu[2], w_qb[2], w_kvb[2], w_mo[2], w_mkv[2], w_mwo[2], w_out[2], w_gu, w_dn, w_egu, w_edn;
    size_t xb, u, cq, ckv, kr, qm, gt, q, kk, vv, oa, om, ys, es, mf, mb, act, ym, kmem, vmem, memb, ropec, ropes;
    size_t lam[2], bb[2], cp[2], list, toke, toks, tokw, tmm, ssp, end;
};
constexpr WsMap make_map() {
    WsMap m{}; size_t o = CTL_BYTES;
    auto take = [&](size_t bytes) { size_t r = o; o = al256(o + bytes); return r; };
    for (int l = 0; l < 2; ++l) {
        m.w_in[l] = take((size_t)INP * DM * 2); m.w_glu[l] = take((size_t)4096 * S5W * 2); m.w_qb[l] = take((size_t)4096 * 512 * 2); m.w_kvb[l] = take((size_t)4096 * 512 * 2);
        m.w_mo[l] = take((size_t)DM * DM * 2); m.w_mkv[l] = take((size_t)DM * DM * 2); m.w_mwo[l] = take((size_t)DM * MEMW * 2); m.w_out[l] = take((size_t)DM * DM * 2);
        m.lam[l] = take((size_t)S5G * S5P * 8); m.bb[l] = take((size_t)S5G * 128 * 16 * 2); m.cp[l] = take((size_t)S5G * 16 * 128 * 2);
    }
    m.w_gu = take((size_t)2 * DFF * DM * 2); m.w_dn = take((size_t)DM * DFF * 2);
    m.w_egu = take((size_t)NE * 2 * DFF * DM * 2); m.w_edn = take((size_t)NE * DM * DFF * 2);
    m.xb = take((size_t)SEQ * DM * 2); m.u = take((size_t)SEQ * S5W * 2); m.cq = take((size_t)SEQ * 512 * 2); m.ckv = take((size_t)SEQ * 512 * 2);
    m.kr = take((size_t)SEQ * 64 * 4); m.qm = take((size_t)SEQ * MEMW * 2); m.gt = take((size_t)SEQ * 3 * DM * 2);
    m.q = take((size_t)NH * SEQ * DQK * 2); m.kk = take((size_t)NH * SEQ * DQK * 2); m.vv = take((size_t)NH * SEQ * DV * 2);
    m.oa = take((size_t)SEQ * DM * 2); m.om = take((size_t)SEQ * MEMW * 2); m.ys = take((size_t)SEQ * S5W * 2); m.es = take((size_t)S5G * 128 * 128 * 4);
    m.mf = take((size_t)SEQ * DM * 4); m.mb = take((size_t)SEQ * DM * 2);
    m.act = take((size_t)ACT_ROWS * DFF * 2); m.ym = take((size_t)KSPLIT * ACT_ROWS * DM * 2);
    m.kmem = take((size_t)2 * MEMH * NMEM * MEMD * 2); m.vmem = take((size_t)2 * MEMH * NMEM * MEMD * 2); m.memb = take((size_t)NMEM * DM * 2);
    m.ropec = take((size_t)SEQ * 32 * 4); m.ropes = take((size_t)SEQ * 32 * 4);
    m.list = take((size_t)NE * SEQ * 4); m.toke = take((size_t)SEQ * 2 * 4); m.toks = take((size_t)SEQ * 2 * 4); m.tokw = take((size_t)SEQ * 2 * 4); m.tmm = take(2 * 128 * 4); m.ssp = take((size_t)SS_FLOATS * 4);
    m.end = o; return m;
}
constexpr WsMap WS = make_map();

constexpr int RING_BYTES = 131072;
constexpr int XT_OFF = RING_BYTES;
constexpr int RK_OFF = XT_OFF + 4096;
constexpr int MISC_OFF = RK_OFF + 1024;
constexpr int LDS_BYTES = 147456;
static_assert(MISC_OFF + 256 <= LDS_BYTES, "LDS map");

#define XB_TMO      128
#define XB_XCNT(j)  (256  + 64 * (j))
#define XB_XSUB(j)  (1280 + 64 * (j))
#define XB_XGEN(j)  (2304 + 64 * (j))
#define XB_TOP      3328
#define XB_TOPGEN   3392
#define XCD_BAR_WORDS 3456
#define XB_SPIN_CAP (1u << 18)
__device__ __forceinline__ unsigned xb_ld(unsigned* p)              { return __hip_atomic_load(p, __ATOMIC_RELAXED, __HIP_MEMORY_SCOPE_AGENT); }
__device__ __forceinline__ unsigned xb_add(unsigned* p, unsigned v) { return __hip_atomic_fetch_add(p, v, __ATOMIC_RELAXED, __HIP_MEMORY_SCOPE_AGENT); }
__device__ __forceinline__ unsigned xb_xcc_id() { return (unsigned)__builtin_amdgcn_s_getreg((3 << 11) | 20) & 0xFu; }
#define XB_SPIN(cond, bar) do { unsigned _sp = 0; while (cond) { __builtin_amdgcn_s_sleep(1); \
    if ((++_sp & 255u) == 0u) { if (xb_ld(&(bar)[XB_TMO])) break; if (_sp > XB_SPIN_CAP) { atomicAdd(&(bar)[XB_TMO], 1u); break; } } } } while (0)
struct XcdBarrier { unsigned* bar; unsigned x; volatile LAS unsigned* st; };
__device__ __forceinline__ XcdBarrier xcd_barrier_post(unsigned* bar, volatile LAS unsigned* st) {
    XcdBarrier b; b.bar = bar; b.x = xb_xcc_id(); b.st = st;
    if (threadIdx.x == 0) (void)xb_add(&bar[XB_XCNT(b.x)], 1u);
    return b;
}
__device__ __forceinline__ void xcd_barrier_complete(unsigned* bar, unsigned x, unsigned& nloc, unsigned& nx) {
    const unsigned G = gridDim.x * gridDim.y * gridDim.z;
    unsigned sum, cnt, mine, sp = 0u;
    for (;;) {
        sum = 0u; cnt = 0u; mine = 0u;
#pragma unroll
        for (unsigned j = 0; j < 16; ++j) { const unsigned c = xb_ld(&bar[XB_XCNT(j)]); sum += c; cnt += (c > 0u) ? 1u : 0u; mine = (j == x) ? c : mine; }
        if (sum == G) break;
        __builtin_amdgcn_s_sleep(1);
        if ((++sp & 255u) == 0u) { if (xb_ld(&bar[XB_TMO])) break; if (sp > XB_SPIN_CAP) { atomicAdd(&bar[XB_TMO], 1u); break; } }
    }
    nloc = mine > 0u ? mine : 1u; nx = cnt > 0u ? cnt : 1u;
}
__device__ __forceinline__ void xcd_barrier(const XcdBarrier& b) {
    asm volatile("s_waitcnt vmcnt(0)" ::: "memory");
    __syncthreads();
    if (threadIdx.x == 0) {
        unsigned* bar = b.bar;
        __builtin_amdgcn_s_waitcnt(0);
        unsigned nloc = b.st[0], nx = b.st[1];
        if (nloc == 0u) { xcd_barrier_complete(bar, b.x, nloc, nx); b.st[0] = nloc; b.st[1] = nx; }
        const unsigned old = xb_add(&bar[XB_XSUB(b.x)], 1u);
        const unsigned gen = old / nloc;
        if (old + 1u == (gen + 1u) * nloc) {
            __builtin_amdgcn_fence(__ATOMIC_RELEASE, "agent");
            asm volatile("s_waitcnt vmcnt(0)" ::: "memory");
            const unsigned og = xb_add(&bar[XB_TOP], 1u);
            const unsigned tg = og / nx;
            if (og + 1u == (tg + 1u) * nx) xb_add(&bar[XB_TOPGEN], 1u);
            else XB_SPIN(xb_ld(&bar[XB_TOPGEN]) == tg, bar);
            __builtin_amdgcn_fence(__ATOMIC_ACQUIRE, "agent");
            xb_add(&bar[XB_XGEN(b.x)], 1u);
            asm volatile("s_waitcnt vmcnt(0)" ::: "memory");
        } else {
            XB_SPIN(xb_ld(&bar[XB_XGEN(b.x)]) == gen, bar);
            __builtin_amdgcn_fence(__ATOMIC_ACQUIRE, "agent");
            asm volatile("s_waitcnt vmcnt(0)" ::: "memory");
        }
    }
    __syncthreads();
}
namespace pg8 {
constexpr int BM = 256, BK = 64, HALF = 128, HTB = HALF * BK * 2, STAGE_BYTES = 8 * HTB, NXCD = 8, WGM = 8;
__host__ __device__ __forceinline__ int lds_byte(int r, int c) { const int st = (r >> 4) * 2 + (c >> 5), rr = r & 15, cc = c & 31, ob = rr * 64 + cc * 2; return st * 1024 + (ob ^ (((ob >> 9) & 1) << 5)); }
__host__ __device__ __forceinline__ void stage_rc(int b, int& R, int& C) { const int st = b / 1024, sb = b % 1024, swz = sb ^ (((sb >> 9) & 1) << 5); R = (st >> 1) * 16 + swz / 64; C = (st & 1) * 32 + (swz % 64) / 2; }
__host__ __device__ __forceinline__ int perm32(int rho) { const int n = rho >> 4, i = rho & 15; return 8 * (i >> 2) + 4 * n + (i & 3); }

struct Unit { int pm, pn, e, ks, p0, cnt; };
struct Gemm { const bf16* A; const bf16* Bt; int lda, ldb, K; };

__device__ __forceinline__ bool static_unit(int L, int nM, int nN, Unit& u) {
    const int nwg = nM * nN; if (L >= nwg) return false;
    int wgid = L; { const int q = nwg / NXCD, r = nwg % NXCD, xcd = wgid % NXCD, off = wgid / NXCD; wgid = (xcd < r ? xcd * (q + 1) : r * (q + 1) + (xcd - r) * q) + off; }
    const int nig = WGM * nN, gid = wgid / nig, fm = gid * WGM, gsz = (nM - fm) < WGM ? (nM - fm) : WGM;
    u.pm = fm + ((wgid % nig) % gsz); u.pn = (wgid % nig) / gsz; return true;
}
struct StaticOrder {
    static constexpr bool GATHER = false;
    int nM, nN, G, c;
    __device__ void init(int nM_, int nN_, int G_, int c_) { nM = nM_; nN = nN_; G = G_; c = c_; }
    __device__ bool next(int i, Unit& u) const { u.e = 0; u.ks = 0; u.p0 = 0; u.cnt = 0; return static_unit(i * G + c, nM, nN, u); }
    __device__ __forceinline__ const char* abase(const Gemm& g, const Unit& u) const { return (const char*)g.A + (size_t)u.pm * BM * g.lda * 2; }
    __device__ __forceinline__ const char* bbase(const Gemm& g, const Unit& u) const { return (const char*)g.Bt + (size_t)u.pn * BM * g.ldb * 2; }
    __device__ __forceinline__ unsigned tok(const Unit&, int) const { return 0u; }
};
struct GluOrder : StaticOrder {
    __device__ bool next(int i, Unit& u) const { u.e = 0; u.ks = 0; u.p0 = 0; u.cnt = 0; if (!static_unit((i >> 1) * G + c, nM, nN, u)) return false; u.pn = 2 * u.pn + (i & 1); return true; }
};
struct MemKvOrder {
    static constexpr bool GATHER = false;
    int G, c;
    __device__ bool next(int i, Unit& u) const { const int L = i * G + c; if (L >= 16) return false; u.pm = 0; u.pn = L & 7; u.e = L >> 3; u.ks = 0; u.p0 = 0; u.cnt = 0; return true; }
    __device__ __forceinline__ const char* abase(const Gemm& g, const Unit&) const { return (const char*)g.A; }
    __device__ __forceinline__ const char* bbase(const Gemm& g, const Unit& u) const { return (const char*)g.Bt + ((size_t)u.e * (WS.w_mkv[1] - WS.w_mkv[0])) + (size_t)u.pn * BM * g.ldb * 2; }
    __device__ __forceinline__ unsigned tok(const Unit&, int) const { return 0u; }
};
template <bool GATHER_, int NKS> struct MoeOrder {
    static constexpr bool GATHER = GATHER_;
    const LAS int* tab; const int* list; int nN, G, c; size_t bstride;
    __device__ bool next(int i, Unit& u) const {
        const int P = tab[8]; int L = i * G + c; if (L >= P * nN * NKS) return false;
        u.ks = L % NKS; L /= NKS;
        static_unit(L, P, nN, u);
        int e = 0;
#pragma unroll
        for (int j = 1; j < 8; ++j) e += (u.pm >= tab[j]) ? 1 : 0;
        u.e = e; u.p0 = tab[e]; u.cnt = tab[16 + e]; return true;
    }
    __device__ __forceinline__ const char* abase(const Gemm& g, const Unit& u) const { return GATHER_ ? (const char*)g.A : (const char*)g.A + ((size_t)u.pm * BM * g.lda + (size_t)u.ks * g.K) * 2; }
    __device__ __forceinline__ const char* bbase(const Gemm& g, const Unit& u) const { return (const char*)g.Bt + (size_t)u.e * bstride + ((size_t)u.pn * BM * g.ldb + (size_t)u.ks * g.K) * 2; }
    __device__ __forceinline__ unsigned tok(const Unit& u, int r) const { const int slot = (u.pm - u.p0) * BM + r; return slot < u.cnt ? (unsigned)list[u.e * SEQ + slot] : 0u; }
};

typedef f32x4 Acc[2][2][4][2];

template <class Epi, class Sched>
__device__ __forceinline__ void gemm_phase(LAS unsigned char* lds, const Gemm g, const Sched& S, const Epi& E) {
    const int tid = fresh_tid(), wid = __builtin_amdgcn_readfirstlane(tid >> 6), lane = tid & 63, wr = wid >> 2, wc = wid & 3, fr = lane & 15, fq = lane >> 4;
    const int K = g.K, nt = K / BK;
    unsigned voffA[2], voffB[2]; int RA[2], CA[2];
#pragma unroll
    for (int i = 0; i < 2; ++i) { int R, C; stage_rc(tid * 16 + i * 8192, R, C); const int Rb = Epi::PERM ? ((R & ~31) + perm32(R & 31)) : R;
        RA[i] = R; CA[i] = C; voffA[i] = (unsigned)(R * g.lda + C) * 2u; voffB[i] = (unsigned)(Rb * g.ldb + C) * 2u; }
    const size_t kstep = (size_t)(BK * 2);
    const size_t hstepA = (size_t)HALF * g.lda * 2, hstepB = (size_t)HALF * g.ldb * 2;
    const unsigned ldsw = (unsigned)wid * 1024u;
    const int aoff = lds_byte(wr * 64 + fr, fq * 8), boff = lds_byte(wc * 32 + fr, fq * 8);
    const char* const gA = (const char*)g.A;
#define PG8_SA(b, h) (((b) * 2 + (h)) * HTB)
#define PG8_SB(b, h) ((4 + (b) * 2 + (h)) * HTB)
#define PG8_STAGE(bufoff, gbase, voff) do { _Pragma("unroll") for (int _i = 0; _i < 2; ++_i) \
        __builtin_amdgcn_global_load_lds((const unsigned*)((const char*)(gbase) + (voff)[_i]), (LAS unsigned*)(lds + (bufoff) + ldsw + _i * 8192), 16, 0, 0); } while (0)
#define PG8_STA1(bufoff, h) do { if constexpr (Sched::GATHER) PG8_STAGE(bufoff, gA + ka1, vc[h]); else PG8_STAGE(bufoff, a1 + (h) * hstepA, voffA); } while (0)
#define PG8_STA2(bufoff, h) do { if constexpr (Sched::GATHER) PG8_STAGE(bufoff, gA + ka2, w2[h]); else PG8_STAGE(bufoff, a2 + (h) * hstepA, voffA); } while (0)
#define PG8_STA3(bufoff, h) do { if constexpr (Sched::GATHER) PG8_STAGE(bufoff, gA + ka2 + kstep, w2[h]); else PG8_STAGE(bufoff, a3 + (h) * hstepA, voffA); } while (0)
#define PG8_LDA(dst, b, h) do { _Pragma("unroll") for (int m = 0; m < 4; ++m) _Pragma("unroll") for (int k = 0; k < 2; ++k) dst[m][k] = *(const LAS bf16x8*)(lds + PG8_SA(b, h) + aoff + m * 2048 + k * 1024); } while (0)
#define PG8_LDB(dst, b, h) do { _Pragma("unroll") for (int n = 0; n < 2; ++n) _Pragma("unroll") for (int k = 0; k < 2; ++k) dst[n][k] = *(const LAS bf16x8*)(lds + PG8_SB(b, h) + boff + n * 2048 + k * 1024); } while (0)
#define PG8_MMA(ai, bj, At, Bt) do { __builtin_amdgcn_s_setprio(1); _Pragma("unroll") for (int m = 0; m < 4; ++m) _Pragma("unroll") for (int n = 0; n < 2; ++n) _Pragma("unroll") for (int k = 0; k < 2; ++k) \
        acc[ai][bj][m][n] = __builtin_amdgcn_mfma_f32_16x16x32_bf16(Bt[n][k], At[m][k], acc[ai][bj][m][n], 0, 0, 0); __builtin_amdgcn_s_setprio(0); } while (0)
#define PG8_WAIT_V(n) asm volatile("s_waitcnt vmcnt(" #n ")" ::: "memory")
#define PG8_WAIT_L(n) asm volatile("s_waitcnt lgkmcnt(" #n ")" ::: "memory")
#define PG8_BAR __builtin_amdgcn_s_barrier()
#define PG8_SCHED __builtin_amdgcn_sched_barrier(0)
#define PG8_GOFF(dst, u) do { _Pragma("unroll") for (int _h = 0; _h < 2; ++_h) _Pragma("unroll") for (int _i = 0; _i < 2; ++_i) \
        dst[_h][_i] = S.tok(u, _h * HALF + RA[_i]) * (unsigned)(g.lda * 2) + (unsigned)(CA[_i] * 2); } while (0)
    Unit cur, nxt; int ui = 0;
    if (!S.next(0, cur)) return;
    Acc acc;
#pragma unroll
    for (int a = 0; a < 2; ++a)
#pragma unroll
        for (int b = 0; b < 2; ++b)
#pragma unroll
            for (int m = 0; m < 4; ++m)
#pragma unroll
                for (int n = 0; n < 2; ++n) acc[a][b][m][n] = (f32x4){0.f, 0.f, 0.f, 0.f};
    bf16x8 At[4][2], B0[2][2], B1[2][2];
    const char* cA = S.abase(g, cur); const char* cB = S.bbase(g, cur);
    unsigned vc[2][2] = {{0u, 0u}, {0u, 0u}}, vn[2][2] = {{0u, 0u}, {0u, 0u}};
    if constexpr (Sched::GATHER) PG8_GOFF(vc, cur);
    {
        const char* a1 = cA; const size_t ka1 = 0;
        PG8_STAGE(PG8_SB(0, 0), cB, voffB); PG8_STAGE(PG8_SB(0, 1), cB + hstepB, voffB); PG8_STA1(PG8_SA(0, 0), 0); PG8_STA1(PG8_SA(0, 1), 1);
        if (wr == 1) PG8_BAR;
        PG8_WAIT_V(2); PG8_BAR;
    }
    {
        const char* a1 = cA + kstep; const size_t ka1 = kstep;
        PG8_STAGE(PG8_SB(1, 0), cB + kstep, voffB); PG8_STA1(PG8_SA(1, 0), 0); PG8_STAGE(PG8_SB(1, 1), cB + hstepB + kstep, voffB);
        PG8_WAIT_V(6); PG8_BAR;
    }
    for (;;) {
        const bool has_next = S.next(ui + 1, nxt);
        const char* nA = has_next ? S.abase(g, nxt) : cA; const char* nB = has_next ? S.bbase(g, nxt) : cB;
        if constexpr (Sched::GATHER) { if (has_next) PG8_GOFF(vn, nxt); else {
#pragma unroll
            for (int _h = 0; _h < 2; ++_h) { vn[_h][0] = vc[_h][0]; vn[_h][1] = vc[_h][1]; } } }
        for (int t = 0; t < nt; t += 2) {
            const bool last = (t == nt - 2);
            const char* a1 = cA + (size_t)(t + 1) * kstep; const size_t ka1 = (size_t)(t + 1) * kstep;
            const char* a2 = last ? nA : cA + (size_t)(t + 2) * kstep; const char* b2 = last ? nB : cB + (size_t)(t + 2) * kstep;
            const size_t ka2 = last ? (size_t)0 : (size_t)(t + 2) * kstep;
            const char* a3 = a2 + kstep; const char* b3 = b2 + kstep;
            unsigned w2[2][2];
#pragma unroll
            for (int _h = 0; _h < 2; ++_h) { w2[_h][0] = last ? vn[_h][0] : vc[_h][0]; w2[_h][1] = last ? vn[_h][1] : vc[_h][1]; }
            PG8_LDB(B0, 0, 0); PG8_LDB(B1, 0, 1); PG8_SCHED; PG8_LDA(At, 0, 0); PG8_STA1(PG8_SA(1, 1), 1);
            PG8_WAIT_V(8); PG8_WAIT_L(0); PG8_BAR; PG8_MMA(0, 0, At, B0); PG8_MMA(0, 1, At, B1); PG8_BAR; PG8_SCHED;
            PG8_LDA(At, 0, 1); PG8_STAGE(PG8_SB(0, 0), b2, voffB); PG8_STAGE(PG8_SB(0, 1), b2 + hstepB, voffB); PG8_STA2(PG8_SA(0, 0), 0);
            PG8_WAIT_V(8); PG8_WAIT_L(0); PG8_BAR; PG8_MMA(1, 0, At, B0); PG8_MMA(1, 1, At, B1); PG8_BAR; PG8_SCHED;
            PG8_LDB(B0, 1, 0); PG8_LDB(B1, 1, 1); PG8_SCHED; PG8_LDA(At, 1, 0); PG8_STA2(PG8_SA(0, 1), 1);
            PG8_WAIT_V(8); PG8_WAIT_L(0); PG8_BAR; PG8_MMA(0, 0, At, B0); PG8_MMA(0, 1, At, B1); PG8_BAR; PG8_SCHED;
            PG8_LDA(At, 1, 1); PG8_STAGE(PG8_SB(1, 0), b3, voffB); PG8_STAGE(PG8_SB(1, 1), b3 + hstepB, voffB); PG8_STA3(PG8_SA(1, 0), 0);
            PG8_WAIT_V(8); PG8_WAIT_L(0); PG8_BAR; PG8_MMA(1, 0, At, B0); PG8_MMA(1, 1, At, B1); PG8_BAR; PG8_SCHED;
        }
        if (wr == 0) PG8_BAR;
        E(acc, cur, wr, wc, fr, fq, lds, tid);
        if (!has_next) break;
#pragma unroll
        for (int a = 0; a < 2; ++a)
#pragma unroll
            for (int b = 0; b < 2; ++b)
#pragma unroll
                for (int m = 0; m < 4; ++m)
#pragma unroll
                    for (int n = 0; n < 2; ++n) acc[a][b][m][n] = (f32x4){0.f, 0.f, 0.f, 0.f};
        cur = nxt; cA = nA; cB = nB; ++ui;
#pragma unroll
        for (int _h = 0; _h < 2; ++_h) { vc[_h][0] = vn[_h][0]; vc[_h][1] = vn[_h][1]; }
        if (wr == 1) PG8_BAR;
    }
    PG8_WAIT_V(0);
    PG8_BAR;
#undef PG8_SA
#undef PG8_SB
#undef PG8_STAGE
#undef PG8_STA1
#undef PG8_STA2
#undef PG8_STA3
#undef PG8_LDA
#undef PG8_LDB
#undef PG8_MMA
#undef PG8_WAIT_V
#undef PG8_WAIT_L
#undef PG8_BAR
#undef PG8_SCHED
#undef PG8_GOFF
}

#define EPI_BAR() do { asm volatile("s_waitcnt lgkmcnt(0)" ::: "memory"); __builtin_amdgcn_s_barrier(); asm volatile("" ::: "memory"); } while (0)
__device__ __forceinline__ void rows_allreduce(float (&part)[2][4], LAS unsigned char* lds, int wr, int wc, int fr, int fq) {
    LAS float* XT = (LAS float*)(lds + XT_OFF);
#pragma unroll
    for (int ai = 0; ai < 2; ++ai)
#pragma unroll
        for (int m = 0; m < 4; ++m) { float s = part[ai][m]; s += __shfl_xor(s, 16); s += __shfl_xor(s, 32);
            if (fq == 0) XT[(ai * HALF + wr * 64 + m * 16 + fr) * 4 + wc] = s; }
    EPI_BAR();
#pragma unroll
    for (int ai = 0; ai < 2; ++ai)
#pragma unroll
        for (int m = 0; m < 4; ++m) { const f32x4 v = *(const LAS f32x4*)(XT + (ai * HALF + wr * 64 + m * 16 + fr) * 4); part[ai][m] = (v[0] + v[1]) + (v[2] + v[3]); }
}
template <int NS> __device__ __forceinline__ void rows_slots(float (&part)[2][4], float* ssp, int row0, int fq, int slot) {
#pragma unroll
    for (int ai = 0; ai < 2; ++ai)
#pragma unroll
        for (int m = 0; m < 4; ++m) { float s = part[ai][m]; s += __shfl_xor(s, 16); s += __shfl_xor(s, 32);
            if (fq == 0) ssp[(size_t)(row0 + ai * HALF + m * 16) * NS + slot] = s; }
}
__device__ __forceinline__ float sq4(f32x4 v) { return (v[0] * v[0] + v[1] * v[1]) + (v[2] * v[2] + v[3] * v[3]); }
__device__ __forceinline__ u32x4 pack8(f32x4 a, f32x4 b) { u32x4 w; w.x = cvt_pk_bf16(a[0], a[1]); w.y = cvt_pk_bf16(a[2], a[3]); w.z = cvt_pk_bf16(b[0], b[1]); w.w = cvt_pk_bf16(b[2], b[3]); return w; }
__device__ __forceinline__ u32x2 pack4(f32x4 a) { u32x2 w; w.x = cvt_pk_bf16(a[0], a[1]); w.y = cvt_pk_bf16(a[2], a[3]); return w; }
__device__ __forceinline__ f32x4 unpack4(u32x2 w) { return (f32x4){bflo(w.x), bfhi(w.x), bflo(w.y), bfhi(w.y)}; }

struct EpiInProj {
    static constexpr bool PERM = true;
    const float* ssx; bf16 *U, *CQ, *CKV, *QM, *GT; float* KR; float *ss_cq, *ss_ckv, *ss_kr; const float* qm_gain;
    __device__ __forceinline__ void operator()(Acc& acc, const Unit& u, int wr, int wc, int fr, int fq, LAS unsigned char* lds, int tid) const {
        asm volatile("" : "+v"(fr), "+v"(fq), "+v"(tid));
        const int pn = u.pn, row0 = u.pm * BM + wr * 64 + fr, cl = wc * 32 + 8 * fq;
        float rs[2][4];
#pragma unroll
        for (int ai = 0; ai < 2; ++ai)
#pragma unroll
            for (int m = 0; m < 4; ++m) rs[ai][m] = 1.0f / sqrtf(sum_slots<32>(ssx + (size_t)(row0 + ai * HALF + m * 16) * 32) * (1.0f / DM) + EPS);
#pragma unroll
        for (int ai = 0; ai < 2; ++ai)
#pragma unroll
            for (int bj = 0; bj < 2; ++bj)
#pragma unroll
                for (int m = 0; m < 4; ++m)
#pragma unroll
                    for (int n = 0; n < 2; ++n) acc[ai][bj][m][n] = acc[ai][bj][m][n] * rs[ai][m];
        if (pn < 4 || (pn >= 4 && pn < 8)) {
            bf16* dst; int ld, c0; float* ss = nullptr; int tl = 0;
            if (pn < 4) { dst = U; ld = S5W; c0 = pn * 256; } else if (pn < 6) { dst = CQ; ld = 512; c0 = (pn - 4) * 256; ss = ss_cq; tl = pn - 4; } else { dst = CKV; ld = 512; c0 = (pn - 6) * 256; ss = ss_ckv; tl = pn - 6; }
            float part[2][4];
#pragma unroll
            for (int ai = 0; ai < 2; ++ai)
#pragma unroll
                for (int m = 0; m < 4; ++m) { bf16* rp = dst + (size_t)(row0 + ai * HALF + m * 16) * ld + c0 + cl; float s = 0.f;
#pragma unroll
                    for (int bj = 0; bj < 2; ++bj) { *(u32x4*)(rp + bj * HALF) = pack8(acc[ai][bj][m][0], acc[ai][bj][m][1]); s += sq4(acc[ai][bj][m][0]) + sq4(acc[ai][bj][m][1]); }
                    part[ai][m] = s; }
            if (ss) rows_slots<8>(part, ss, row0, fq, tl * 4 + wc);
        } else if (pn == 8) {
            float part[2][4];
#pragma unroll
            for (int ai = 0; ai < 2; ++ai)
#pragma unroll
                for (int m = 0; m < 4; ++m) { float s = 0.f;
                    if (wc < 2) { float* rp = KR + (size_t)(row0 + ai * HALF + m * 16) * 64 + cl; *(f32x4*)rp = acc[ai][0][m][0]; *(f32x4*)(rp + 4) = acc[ai][0][m][1]; s = sq4(acc[ai][0][m][0]) + sq4(acc[ai][0][m][1]); }
                    part[ai][m] = s; }
            rows_slots<4>(part, ss_kr, row0, fq, wc);
        } else if (pn < 13) {
            float part[2][4];
#pragma unroll
            for (int ai = 0; ai < 2; ++ai)
#pragma unroll
                for (int m = 0; m < 4; ++m) { float s = 0.f;
#pragma unroll
                    for (int bj = 0; bj < 2; ++bj) s += sq4(acc[ai][bj][m][0]) + sq4(acc[ai][bj][m][1]);
                    part[ai][m] = s; }
            rows_allreduce(part, lds, wr, wc, fr, fq);
            f32x4 gn[2][2];
#pragma unroll
            for (int bj = 0; bj < 2; ++bj)
#pragma unroll
                for (int n = 0; n < 2; ++n) gn[bj][n] = *(const f32x4*)(qm_gain + bj * HALF + cl + 4 * n) * (0.0625f * LOG2E);
#pragma unroll
            for (int ai = 0; ai < 2; ++ai)
#pragma unroll
                for (int m = 0; m < 4; ++m) { const float rq = 1.0f / sqrtf(part[ai][m] * (1.0f / MEMD) + EPS); bf16* rp = QM + (size_t)(row0 + ai * HALF + m * 16) * MEMW + (pn - 9) * 256 + cl;
#pragma unroll
                    for (int bj = 0; bj < 2; ++bj) *(u32x4*)(rp + bj * HALF) = pack8(acc[ai][bj][m][0] * gn[bj][0] * rq, acc[ai][bj][m][1] * gn[bj][1] * rq); }
        } else {
#pragma unroll
            for (int ai = 0; ai < 2; ++ai)
#pragma unroll
                for (int m = 0; m < 4; ++m) { bf16* rp = GT + (size_t)(row0 + ai * HALF + m * 16) * (3 * DM) + (pn - 13) * 256 + cl;
#pragma unroll
                    for (int bj = 0; bj < 2; ++bj) { f32x4 a = acc[ai][bj][m][0], b = acc[ai][bj][m][1];
#pragma unroll
                        for (int e = 0; e < 4; ++e) { a[e] = sigmoidf_(a[e]); b[e] = sigmoidf_(b[e]); }
                        *(u32x4*)(rp + bj * HALF) = pack8(a, b); } }
        }
    }
};

struct EpiQ {
    static constexpr bool PERM = true;
    const float* ss_cq; const float* qn; const float* ropec; const float* ropes; bf16* Q;
    __device__ __forceinline__ void operator()(Acc& acc, const Unit& u, int wr, int wc, int fr, int fq, LAS unsigned char* lds, int tid) const {
        asm volatile("" : "+v"(fr), "+v"(fq), "+v"(tid));
        const int row0 = u.pm * BM + wr * 64 + fr, cl = wc * 32 + 8 * fq;
        float part[2][4];
#pragma unroll
        for (int ai = 0; ai < 2; ++ai)
#pragma unroll
            for (int m = 0; m < 4; ++m) { const float a = 1.0f / sqrtf(sum_slots<8>(ss_cq + (size_t)(row0 + ai * HALF + m * 16) * 8) * (1.0f / QRANK) + EPS); float s = 0.f;
#pragma unroll
                for (int bj = 0; bj < 2; ++bj)
#pragma unroll
                    for (int n = 0; n < 2; ++n) { acc[ai][bj][m][n] = acc[ai][bj][m][n] * a; s += sq4(acc[ai][bj][m][n]); }
                part[ai][m] = s; }
        rows_allreduce(part, lds, wr, wc, fr, fq);
        const float SC = 0.07216878364870322f * LOG2E;
        { f32x4 g0 = *(const f32x4*)(qn + cl), g1 = *(const f32x4*)(qn + cl + 4);
#pragma unroll
          for (int ai = 0; ai < 2; ++ai)
#pragma unroll
            for (int m = 0; m < 4; ++m) { const float rq = SC / sqrtf(part[ai][m] * (1.0f / DQK) + EPS); bf16* rp = Q + ((size_t)u.pn * SEQ + row0 + ai * HALF + m * 16) * DQK + cl;
                *(u32x4*)rp = pack8(acc[ai][0][m][0] * g0 * rq, acc[ai][0][m][1] * g1 * rq); } }
        if (wc < 2) {
            const int i0 = cl >> 1; float g1v[4], g2v[4];
#pragma unroll
            for (int j = 0; j < 4; ++j) { g1v[j] = qn[128 + i0 + j]; g2v[j] = qn[160 + i0 + j]; }
#pragma unroll
            for (int ai = 0; ai < 2; ++ai)
#pragma unroll
                for (int m = 0; m < 4; ++m) { const int row = row0 + ai * HALF + m * 16; const float rq = SC / sqrtf(part[ai][m] * (1.0f / DQK) + EPS);
                    const f32x4 cs = *(const f32x4*)(ropec + (size_t)row * 32 + i0), sn = *(const f32x4*)(ropes + (size_t)row * 32 + i0);
                    f32x4 o0, o1;
                    { const float x1 = acc[ai][1][m][0][0] * g1v[0] * rq, x2 = acc[ai][1][m][0][1] * g2v[0] * rq; o0[0] = x1 * cs[0] - x2 * sn[0]; o0[1] = x2 * cs[0] + x1 * sn[0]; }
                    { const float x1 = acc[ai][1][m][0][2] * g1v[1] * rq, x2 = acc[ai][1][m][0][3] * g2v[1] * rq; o0[2] = x1 * cs[1] - x2 * sn[1]; o0[3] = x2 * cs[1] + x1 * sn[1]; }
                    { const float x1 = acc[ai][1][m][1][0] * g1v[2] * rq, x2 = acc[ai][1][m][1][1] * g2v[2] * rq; o1[0] = x1 * cs[2] - x2 * sn[2]; o1[1] = x2 * cs[2] + x1 * sn[2]; }
                    { const float x1 = acc[ai][1][m][1][2] * g1v[3] * rq, x2 = acc[ai][1][m][1][3] * g2v[3] * rq; o1[2] = x1 * cs[3] - x2 * sn[3]; o1[3] = x2 * cs[3] + x1 * sn[3]; }
                    *(u32x4*)(Q + ((size_t)u.pn * SEQ + row) * DQK + 128 + cl) = pack8(o0, o1); }
        }
    }
};

struct EpiKV {
    static constexpr bool PERM = true;
    const float* ss_ckv; const float* ss_kr; const float* kn; const float* KR; const float* ropec; const float* ropes; bf16* Kc; bf16* Vc;
    __device__ __forceinline__ void operator()(Acc& acc, const Unit& u, int wr, int wc, int fr, int fq, LAS unsigned char* lds, int tid) const {
        asm volatile("" : "+v"(fr), "+v"(fq), "+v"(tid));
        const int row0 = u.pm * BM + wr * 64 + fr, cl = wc * 32 + 8 * fq;
        float part[2][4];
#pragma unroll
        for (int ai = 0; ai < 2; ++ai)
#pragma unroll
            for (int m = 0; m < 4; ++m) { const float a = 1.0f / sqrtf(sum_slots<8>(ss_ckv + (size_t)(row0 + ai * HALF + m * 16) * 8) * (1.0f / KVRANK) + EPS);
#pragma unroll
                for (int bj = 0; bj < 2; ++bj)
#pragma unroll
                    for (int n = 0; n < 2; ++n) acc[ai][bj][m][n] = acc[ai][bj][m][n] * a;
                part[ai][m] = sq4(acc[ai][0][m][0]) + sq4(acc[ai][0][m][1]); }
        rows_allreduce(part, lds, wr, wc, fr, fq);
        LAS float* RKt = (LAS float*)(lds + RK_OFF);
        const f32x4 g0 = *(const f32x4*)(kn + cl), g1 = *(const f32x4*)(kn + cl + 4);
#pragma unroll
        for (int ai = 0; ai < 2; ++ai)
#pragma unroll
            for (int m = 0; m < 4; ++m) { const int row = row0 + ai * HALF + m * 16; const float rk = 1.0f / sqrtf((part[ai][m] + sum_slots<4>(ss_kr + (size_t)row * 4)) * (1.0f / DQK) + EPS);
                *(u32x4*)(Kc + ((size_t)u.pn * SEQ + row) * DQK + cl) = pack8(acc[ai][0][m][0] * g0 * rk, acc[ai][0][m][1] * g1 * rk);
                *(u32x4*)(Vc + ((size_t)u.pn * SEQ + row) * DV + cl) = pack8(acc[ai][1][m][0], acc[ai][1][m][1]);
                if (wc == 0 && fq == 0) RKt[ai * HALF + wr * 64 + m * 16 + fr] = rk; }
        EPI_BAR();
        {
            const int rl = tid >> 1, i0 = (tid & 1) * 16, row = u.pm * BM + rl; const float rk = RKt[rl];
            const float* kr = KR + (size_t)row * 64; bf16* dst = Kc + ((size_t)u.pn * SEQ + row) * DQK + 128 + 2 * i0;
#pragma unroll
            for (int j4 = 0; j4 < 4; ++j4) { const int i = i0 + 4 * j4;
                const f32x4 x1 = *(const f32x4*)(kr + i) * *(const f32x4*)(kn + 128 + i) * rk, x2 = *(const f32x4*)(kr + 32 + i) * *(const f32x4*)(kn + 160 + i) * rk;
                const f32x4 cs = *(const f32x4*)(ropec + (size_t)row * 32 + i), sn = *(const f32x4*)(ropes + (size_t)row * 32 + i);
                const f32x4 a = x1 * cs - x2 * sn, b = x2 * cs + x1 * sn;
                *(u32x4*)(dst + 8 * j4) = pack8((f32x4){a[0], b[0], a[1], b[1]}, (f32x4){a[2], b[2], a[3], b[3]}); }
        }
    }
};

struct EpiMemKV {
    static constexpr bool PERM = true;
    const float* kng[2]; bf16* KM; bf16* VM;
    __device__ __forceinline__ void operator()(Acc& acc, const Unit& u, int wr, int wc, int fr, int fq, LAS unsigned char* lds, int tid) const {
        asm volatile("" : "+v"(fr), "+v"(fq), "+v"(tid));
        const int rl0 = wr * 64 + fr, cl = wc * 32 + 8 * fq;
        float part[2][4];
#pragma unroll
        for (int ai = 0; ai < 2; ++ai)
#pragma unroll
            for (int m = 0; m < 4; ++m) { float s = 0.f;
#pragma unroll
                for (int bj = 0; bj < 2; ++bj) s += sq4(acc[ai][bj][m][0]) + sq4(acc[ai][bj][m][1]);
                part[ai][m] = s; }
        rows_allreduce(part, lds, wr, wc, fr, fq);
        const bool isk = u.pn < 4; const float* kg = u.e ? kng[1] : kng[0];
        bf16* dst = (isk ? KM : VM) + ((size_t)u.e * MEMH + (u.pn & 3)) * NMEM * MEMD;
#pragma unroll
        for (int ai = 0; ai < 2; ++ai)
#pragma unroll
            for (int m = 0; m < 4; ++m) { const float rk = isk ? 1.0f / sqrtf(part[ai][m] * (1.0f / MEMD) + EPS) : 1.0f;
#pragma unroll
                for (int bj = 0; bj < 2; ++bj) { f32x4 g0 = (f32x4){1.f, 1.f, 1.f, 1.f}, g1 = g0; if (isk) { g0 = *(const f32x4*)(kg + bj * HALF + cl); g1 = *(const f32x4*)(kg + bj * HALF + cl + 4); }
                    *(u32x4*)(dst + (size_t)(rl0 + ai * HALF + m * 16) * MEMD + bj * HALF + cl) = pack8(acc[ai][bj][m][0] * g0 * rk, acc[ai][bj][m][1] * g1 * rk); } }
    }
};

template <int MODE> struct EpiMerge {
    static constexpr bool PERM = false;
    const bf16* GT; float* MF;
    __device__ __forceinline__ void operator()(Acc& acc, const Unit& u, int wr, int wc, int fr, int fq, LAS unsigned char* lds, int tid) const {
        asm volatile("" : "+v"(fr), "+v"(fq), "+v"(tid));
        const int row0 = u.pm * BM + wr * 64 + fr, col0 = u.pn * BM + wc * 32 + 4 * fq;
#pragma unroll
        for (int ai = 0; ai < 2; ++ai)
#pragma unroll
            for (int m = 0; m < 4; ++m) { const size_t row = row0 + ai * HALF + m * 16;
#pragma unroll
                for (int bj = 0; bj < 2; ++bj)
#pragma unroll
                    for (int n = 0; n < 2; ++n) { const int c = col0 + bj * HALF + n * 16; const f32x4 gg = unpack4(*(const u32x2*)(GT + row * (3 * DM) + MODE * DM + c));
                        float* p = MF + row * DM + c; f32x4 v = acc[ai][bj][m][n] * gg; if (MODE == 2) v = v + *(const f32x4*)p; *(f32x4*)p = v; } }
    }
};
struct EpiGlu {
    static constexpr bool PERM = false;
    const bf16* GT; const float* MF; bf16* MB;
    __device__ __forceinline__ void operator()(Acc& acc, const Unit& u, int wr, int wc, int fr, int fq, LAS unsigned char* lds, int tid) const {
        asm volatile("" : "+v"(fr), "+v"(fq), "+v"(tid));
        const int row0 = u.pm * BM + wr * 64 + fr, col0 = u.pn * HALF + wc * 32 + 4 * fq;
#pragma unroll
        for (int ai = 0; ai < 2; ++ai)
#pragma unroll
            for (int m = 0; m < 4; ++m) { const size_t row = row0 + ai * HALF + m * 16;
#pragma unroll
                for (int n = 0; n < 2; ++n) { const int c = col0 + n * 16; const f32x4 gg = unpack4(*(const u32x2*)(GT + row * (3 * DM) + c));
                    const f32x4 ga = acc[ai][0][m][n], gb = acc[ai][1][m][n]; f32x4 v = *(const f32x4*)(MF + row * DM + c);
#pragma unroll
                    for (int e = 0; e < 4; ++e) v[e] += gg[e] * ga[e] * sigmoidf_(gb[e]);
                    *(u32x2*)(MB + row * DM + c) = pack4(v); } }
    }
};
struct EpiResid {
    static constexpr bool PERM = false;
    const float* base; float* OUT; bf16* XBo; float* ss;
    __device__ __forceinline__ void operator()(Acc& acc, const Unit& u, int wr, int wc, int fr, int fq, LAS unsigned char* lds, int tid) const {
        asm volatile("" : "+v"(fr), "+v"(fq), "+v"(tid));
        const int row0 = u.pm * BM + wr * 64 + fr, col0 = u.pn * BM + wc * 32 + 4 * fq;
        float part[2][4];
#pragma unroll
        for (int ai = 0; ai < 2; ++ai)
#pragma unroll
            for (int m = 0; m < 4; ++m) { const size_t row = row0 + ai * HALF + m * 16; float s = 0.f;
#pragma unroll
                for (int bj = 0; bj < 2; ++bj)
#pragma unroll
                    for (int n = 0; n < 2; ++n) { const int c = col0 + bj * HALF + n * 16; const f32x4 v = acc[ai][bj][m][n] + *(const f32x4*)(base + row * DM + c);
                        *(f32x4*)(OUT + row * DM + c) = v; if (XBo) *(u32x2*)(XBo + row * DM + c) = pack4(v); s += sq4(v); }
                part[ai][m] = s; }
        if (ss) rows_slots<32>(part, ss, row0, fq, u.pn * 4 + wc);
    }
};
template <class Sched> struct EpiSwiGLU {
    static constexpr bool PERM = true;
    const float* ssx; bf16* ACT; const Sched* S; bool moe;
    __device__ __forceinline__ void operator()(Acc& acc, const Unit& u, int wr, int wc, int fr, int fq, LAS unsigned char* lds, int tid) const {
        asm volatile("" : "+v"(fr), "+v"(fq), "+v"(tid));
        const int rl0 = wr * 64 + fr, cl = wc * 32 + 8 * fq;
#pragma unroll
        for (int ai = 0; ai < 2; ++ai)
#pragma unroll
            for (int m = 0; m < 4; ++m) { const int rl = rl0 + ai * HALF + m * 16; const unsigned tk = moe ? S->tok(u, rl) : (unsigned)(u.pm * BM + rl);
                const float rs = 1.0f / sqrtf(sum_slots<32>(ssx + (size_t)tk * 32) * (1.0f / DM) + EPS);
                f32x4 o[2];
#pragma unroll
                for (int n = 0; n < 2; ++n) { const f32x4 gg = acc[ai][0][m][n] * rs, uu = acc[ai][1][m][n] * rs;
#pragma unroll
                    for (int e = 0; e < 4; ++e) o[n][e] = gg[e] * sigmoidf_(gg[e]) * uu[e]; }
                *(u32x4*)(ACT + (size_t)(u.pm * BM + rl) * DFF + u.pn * HALF + cl) = pack8(o[0], o[1]); }
    }
};
struct EpiMoeDown {
    static constexpr bool PERM = true;
    bf16* YM;
    __device__ __forceinline__ void operator()(Acc& acc, const Unit& u, int wr, int wc, int fr, int fq, LAS unsigned char* lds, int tid) const {
        asm volatile("" : "+v"(fr), "+v"(fq), "+v"(tid));
        const int rl0 = wr * 64 + fr, cl = wc * 32 + 8 * fq;
        bf16* dst = YM + (size_t)u.ks * ACT_ROWS * DM;
#pragma unroll
        for (int ai = 0; ai < 2; ++ai)
#pragma unroll
            for (int m = 0; m < 4; ++m) { bf16* rp = dst + (size_t)(u.pm * BM + rl0 + ai * HALF + m * 16) * DM + u.pn * BM + cl;
#pragma unroll
                for (int bj = 0; bj < 2; ++bj) *(u32x4*)(rp + bj * HALF) = pack8(acc[ai][bj][m][0], acc[ai][bj][m][1]); }
    }
};
}
namespace attn {
constexpr int A_KOFF = 0, A_VOFF = 65536, A_WS = 98304, A_POSK = 100352, A_LIST = 100864;
__device__ __forceinline__ int v_st(int k, int c) { const int kk = (k & ~0xC) | ((k & 4) << 1) | ((k & 8) >> 1); return ((kk >> 3) * 4 + (c >> 5)) * 512 + ((kk & 7) * 32 + (c & 31)) * 2; }
__device__ __forceinline__ int v_rd_base(int lane) { return ((lane & 3) << 3) | (((lane >> 2) & 3) << 6) | (((lane >> 4) & 1) << 5) | (((lane >> 5) & 1) << 8); }
constexpr int v_rd_off(int d0, int ks, int half) { return d0 * 512 + ks * 4096 + half * 2048; }
__device__ __forceinline__ int crow(int r, int hi) { return (r & 3) + 8 * (r >> 2) + 4 * hi; }

template <int VBOFF>
__device__ __forceinline__ void pv_tile(f32x16* o, int vb0, bf16x8 pa0, bf16x8 pa1, bf16x8 pa2, bf16x8 pa3) {
#define TRRD(dst, off) asm volatile("ds_read_b64_tr_b16 %0, %1 offset:%2" : "=&v"(dst) : "v"(vb0), "i"(off) : "memory")
#define PV_D0(d0) do { s16x4 l0, l1, l2, l3, h0, h1, h2, h3; constexpr int b_ = VBOFF + v_rd_off(d0, 0, 0); \
        TRRD(l0, b_); TRRD(h0, b_ + 2048); TRRD(l1, b_ + 4096); TRRD(h1, b_ + 6144); TRRD(l2, b_ + 8192); TRRD(h2, b_ + 10240); TRRD(l3, b_ + 12288); TRRD(h3, b_ + 14336); \
        asm volatile("s_waitcnt lgkmcnt(0)" ::: "memory"); SBAR(); \
        o[d0] = __builtin_amdgcn_mfma_f32_32x32x16_bf16(pa0, (bf16x8){l0[0], l0[1], l0[2], l0[3], h0[0], h0[1], h0[2], h0[3]}, o[d0], 0, 0, 0);   \
        o[d0] = __builtin_amdgcn_mfma_f32_32x32x16_bf16(pa1, (bf16x8){l1[0], l1[1], l1[2], l1[3], h1[0], h1[1], h1[2], h1[3]}, o[d0], 0, 0, 0);   \
        o[d0] = __builtin_amdgcn_mfma_f32_32x32x16_bf16(pa2, (bf16x8){l2[0], l2[1], l2[2], l2[3], h2[0], h2[1], h2[2], h2[3]}, o[d0], 0, 0, 0);   \
        o[d0] = __builtin_amdgcn_mfma_f32_32x32x16_bf16(pa3, (bf16x8){l3[0], l3[1], l3[2], l3[3], h3[0], h3[1], h3[2], h3[3]}, o[d0], 0, 0, 0); } while (0)
    PV_D0(0); PV_D0(1); PV_D0(2); PV_D0(3);
#undef PV_D0
#undef TRRD
}

template <int DQ, bool CAUSAL, int qstride, int vstride, int ostride, bool QREG>
__device__ __forceinline__ void attn_item(char* lds, LAS unsigned char* ldsl, const bf16* Qb, const bf16* Kh, const bf16* Vh, bf16* Ob,
                                          const int* pos, int q0, int nkt, const int* tmin, const int* tmax) {
    constexpr int KSTR = DQ * 2, KBYTES = 64 * KSTR, NCH = DQ / 64, CPR = DQ / 8, ND0 = DQ / 16;
    const int tid = fresh_tid(), wid = __builtin_amdgcn_readfirstlane(tid >> 6), lane = tid & 63, r32 = lane & 31, hi = lane >> 5;
    char* K_lds = lds + A_KOFF; char* V_lds = lds + A_VOFF;
    float* wsf = (float*)(lds + A_WS) + wid * 64; float* li_l = wsf; float* al_l = wsf + 32;
    int* posk = (int*)(lds + A_POSK); int* tlist = (int*)(lds + A_LIST);
    int NT = nkt;
    if constexpr (CAUSAL) {
        if (wid == 0) {
            const int qt = q0 >> 6; int qmax = tmax[qt]; qmax = max(qmax, tmax[qt + 1]); qmax = max(qmax, tmax[qt + 2]); qmax = max(qmax, tmax[qt + 3]);
            const bool n0 = lane < nkt && tmin[lane] <= qmax, n1 = lane + 64 < nkt && tmin[lane + 64] <= qmax;
            const unsigned long long b0 = __ballot(n0), b1 = __ballot(n1); const int c0 = __popcll(b0);
            const unsigned long long below = (lane == 0) ? 0ull : (~0ull >> (64 - lane));
            if (n0) tlist[__popcll(b0 & below)] = lane;
            if (n1) tlist[c0 + __popcll(b1 & below)] = lane + 64;
            if (lane == 0) tlist[128] = c0 + __popcll(b1);
        }
        __syncthreads();
        NT = tlist[128];
    }
#define TILE(t) (CAUSAL ? tlist[t] : (t))
    int ksrc[NCH], vsrc[2];
#pragma unroll
    for (int jj = 0; jj < NCH; ++jj) { const int p = jj * 512 + tid, row = p / CPR, cs = p % CPR, cc = (cs & ~7) | ((cs & 7) ^ (row & 7)); ksrc[jj] = row * DQ + cc * 8; }
#pragma unroll
    for (int jj = 0; jj < 2; ++jj) { const int p = jj * 512 + tid, kk = (p >> 7) * 8 + ((p & 31) >> 2), k = (kk & ~0xC) | ((kk & 4) << 1) | ((kk & 8) >> 1), cv = ((p >> 5) & 3) * 32 + (p & 3) * 8; vsrc[jj] = k * vstride + cv; }
    int stP = 0;
#define A_STAGE(tile_, bf) do { const int kb_ = (tile_) * 64; \
        _Pragma("unroll") for (int jj = 0; jj < NCH; ++jj) __builtin_amdgcn_global_load_lds((const unsigned*)(Kh + (size_t)kb_ * DQ + ksrc[jj]), (LAS unsigned*)(ldsl + A_KOFF + (bf) * KBYTES + jj * 8192 + wid * 1024), 16, 0, 0); \
        _Pragma("unroll") for (int jj = 0; jj < 2; ++jj) __builtin_amdgcn_global_load_lds((const unsigned*)(Vh + (size_t)kb_ * vstride + vsrc[jj]), (LAS unsigned*)(ldsl + A_VOFF + (bf) * 16384 + jj * 8192 + wid * 1024), 16, 0, 0); \
        if (CAUSAL && tid < 64) stP = pos[kb_ + tid]; } while (0)
#define A_POSW(bf) do { if (CAUSAL && tid < 64) posk[(bf) * 64 + tid] = stP; } while (0)
    A_STAGE(TILE(0), 0);
    bf16x8 qr[QREG ? ND0 : 1];
    if constexpr (QREG) {
#pragma unroll
        for (int d0 = 0; d0 < ND0; ++d0) qr[d0] = *(const bf16x8*)(Qb + (size_t)(wid * 32 + r32) * qstride + d0 * 16 + hi * 8); }
    int posq = 0, wminq = 0;
    if constexpr (CAUSAL) { posq = pos[q0 + wid * 32 + r32]; int v = posq;
#pragma unroll
        for (int o_ = 1; o_ < 32; o_ <<= 1) v = min(v, __shfl_xor(v, o_));
        wminq = __builtin_amdgcn_readfirstlane(v); }
    A_POSW(0);
    __syncthreads();
    float m_reg = -1e30f, l_reg = 0.f; f32x16 o[4] = {};
    const int vb0 = (int)(uintptr_t)V_lds + v_rd_base(lane);
    int kbv[4];
#pragma unroll
    for (int dd = 0; dd < 4; ++dd) kbv[dd] = r32 * KSTR + (((dd * 2 + hi) ^ (r32 & 7)) << 4);
    for (int t = 0; t < NT; ++t) {
        const int buf = t & 1; const int tile = TILE(t);
        if (t + 1 < NT) { if (buf == 0) A_STAGE(TILE(t + 1), 1); else A_STAGE(TILE(t + 1), 0); }
        SBAR();
        f32x16 p0 = {}, p1 = {};
        { const char* kb_ = K_lds + buf * KBYTES; int qo = (wid * 32 + r32) * qstride + hi * 8; if (!QREG) asm volatile("" : "+v"(qo));
#pragma unroll
          for (int d0 = 0; d0 < ND0; ++d0) { const char* a = kb_ + kbv[d0 & 3] + (d0 >> 2) * 128;
              const bf16x8 b0 = *(const bf16x8*)a, b1 = *(const bf16x8*)(a + 32 * KSTR);
              bf16x8 qf; if constexpr (QREG) qf = qr[d0]; else qf = *(const bf16x8*)(Qb + qo + d0 * 16);
              p0 = __builtin_amdgcn_mfma_f32_32x32x16_bf16(b0, qf, p0, 0, 0, 0);
              p1 = __builtin_amdgcn_mfma_f32_32x32x16_bf16(b1, qf, p1, 0, 0, 0); } }
        if constexpr (CAUSAL) {
            if (tmax[tile] > wminq) {
                const float NEG = -__builtin_inff(); const int* pk = posk + buf * 64 + 4 * hi;
#pragma unroll
                for (int g = 0; g < 4; ++g) { const int4 k0 = *(const int4*)(pk + 8 * g), k1 = *(const int4*)(pk + 32 + 8 * g);
                    if (k0.x > posq) p0[4 * g + 0] = NEG; if (k0.y > posq) p0[4 * g + 1] = NEG; if (k0.z > posq) p0[4 * g + 2] = NEG; if (k0.w > posq) p0[4 * g + 3] = NEG;
                    if (k1.x > posq) p1[4 * g + 0] = NEG; if (k1.y > posq) p1[4 * g + 1] = NEG; if (k1.z > posq) p1[4 * g + 2] = NEG; if (k1.w > posq) p1[4 * g + 3] = NEG; }
            }
        }
        float pmax = p0[0];
#pragma unroll
        for (int r = 1; r < 16; ++r) pmax = fmaxf(pmax, p0[r]);
#pragma unroll
        for (int r = 0; r < 16; ++r) pmax = fmaxf(pmax, p1[r]);
        { auto rr = __builtin_amdgcn_permlane32_swap(__float_as_uint(pmax), __float_as_uint(pmax), false, false); pmax = fmaxf(__uint_as_float(rr[0]), __uint_as_float(rr[1])); }
        const float mn = fmaxf(m_reg, pmax); const float alpha = __builtin_amdgcn_exp2f(m_reg - mn); m_reg = mn;
        float ps = 0.f;
#pragma unroll
        for (int r = 0; r < 16; ++r) { p0[r] = __builtin_amdgcn_exp2f(p0[r] - mn); ps += p0[r]; }
#pragma unroll
        for (int r = 0; r < 16; ++r) { p1[r] = __builtin_amdgcn_exp2f(p1[r] - mn); ps += p1[r]; }
        { auto rr = __builtin_amdgcn_permlane32_swap(__float_as_uint(ps), __float_as_uint(ps), false, false); ps = __uint_as_float(rr[0]) + __uint_as_float(rr[1]); }
        l_reg = l_reg * alpha + ps;
        bf16x8 pa0, pa1, pa2, pa3;
#define PK4(P, B_, OUT) do { unsigned a0 = cvt_pk_bf16(P[B_+0], P[B_+1]), a1 = cvt_pk_bf16(P[B_+2], P[B_+3]); \
        unsigned b0 = cvt_pk_bf16(P[B_+4], P[B_+5]), b1 = cvt_pk_bf16(P[B_+6], P[B_+7]); \
        auto r0 = __builtin_amdgcn_permlane32_swap(a0, b0, false, false); auto r1 = __builtin_amdgcn_permlane32_swap(a1, b1, false, false); \
        u32x4 w = {r0[0], r1[0], r0[1], r1[1]}; OUT = *reinterpret_cast<bf16x8*>(&w); } while (0)
        PK4(p0, 0, pa0); PK4(p0, 8, pa1); PK4(p1, 0, pa2); PK4(p1, 8, pa3);
#undef PK4
        if (__any(alpha < 1.f)) { if (hi == 0) al_l[r32] = alpha; asm volatile("s_waitcnt lgkmcnt(0)" ::: "memory");
#pragma unroll
            for (int r = 0; r < 16; ++r) { const float a = al_l[crow(r, hi)];
#pragma unroll
                for (int d_ = 0; d_ < 4; ++d_) o[d_][r] *= a; } }
        SBAR();
        if (buf == 0) pv_tile<0>(o, vb0, pa0, pa1, pa2, pa3); else pv_tile<16384>(o, vb0, pa0, pa1, pa2, pa3);
        SBAR();
        if (t + 1 < NT) { if (buf == 0) A_POSW(1); else A_POSW(0); }
        __syncthreads();
    }
    if (hi == 0) li_l[r32] = l_reg; asm volatile("s_waitcnt lgkmcnt(0)" ::: "memory");
    int oofs = (wid * 32 + 4 * hi) * ostride + r32; asm volatile("" : "+v"(oofs));
    bf16* Ow = Ob + oofs;
#pragma unroll
    for (int r = 0; r < 16; ++r) { constexpr int dummy = 0; (void)dummy; const int orow = crow(r, hi); const float rl = __builtin_amdgcn_rcpf(li_l[orow]);
#pragma unroll
        for (int d0 = 0; d0 < 4; ++d0) { const float v = o[d0][r] * rl; const float vn = __shfl_xor(v, 1);
            if ((r32 & 1) == 0) *(unsigned*)(Ow + ((r & 3) + 8 * (r >> 2)) * ostride + d0 * 32) = cvt_pk_bf16(v, vn); } }
    __syncthreads();
#undef A_STAGE
#undef A_POSW
#undef TILE
}
}
namespace s5 {
constexpr int TROW = 136;
constexpr int WAVE_LDS = 32 * TROW * 2;
__device__ __forceinline__ void cmul(float ar, float ai, float br, float bi, float& cr, float& ci) { cr = ar * br - ai * bi; ci = ar * bi + ai * br; }
__device__ __forceinline__ float gelu_tanh(float x) { const float z = 1.5957691216057308f * (x + 0.044715f * x * x * x); return x * sigmoidf_(z); }

template <int PART>
__device__ __forceinline__ void s5_wave(char* ldsw, int g, int c0, const bf16* U, const f32x2* LAM, const bf16* BB, const bf16* CP, const float* Dd, float* ES, bf16* YS, int lane) {
    const int c = lane & 31, hi = lane >> 5;
    float l1r[2], l1i[2], l2r[2], l2i[2], l3r[2], l3i[2], l4r[2], l4i[2];
    bf16x8 bfrag[2][2];
#pragma unroll
    for (int sb = 0; sb < 2; ++sb) { const f32x2 lm = LAM[g * 64 + 32 * sb + c]; l1r[sb] = lm.x; l1i[sb] = lm.y;
        cmul(l1r[sb], l1i[sb], l1r[sb], l1i[sb], l2r[sb], l2i[sb]); cmul(l2r[sb], l2i[sb], l1r[sb], l1i[sb], l3r[sb], l3i[sb]); cmul(l2r[sb], l2i[sb], l2r[sb], l2i[sb], l4r[sb], l4i[sb]);
#pragma unroll
        for (int ri = 0; ri < 2; ++ri) bfrag[sb][ri] = *(const bf16x8*)(BB + ((size_t)(g * 128 + 64 * ri + 32 * sb + c)) * 16 + 8 * hi); }
    float sr[2] = {0.f, 0.f}, si[2] = {0.f, 0.f};
    bf16x8 cpf[8];
    if constexpr (PART == 2) {
        float l64r[2], l64i[2];
#pragma unroll
        for (int sb = 0; sb < 2; ++sb) { float ar = l4r[sb], ai = l4i[sb];
#pragma unroll
            for (int k = 0; k < 4; ++k) { float tr, ti; cmul(ar, ai, ar, ai, tr, ti); ar = tr; ai = ti; }
            l64r[sb] = ar; l64i[sb] = ai; }
        for (int cc = 0; cc < c0; ++cc) { const float* e = ES + ((size_t)g * 128 + cc) * 128;
#pragma unroll
            for (int sb = 0; sb < 2; ++sb) { const float er = e[32 * sb + c], ei = e[64 + 32 * sb + c]; float tr, ti; cmul(l64r[sb], l64i[sb], sr[sb], si[sb], tr, ti); sr[sb] = tr + er; si[sb] = ti + ei; } }
#pragma unroll
        for (int ks = 0; ks < 8; ++ks) { cpf[ks] = (bf16x8){0, 0, 0, 0, 0, 0, 0, 0}; if (c < 16) cpf[ks] = *(const bf16x8*)(CP + ((size_t)(g * 16 + c)) * 128 + 16 * ks + 8 * hi); }
    }
    bf16* T = (bf16*)ldsw;
    for (int blk = 0; blk < 8; ++blk) {
        const int t0 = (c0 * 2 + blk) * 32;
        if (PART == 1 && (blk & 1) == 0) { sr[0] = 0.f; si[0] = 0.f; sr[1] = 0.f; si[1] = 0.f; }
        const bf16x8 af = *(const bf16x8*)(U + (size_t)(t0 + c) * S5W + g * 16 + 8 * hi);
#pragma unroll
        for (int sb = 0; sb < 2; ++sb) {
            f32x16 br = {}, bi = {};
            br = __builtin_amdgcn_mfma_f32_32x32x16_bf16(af, bfrag[sb][0], br, 0, 0, 0);
            bi = __builtin_amdgcn_mfma_f32_32x32x16_bf16(af, bfrag[sb][1], bi, 0, 0, 0);
#pragma unroll
            for (int q4 = 0; q4 < 4; ++q4)
#pragma unroll
                for (int k = 1; k < 4; ++k) { const int r = 4 * q4 + k; float tr, ti; cmul(l1r[sb], l1i[sb], br[r - 1], bi[r - 1], tr, ti); br[r] += tr; bi[r] += ti; }
            float per[4], pei[4];
#pragma unroll
            for (int q4 = 0; q4 < 4; ++q4) { per[q4] = __shfl_xor(br[4 * q4 + 3], 32); pei[q4] = __shfl_xor(bi[4 * q4 + 3], 32); }
            float cr = sr[sb], ci = si[sb], cinr[4], cini[4];
#pragma unroll
            for (int q = 0; q < 8; ++q) { const bool own = ((q & 1) == hi); const int q4 = q >> 1;
                if ((q & 1) == 0) { if (hi == 0) { cinr[q4] = cr; cini[q4] = ci; } } else { if (hi == 1) { cinr[q4] = cr; cini[q4] = ci; } }
                const float er = own ? br[4 * q4 + 3] : per[q4], ei = own ? bi[4 * q4 + 3] : pei[q4];
                float tr, ti; cmul(l4r[sb], l4i[sb], cr, ci, tr, ti); cr = tr + er; ci = ti + ei; }
            sr[sb] = cr; si[sb] = ci;
            if constexpr (PART == 2) {
#pragma unroll
                for (int q4 = 0; q4 < 4; ++q4) { float tr, ti;
                    cmul(l1r[sb], l1i[sb], cinr[q4], cini[q4], tr, ti); br[4 * q4 + 0] += tr; bi[4 * q4 + 0] += ti;
                    cmul(l2r[sb], l2i[sb], cinr[q4], cini[q4], tr, ti); br[4 * q4 + 1] += tr; bi[4 * q4 + 1] += ti;
                    cmul(l3r[sb], l3i[sb], cinr[q4], cini[q4], tr, ti); br[4 * q4 + 2] += tr; bi[4 * q4 + 2] += ti;
                    cmul(l4r[sb], l4i[sb], cinr[q4], cini[q4], tr, ti); br[4 * q4 + 3] += tr; bi[4 * q4 + 3] += ti; }
#pragma unroll
                for (int r = 0; r < 16; ++r) { const int tok = (r & 3) + 8 * (r >> 2) + 4 * hi;
                    T[tok * TROW + 32 * sb + c] = (bf16)f2bf(br[r]); T[tok * TROW + 64 + 32 * sb + c] = (bf16)f2bf(bi[r]); }
            }
        }
        if constexpr (PART == 1) {
            if ((blk & 1) == 1 && hi == 0) { float* e = ES + ((size_t)g * 128 + c0 + (blk >> 1)) * 128;
#pragma unroll
                for (int sb = 0; sb < 2; ++sb) { e[32 * sb + c] = sr[sb]; e[64 + 32 * sb + c] = si[sb]; } }
        } else {
            asm volatile("s_waitcnt lgkmcnt(0)" ::: "memory"); __builtin_amdgcn_wave_barrier(); asm volatile("" ::: "memory");
            f32x16 acc = {};
#pragma unroll
            for (int ks = 0; ks < 8; ++ks) { const bf16x8 sfrag = *(const bf16x8*)(T + c * TROW + 16 * ks + 8 * hi);
                acc = __builtin_amdgcn_mfma_f32_32x32x16_bf16(cpf[ks], sfrag, acc, 0, 0, 0); }
            const size_t ro = (size_t)(t0 + c) * S5W + g * 16;
            const f32x4 ua = pg8::unpack4(*(const u32x2*)(U + ro + 4 * hi)), ub = pg8::unpack4(*(const u32x2*)(U + ro + 8 + 4 * hi));
            const f32x4 da = *(const f32x4*)(Dd + g * 16 + 4 * hi), db = *(const f32x4*)(Dd + g * 16 + 8 + 4 * hi);
            f32x4 ya, yb;
#pragma unroll
            for (int e = 0; e < 4; ++e) { ya[e] = gelu_tanh(acc[e] + da[e] * ua[e]); yb[e] = gelu_tanh(acc[4 + e] + db[e] * ub[e]); }
            *(u32x2*)(YS + ro + 4 * hi) = pg8::pack4(ya); *(u32x2*)(YS + ro + 8 + 4 * hi) = pg8::pack4(yb);
            asm volatile("" ::: "memory"); __builtin_amdgcn_wave_barrier();
        }
    }
}
}
struct MapId   { __device__ __forceinline__ int operator()(int n) const { return n; } };
struct MapInProj { __device__ __forceinline__ int operator()(int n) const { return n < 1472 ? n : (n < 1536 ? -1 : (n < 2112 ? n - 64 : (n < 2304 ? -1 : n - 256))); } };
struct MapGlu  { int half; __device__ __forceinline__ int operator()(int n) const { const int j = n >> 8, r = n & 255; return r < 128 ? 128 * j + r : half + 128 * j + (r - 128); } };
struct MapQB   { __device__ __forceinline__ int operator()(int n) const { const int h = n >> 8, j = n & 255; if (j < 128) return 192 * h + j; if (j >= 192) return -1; const int jj = j - 128; return 192 * h + 128 + 32 * (jj & 1) + (jj >> 1); } };

template <class Map>
__device__ __forceinline__ void transpose_item(const float* W, int N, int K, bf16* WT, int Kd, const float* gain, const Map& map, LAS float* scr, int kb, int nb, int lane) {
    const int k0 = 64 * kb, n0 = 64 * nb; const int scol = map(n0 + lane);
    const bool kin = k0 < K;
#pragma unroll 8
    for (int kk = 0; kk < 64; ++kk) { float v = 0.f; if (kin && scol >= 0) { v = W[(size_t)(k0 + kk) * N + scol]; if (gain) v *= gain[k0 + kk]; } scr[kk * 65 + lane] = v; }
    LDS_WAIT(); asm volatile("" ::: "memory");
    const int c = lane & 7;
#pragma unroll
    for (int j = 0; j < 8; ++j) { const int n = (lane >> 3) + 8 * j; const LAS float* s = scr + (8 * c) * 65 + n;
        u32x4 o; o.x = pk2(s[0 * 65], s[1 * 65]); o.y = pk2(s[2 * 65], s[3 * 65]); o.z = pk2(s[4 * 65], s[5 * 65]); o.w = pk2(s[6 * 65], s[7 * 65]);
        *(GAS u32x4*)(WT + (size_t)(n0 + n) * Kd + k0 + 8 * c) = o; }
    LDS_WAIT(); asm volatile("" ::: "memory");
}
template <class Map>
__device__ __forceinline__ void transpose_job(const float* W, size_t wstride, int N, int K, bf16* WT, size_t wtstride, int Kd, int Nd, const float* gain, int gstride, int ninst, const Map& map,
                                              LAS float* scr, int gw, int NGW, int lane) {
    const int nkb = Kd / 64, nnb = Nd / 64, per = nkb * nnb;
    for (int it = gw; it < per * ninst; it += NGW) { const int inst = it / per, r = it - inst * per, nb = r / nkb, kb = r - nb * nkb;
        transpose_item(W + (size_t)inst * wstride, N, K, WT + (size_t)inst * wtstride, Kd, gain ? gain + (size_t)inst * gstride : nullptr, map, scr, kb, nb, lane); }
}
__device__ __forceinline__ float row_to_bf16(const float* xrow, bf16* orow, bool normalize, int lane) {
    const GAS f32x4* xr = (const GAS f32x4*)xrow + lane;
    f32x4 v[8]; float s = 0.f;
#pragma unroll
    for (int j = 0; j < 8; ++j) { v[j] = xr[64 * j]; s += pg8::sq4(v[j]); }
    s = wave_sum(s);
    const float sc = normalize ? 1.0f / sqrtf(s * (1.0f / DM) + EPS) : 1.0f;
    GAS u32x2* o8 = (GAS u32x2*)orow + lane;
#pragma unroll
    for (int j = 0; j < 8; ++j) o8[64 * j] = pg8::pack4(v[j] * sc);
    return s;
}
__device__ __forceinline__ void router_token(const float* xrow, const float* gain, const float* R, const float* rb, int tok, unsigned* cnt, int* list, int* toke, int* toks, float* tokw, int lane) {
    float lg[8] = {0.f, 0.f, 0.f, 0.f, 0.f, 0.f, 0.f, 0.f}; float ssq = 0.f;
#pragma unroll
    for (int j = 0; j < 8; ++j) { const int k0 = 256 * j + 4 * lane; const f32x4 xv = *(const f32x4*)(xrow + k0), gv = *(const f32x4*)(gain + k0); ssq += pg8::sq4(xv);
#pragma unroll
        for (int e = 0; e < 4; ++e) { const float h = xv[e] * gv[e]; const f32x4 r0 = *(const f32x4*)(R + (size_t)(k0 + e) * 8), r1 = *(const f32x4*)(R + (size_t)(k0 + e) * 8 + 4);
            lg[0] += h * r0[0]; lg[1] += h * r0[1]; lg[2] += h * r0[2]; lg[3] += h * r0[3]; lg[4] += h * r1[0]; lg[5] += h * r1[1]; lg[6] += h * r1[2]; lg[7] += h * r1[3]; } }
    ssq = wave_sum(ssq); const float rstd = 1.0f / sqrtf(ssq * (1.0f / DM) + EPS);
#pragma unroll
    for (int e = 0; e < 8; ++e) lg[e] = wave_sum(lg[e]) * rstd + rb[e];
    if (lane == 0) {
        int i1 = 0; float v1 = lg[0];
#pragma unroll
        for (int e = 1; e < 8; ++e) if (lg[e] > v1) { v1 = lg[e]; i1 = e; }
        int i2 = -1; float v2 = -3.0e38f;
#pragma unroll
        for (int e = 0; e < 8; ++e) if (e != i1 && lg[e] > v2) { v2 = lg[e]; i2 = e; }
        const float w1 = 1.0f / (1.0f + expf(v2 - v1)), w2 = 1.0f - w1;
        const int s1 = (int)atomicAdd(cnt + 64 * i1, 1u), s2 = (int)atomicAdd(cnt + 64 * i2, 1u);
        list[i1 * SEQ + s1] = tok; list[i2 * SEQ + s2] = tok;
        toke[2 * tok] = i1; toke[2 * tok + 1] = i2; toks[2 * tok] = s1; toks[2 * tok + 1] = s2; tokw[2 * tok] = w1; tokw[2 * tok + 1] = w2;
    }
}
#ifndef MK_PHMASK
#define MK_PHMASK 0xFFFFFFFFu
#endif
#define PH_ON(id) (((MK_PHMASK) >> (id)) & 1u)
constexpr int NWAVES = 8;
constexpr int NPH = 17;
struct Args { const void* in[34]; float* out; unsigned char* ws; int ph_lo, ph_hi; };
static_assert(sizeof(Args) == 34 * 8 + 8 + 8 + 8, "Args has no padding");


__global__ void __launch_bounds__(NWAVES * 64, 2) fwd(Args args) {
    extern __shared__ __attribute__((aligned(16))) unsigned char lds_raw[];
    LAS unsigned char* lds = (LAS unsigned char*)lds_raw;
    volatile LAS unsigned* MISC = (volatile LAS unsigned*)(lds + MISC_OFF);
    const int tid = threadIdx.x, lane = tid & 63, wave = __builtin_amdgcn_readfirstlane(tid >> 6);
    const int G = gridDim.x, bid = blockIdx.x, vcu = (G % 8 == 0) ? (bid % 8) * (G / 8) + bid / 8 : bid;
    const int gw = vcu * NWAVES + wave, NGW = G * NWAVES;
    unsigned char* ws = args.ws;
    gu32* ctl = (gu32*)ws;
    float* SS = (float*)(ws + WS.ssp);
    for (int i = tid; i < 64; i += NWAVES * 64) MISC[i] = 0u;
    __syncthreads();
    XcdBarrier bar; bar.bar = (unsigned*)ctl + CW_BAR; bar.x = 0; bar.st = nullptr;
#if !MK_PER_PHASE
    bar = xcd_barrier_post((unsigned*)ctl + CW_BAR, MISC + 8);
#define GRID_BAR() xcd_barrier(bar)
#else
#define GRID_BAR() do { } while (0)
#endif
    const int lo = args.ph_lo, hi = args.ph_hi;
#define IN(k) (lo <= (k) && (k) < hi)
#define BOTH(k) (IN(k) && IN((k) + 1))
    const float* x_in = (const float*)args.in[0]; const float* mem_in = (const float*)args.in[1]; const int* pos = (const int*)args.in[2];
    const float* norm_mix = (const float*)args.in[3]; const float* w_in = (const float*)args.in[4];
    const float* s5_a_re = (const float*)args.in[5]; const float* s5_a_im = (const float*)args.in[6]; const float* s5_log_dt = (const float*)args.in[7];
    const float* s5_b_re = (const float*)args.in[8]; const float* s5_b_im = (const float*)args.in[9]; const float* s5_c_re = (const float*)args.in[10]; const float* s5_c_im = (const float*)args.in[11];
    const float* s5_d = (const float*)args.in[12]; const float* s5_w_glu = (const float*)args.in[13];
    const float* q_a_norm = (const float*)args.in[14]; const float* w_q_b = (const float*)args.in[15]; const float* kv_norm = (const float*)args.in[16]; const float* w_kv_b = (const float*)args.in[17];
    const float* q_norm = (const float*)args.in[18]; const float* k_norm = (const float*)args.in[19]; const float* mla_w_o = (const float*)args.in[20];
    const float* mem_norm = (const float*)args.in[21]; const float* mem_w_kv = (const float*)args.in[22]; const float* mem_q_norm = (const float*)args.in[23]; const float* mem_k_norm = (const float*)args.in[24];
    const float* mem_w_o = (const float*)args.in[25]; const float* w_out = (const float*)args.in[26]; const float* norm_ffn = (const float*)args.in[27];
    const float* ffn_gu = (const float*)args.in[28]; const float* ffn_dn = (const float*)args.in[29]; const float* moe_router = (const float*)args.in[30]; const float* moe_rb = (const float*)args.in[31];
    const float* moe_gu = (const float*)args.in[32]; const float* moe_dn = (const float*)args.in[33];
    float* OUT = args.out;
    bf16* XB = (bf16*)(ws + WS.xb); bf16* Ub = (bf16*)(ws + WS.u); bf16* CQ = (bf16*)(ws + WS.cq); bf16* CKV = (bf16*)(ws + WS.ckv); float* KR = (float*)(ws + WS.kr);
    bf16* QM = (bf16*)(ws + WS.qm); bf16* GT = (bf16*)(ws + WS.gt); bf16* Qh = (bf16*)(ws + WS.q); bf16* Kh = (bf16*)(ws + WS.kk); bf16* Vh = (bf16*)(ws + WS.vv);
    bf16* OA = (bf16*)(ws + WS.oa); bf16* OM = (bf16*)(ws + WS.om); bf16* YS = (bf16*)(ws + WS.ys); float* ES = (float*)(ws + WS.es); float* MF = (float*)(ws + WS.mf); bf16* MB = (bf16*)(ws + WS.mb);
    bf16* ACT = (bf16*)(ws + WS.act); bf16* YM = (bf16*)(ws + WS.ym); bf16* KMEM = (bf16*)(ws + WS.kmem); bf16* VMEM = (bf16*)(ws + WS.vmem); bf16* MEMB = (bf16*)(ws + WS.memb);
    float* ROPEC = (float*)(ws + WS.ropec); float* ROPES = (float*)(ws + WS.ropes);
    int* LIST = (int*)(ws + WS.list); int* TOKE = (int*)(ws + WS.toke); int* TOKS = (int*)(ws + WS.toks); float* TOKW = (float*)(ws + WS.tokw); int* TMIN = (int*)(ws + WS.tmm); int* TMAX = TMIN + 128;
    unsigned* CNT = (unsigned*)ctl + CW_CNT;

    if (PH_ON(0) && IN(0)) {
        const int lane = fresh_tid() & 63;
        LAS float* scr = (LAS float*)(lds + wave * 16640);
        transpose_job(w_in, (size_t)DM * IN_COLS, IN_COLS, DM, (bf16*)(ws + WS.w_in[0]), (WS.w_in[1] - WS.w_in[0]) / 2, DM, INP, norm_mix, DM, 2, MapInProj{}, scr, gw, NGW, lane);
        transpose_job(s5_w_glu, (size_t)S5W * 4096, 4096, S5W, (bf16*)(ws + WS.w_glu[0]), (WS.w_glu[1] - WS.w_glu[0]) / 2, S5W, 4096, nullptr, 0, 2, MapGlu{2048}, scr, gw, NGW, lane);
        transpose_job(w_q_b, (size_t)QRANK * 3072, 3072, QRANK, (bf16*)(ws + WS.w_qb[0]), (WS.w_qb[1] - WS.w_qb[0]) / 2, 512, 4096, q_a_norm, QRANK, 2, MapQB{}, scr, gw, NGW, lane);
        transpose_job(w_kv_b, (size_t)KVRANK * 4096, 4096, KVRANK, (bf16*)(ws + WS.w_kvb[0]), (WS.w_kvb[1] - WS.w_kvb[0]) / 2, 512, 4096, kv_norm, KVRANK, 2, MapId{}, scr, gw, NGW, lane);
        transpose_job(mla_w_o, (size_t)DM * DM, DM, DM, (bf16*)(ws + WS.w_mo[0]), (WS.w_mo[1] - WS.w_mo[0]) / 2, DM, DM, nullptr, 0, 2, MapId{}, scr, gw, NGW, lane);
        transpose_job(mem_w_kv, (size_t)DM * DM, DM, DM, (bf16*)(ws + WS.w_mkv[0]), (WS.w_mkv[1] - WS.w_mkv[0]) / 2, DM, DM, mem_norm, DM, 2, MapId{}, scr, gw, NGW, lane);
        transpose_job(mem_w_o, (size_t)MEMW * DM, DM, MEMW, (bf16*)(ws + WS.w_mwo[0]), (WS.w_mwo[1] - WS.w_mwo[0]) / 2, MEMW, DM, nullptr, 0, 2, MapId{}, scr, gw, NGW, lane);
        transpose_job(w_out, (size_t)DM * DM, DM, DM, (bf16*)(ws + WS.w_out[0]), (WS.w_out[1] - WS.w_out[0]) / 2, DM, DM, nullptr, 0, 2, MapId{}, scr, gw, NGW, lane);
        transpose_job(ffn_gu, 0, 2 * DFF, DM, (bf16*)(ws + WS.w_gu), 0, DM, 2 * DFF, norm_ffn, 0, 1, MapGlu{DFF}, scr, gw, NGW, lane);
        transpose_job(ffn_dn, 0, DM, DFF, (bf16*)(ws + WS.w_dn), 0, DFF, DM, nullptr, 0, 1, MapId{}, scr, gw, NGW, lane);
        transpose_job(moe_gu, (size_t)DM * 2 * DFF, 2 * DFF, DM, (bf16*)(ws + WS.w_egu), (size_t)2 * DFF * DM, DM, 2 * DFF, norm_ffn + DM, 0, NE, MapGlu{DFF}, scr, gw, NGW, lane);
        transpose_job(moe_dn, (size_t)DFF * DM, DM, DFF, (bf16*)(ws + WS.w_edn), (size_t)DM * DFF, DFF, DM, nullptr, 0, NE, MapId{}, scr, gw, NGW, lane);
        for (int i = gw * 64 + lane; i < SEQ * 32; i += NGW * 64) { const int t = i >> 5, j = i & 31; const float inv = powf(10000.0f, -(float)(2 * j) / 64.0f); const float ang = (float)pos[t] * inv;
            ROPEC[i] = cosf(ang); ROPES[i] = sinf(ang); }
        for (int t = gw; t < 128; t += NGW) { int v = pos[64 * t + lane], mn = v, mx = v;
#pragma unroll
            for (int o_ = 1; o_ < 64; o_ <<= 1) { mn = min(mn, __shfl_xor(mn, o_)); mx = max(mx, __shfl_xor(mx, o_)); }
            if (lane == 0) { TMIN[t] = mn; TMAX[t] = mx; } }
        for (int i = gw * 64 + lane; i < 2 * S5G * S5P; i += NGW * 64) { const int l = i / (S5G * S5P), gp = i % (S5G * S5P), g = gp / S5P, p = gp % S5P;
            const float are = s5_a_re[i], aim = s5_a_im[i], dt = expf(s5_log_dt[l * S5G + g]);
            const float mag = expf(dt * are), lr = mag * cosf(dt * aim), li = mag * sinf(dt * aim);
            ((f32x2*)(ws + WS.lam[l]))[gp] = (f32x2){lr, li};
            const float den = are * are + aim * aim, nr = lr - 1.0f, ni = li, fr = (nr * are + ni * aim) / den, fi = (ni * are - nr * aim) / den;
            bf16* bbr = (bf16*)(ws + WS.bb[l]) + ((size_t)(g * 128 + p)) * 16; bf16* bbi = bbr + 64 * 16;
            const float* bre = s5_b_re + (size_t)i * S5H; const float* bim = s5_b_im + (size_t)i * S5H;
#pragma unroll
            for (int h = 0; h < S5H; ++h) { bbr[h] = (bf16)f2bf(fr * bre[h] - fi * bim[h]); bbi[h] = (bf16)f2bf(fr * bim[h] + fi * bre[h]); }
            bf16* cp = (bf16*)(ws + WS.cp[l]) + (size_t)g * 16 * 128;
#pragma unroll
            for (int h = 0; h < S5H; ++h) { const size_t ci = ((size_t)(l * S5G + g) * S5H + h) * S5P + p; cp[h * 128 + p] = (bf16)f2bf(s5_c_re[ci]); cp[h * 128 + 64 + p] = (bf16)f2bf(-s5_c_im[ci]); } }
        for (int m = gw; m < SEQ; m += NGW) { const float s = row_to_bf16(x_in + (size_t)m * DM, XB + (size_t)m * DM, false, lane); if (lane < 32) SS[SS_X + (size_t)m * 32 + lane] = lane == 0 ? s : 0.f; }
        for (int m = gw; m < NMEM; m += NGW) (void)row_to_bf16(mem_in + (size_t)m * DM, MEMB + (size_t)m * DM, true, lane);
        if (BOTH(0)) GRID_BAR();
    }

    for (int l = 0; l < DEPTH; ++l) {
        const int pb = 1 + 7 * l;
        const float* ssx_mix = SS + SS_X + (size_t)(2 * l) * SEQ * 32; float* ssx_ffn = SS + SS_X + (size_t)(2 * l + 1) * SEQ * 32;
        if (IN(pb + 0)) {
            if constexpr (PH_ON(1)) { pg8::Gemm g{XB, (const bf16*)(ws + WS.w_in[l]), DM, DM, DM}; pg8::StaticOrder S; S.init(SEQ / 256, INP / 256, G, bid);
              pg8::EpiInProj E{ssx_mix, Ub, CQ, CKV, QM, GT, KR, SS + SS_CQ + (size_t)l * SEQ * 8, SS + SS_CKV + (size_t)l * SEQ * 8, SS + SS_KR + (size_t)l * SEQ * 4, mem_q_norm + l * MEMD};
              pg8::gemm_phase(lds, g, S, E); }
            if constexpr (PH_ON(18)) if (l == 0) { pg8::Gemm g{MEMB, (const bf16*)(ws + WS.w_mkv[0]), DM, DM, DM}; pg8::MemKvOrder S{G, bid};
              pg8::EpiMemKV E{{mem_k_norm, mem_k_norm + MEMD}, KMEM, VMEM};
              pg8::gemm_phase(lds, g, S, E); }
            if (BOTH(pb + 0)) GRID_BAR();
        }
        if (IN(pb + 1)) {
            if constexpr (PH_ON(12)) { pg8::Gemm g{CQ, (const bf16*)(ws + WS.w_qb[l]), 512, 512, 512}; pg8::StaticOrder S; S.init(SEQ / 256, NH, G, bid);
              pg8::EpiQ E{SS + SS_CQ + (size_t)l * SEQ * 8, q_norm + l * DQK, ROPEC, ROPES, Qh};
              pg8::gemm_phase(lds, g, S, E); }
            if constexpr (PH_ON(13)) { pg8::Gemm g{CKV, (const bf16*)(ws + WS.w_kvb[l]), 512, 512, 512}; pg8::StaticOrder S; S.init(SEQ / 256, NH, G, bid);
              pg8::EpiKV E{SS + SS_CKV + (size_t)l * SEQ * 8, SS + SS_KR + (size_t)l * SEQ * 4, k_norm + l * DQK, KR, ROPEC, ROPES, Kh, Vh};
              pg8::gemm_phase(lds, g, S, E); }
            if constexpr (PH_ON(14)) for (int it = gw; it < S5G * 32; it += NGW)
                s5::s5_wave<1>((char*)lds_raw + wave * s5::WAVE_LDS, it >> 5, (it & 31) * 4, Ub, (const f32x2*)(ws + WS.lam[l]), (const bf16*)(ws + WS.bb[l]), (const bf16*)(ws + WS.cp[l]), s5_d + l * S5W, ES, YS, fresh_tid() & 63);
            __syncthreads();
            if constexpr (PH_ON(15)) for (int it = vcu; it < MEMH * 32 * 2; it += G) { const int h = it >> 6, qb = (it & 63) >> 1, dvh = it & 1;
                attn::attn_item<MEMD, false, MEMW, MEMD, MEMW, false>((char*)lds_raw, lds, QM + (size_t)qb * 256 * MEMW + h * MEMD, KMEM + ((size_t)l * MEMH + h) * NMEM * MEMD, VMEM + ((size_t)l * MEMH + h) * NMEM * MEMD + dvh * 128,
                                             OM + (size_t)qb * 256 * MEMW + h * MEMD + dvh * 128, nullptr, qb * 256, NMEM / 64, nullptr, nullptr); }
            if (BOTH(pb + 1)) GRID_BAR();
        }
        if (IN(pb + 2)) {
            if constexpr (PH_ON(16)) for (int it = vcu; it < NH * 16; it += G) { const int h = it >> 4, pr = it & 15;
#pragma unroll 1
                for (int pass = 0; pass < 2; ++pass) { const int qb = pass ? pr : 31 - pr;
                    attn::attn_item<DQK, true, DQK, DV, DM, true>((char*)lds_raw, lds, Qh + ((size_t)h * SEQ + qb * 256) * DQK, Kh + (size_t)h * SEQ * DQK, Vh + (size_t)h * SEQ * DV,
                                               OA + (size_t)qb * 256 * DM + h * DV, pos, qb * 256, SEQ / 64, TMIN, TMAX); } }
            if constexpr (PH_ON(17)) for (int it = gw; it < S5G * 32; it += NGW)
                s5::s5_wave<2>((char*)lds_raw + wave * s5::WAVE_LDS, it >> 5, (it & 31) * 4, Ub, (const f32x2*)(ws + WS.lam[l]), (const bf16*)(ws + WS.bb[l]), (const bf16*)(ws + WS.cp[l]), s5_d + l * S5W, ES, YS, fresh_tid() & 63);
            __syncthreads();
            if (BOTH(pb + 2)) GRID_BAR();
        }
        if (IN(pb + 3)) {
            if constexpr (PH_ON(4)) { pg8::Gemm g{OA, (const bf16*)(ws + WS.w_mo[l]), DM, DM, DM}; pg8::StaticOrder S; S.init(SEQ / 256, DM / 256, G, bid); pg8::EpiMerge<1> E{GT, MF}; pg8::gemm_phase(lds, g, S, E); }
            if constexpr (PH_ON(19)) { pg8::Gemm g{OM, (const bf16*)(ws + WS.w_mwo[l]), MEMW, MEMW, MEMW}; pg8::StaticOrder S; S.init(SEQ / 256, DM / 256, G, bid); pg8::EpiMerge<2> E{GT, MF}; pg8::gemm_phase(lds, g, S, E); }
            if constexpr (PH_ON(20)) { pg8::Gemm g{YS, (const bf16*)(ws + WS.w_glu[l]), S5W, S5W, S5W}; pg8::GluOrder S; S.init(SEQ / 256, DM / 256, G, bid); pg8::EpiGlu E{GT, MF, MB}; pg8::gemm_phase(lds, g, S, E); }
            if (BOTH(pb + 3)) GRID_BAR();
        }
        if (PH_ON(5) && IN(pb + 4)) {
            pg8::Gemm g{MB, (const bf16*)(ws + WS.w_out[l]), DM, DM, DM}; pg8::StaticOrder S; S.init(SEQ / 256, DM / 256, G, bid);
            pg8::EpiResid E{l == 0 ? x_in : OUT, OUT, XB, ssx_ffn}; pg8::gemm_phase(lds, g, S, E);
            if (BOTH(pb + 4)) GRID_BAR();
        }
        if (l == 0) {
            if (PH_ON(6) && IN(pb + 5)) {
                pg8::Gemm g{XB, (const bf16*)(ws + WS.w_gu), DM, DM, DM}; pg8::StaticOrder S; S.init(SEQ / 256, 2 * DFF / 256, G, bid);
                pg8::EpiSwiGLU<pg8::StaticOrder> E{ssx_ffn, ACT, &S, false}; pg8::gemm_phase(lds, g, S, E);
                if (BOTH(pb + 5)) GRID_BAR();
            }
            if (PH_ON(7) && IN(pb + 6)) {
                pg8::Gemm g{ACT, (const bf16*)(ws + WS.w_dn), DFF, DFF, DFF}; pg8::StaticOrder S; S.init(SEQ / 256, DM / 256, G, bid);
                pg8::EpiResid E{OUT, OUT, XB, SS + SS_X + (size_t)2 * SEQ * 32}; pg8::gemm_phase(lds, g, S, E);
                if (BOTH(pb + 6)) GRID_BAR();
            }
        } else {
            LAS int* MT = (LAS int*)(lds + MISC_OFF + 64);
#define MOE_TABLE() do { if (tid == 0) { int p = 0; for (int e = 0; e < NE; ++e) { const int c_ = (int)__hip_atomic_load(CNT + 64 * e, RLX_AGENT); MT[e] = p; MT[16 + e] = c_; p += (c_ + 255) >> 8; } MT[8] = p; } __syncthreads(); } while (0)
            if (PH_ON(8) && IN(pb + 5)) {
                const int lane = fresh_tid() & 63;
                for (int t = gw; t < SEQ; t += NGW) router_token(OUT + (size_t)t * DM, norm_ffn + DM, moe_router, moe_rb, t, CNT, LIST, TOKE, TOKS, TOKW, lane);
                if (BOTH(pb + 5)) GRID_BAR();
            }
            if (PH_ON(9) && IN(pb + 6)) {
                MOE_TABLE();
                typedef pg8::MoeOrder<true, 1> Ord;
                pg8::Gemm g{XB, (const bf16*)(ws + WS.w_egu), DM, DM, DM}; Ord S{MT, LIST, 2 * DFF / 256, G, bid, (size_t)2 * DFF * DM * 2};
                pg8::EpiSwiGLU<Ord> E{ssx_ffn, ACT, &S, true}; pg8::gemm_phase(lds, g, S, E);
                if (BOTH(pb + 6)) GRID_BAR();
            }
            if (PH_ON(10) && IN(pb + 7)) {
                MOE_TABLE();
                typedef pg8::MoeOrder<false, KSPLIT> Ord;
                pg8::Gemm g{ACT, (const bf16*)(ws + WS.w_edn), DFF, DFF, DFF / KSPLIT}; Ord S{MT, LIST, DM / 256, G, bid, (size_t)DM * DFF * 2};
                pg8::EpiMoeDown E{YM}; pg8::gemm_phase(lds, g, S, E);
                if (BOTH(pb + 7)) GRID_BAR();
            }
            if (PH_ON(11) && IN(pb + 8)) {
                MOE_TABLE();
                const int lane = fresh_tid() & 63;
                for (int t = gw; t < SEQ; t += NGW) {
                    const int e1 = TOKE[2 * t], e2 = TOKE[2 * t + 1]; const size_t r1 = (size_t)MT[e1] * 256 + TOKS[2 * t], r2 = (size_t)MT[e2] * 256 + TOKS[2 * t + 1];
                    const float w1 = TOKW[2 * t], w2 = TOKW[2 * t + 1];
#pragma unroll
                    for (int j = 0; j < 4; ++j) { const int c = 512 * j + 8 * lane; float* op = OUT + (size_t)t * DM + c; f32x4 a = *(const f32x4*)op, b = *(const f32x4*)(op + 4);
#pragma unroll
                        for (int ks = 0; ks < KSPLIT; ++ks) { const u32x4 y1 = *(const u32x4*)(YM + ((size_t)ks * ACT_ROWS + r1) * DM + c), y2 = *(const u32x4*)(YM + ((size_t)ks * ACT_ROWS + r2) * DM + c);
                            a[0] += w1 * bflo(y1.x) + w2 * bflo(y2.x); a[1] += w1 * bfhi(y1.x) + w2 * bfhi(y2.x); a[2] += w1 * bflo(y1.y) + w2 * bflo(y2.y); a[3] += w1 * bfhi(y1.y) + w2 * bfhi(y2.y);
                            b[0] += w1 * bflo(y1.z) + w2 * bflo(y2.z); b[1] += w1 * bfhi(y1.z) + w2 * bfhi(y2.z); b[2] += w1 * bflo(y1.w) + w2 * bflo(y2.w); b[3] += w1 * bfhi(y1.w) + w2 * bfhi(y2.w); }
                        *(f32x4*)op = a; *(f32x4*)(op + 4) = b; } }
            }
        }
    }
#undef IN
#undef BOTH
}

extern "C" void kernel_launch(void* const* d_in, const int* in_sizes, int n_in, void* d_out, int out_size, void* d_ws, size_t ws_size, hipStream_t stream) {
    static int grid = 0;
    if (grid == 0) {
        if (n_in != 34 || in_sizes[0] != SEQ * DM || out_size != SEQ * DM || ws_size < WS.end) {
            fprintf(stderr, "kernel_launch: shape mismatch: n_in %d in0 %d out %d ws %zu (need %zu)\n", n_in, n_in > 0 ? in_sizes[0] : -1, out_size, ws_size, (size_t)WS.end); grid = -1; return; }
        int dev = 0, cus = 0;
        if (hipGetDevice(&dev) != hipSuccess || hipDeviceGetAttribute(&cus, hipDeviceAttributeMultiprocessorCount, dev) != hipSuccess) { grid = -1; return; }
        if (hipFuncSetAttribute((const void*)fwd, hipFuncAttributeMaxDynamicSharedMemorySize, LDS_BYTES) != hipSuccess) { fprintf(stderr, "kernel_launch: hipFuncSetAttribute failed\n"); grid = -1; return; }
        int per_cu = 0;
        if (hipOccupancyMaxActiveBlocksPerMultiprocessor(&per_cu, (const void*)fwd, NWAVES * 64, LDS_BYTES) != hipSuccess || per_cu < 1) fprintf(stderr, "kernel_launch: occupancy query says %d\n", per_cu);
        (void)hipGetLastError();
        grid = cus;
    }
    if (grid < 0) return;
    (void)hipMemsetAsync(d_ws, 0, CTL_BYTES, stream);
    Args a{};
    for (int i = 0; i < 34; ++i) a.in[i] = d_in[i];
    a.out = (float*)d_out; a.ws = (unsigned char*)d_ws;
#if MK_PER_PHASE
#if MK_CHECK == 2
    (void)hipMemsetAsync((unsigned char*)d_ws + WS.end, 0, 4096, stream);
    for (int pass = 0; pass < 2; ++pass) {
        if (pass) (void)hipMemsetAsync(d_ws, 0, CTL_BYTES, stream);
        for (int p = 0; p < NPH; ++p) { a.ph_lo = p; a.ph_hi = p + 1; hipLaunchKernelGGL(fwd, dim3(grid), dim3(NWAVES * 64), LDS_BYTES, stream, a); diff_after_phase(pass, p, a, ws_size, stream); }
    }
    hipLaunchKernelGGL(diff_final, dim3(1024), dim3(256), 0, stream, (const float*)((unsigned char*)d_ws + WS.end), (float*)d_out);
#else
    for (int p = 0; p < NPH; ++p) { a.ph_lo = p; a.ph_hi = p + 1;
#if MK_CHECK == 1
        launch_checks_pre(p, a, stream);
#endif
        hipLaunchKernelGGL(fwd, dim3(grid), dim3(NWAVES * 64), LDS_BYTES, stream, a);
#if MK_CHECK == 1
        launch_checks(p, a, stream);
#endif
    }
#if MK_CHECK == 1
    launch_check_final(a, stream);
#endif
#endif
#else
    a.ph_lo = 0; a.ph_hi = NPH; hipLaunchKernelGGL(fwd, dim3(grid), dim3(NWAVES * 64), LDS_BYTES, stream, a);
#endif
    const hipError_t le = hipPeekAtLastError();
    if (le != hipSuccess) fprintf(stderr, "kernel_launch: launch failed: %s\n", hipGetErrorName(le));
}
```

```cpp
#include <hip/hip_runtime.h>
#include <cstdio>
#include <cstdint>

#ifndef MK_PER_PHASE
#define MK_PER_PHASE 0
#endif
#ifndef MK_CHECK
#define MK_CHECK 0
#endif

constexpr int SEQ = 8192, DM = 2048, DEPTH = 2, NMEM = 256;
constexpr int S5W = 1024, S5G = 64, S5H = 16, S5P = 64;
constexpr int NH = 16, QRANK = 448, KVRANK = 512, DNOPE = 128, DROPE = 64, DQK = 192, DV = 128;
constexpr int MEMH = 4, MEMD = 256, MEMW = 1024;
constexpr int DFF = 7168, NE = 8;
constexpr int INP = 9472;
constexpr int IN_COLS = 9216;
constexpr float EPS = 1e-6f;
constexpr float LOG2E = 1.4426950408889634f;
constexpr int ACT_ROWS = 2 * SEQ + NE * 256;
constexpr int KSPLIT = 4;

typedef unsigned short bf16;
typedef short bf16x8 __attribute__((ext_vector_type(8)));
typedef short s16x4 __attribute__((ext_vector_type(4)));
typedef float f32x4 __attribute__((ext_vector_type(4)));
typedef float f32x2 __attribute__((ext_vector_type(2)));
typedef float f32x16 __attribute__((ext_vector_type(16)));
typedef unsigned u32x4 __attribute__((ext_vector_type(4)));
typedef unsigned u32x2 __attribute__((ext_vector_type(2)));
#define GAS __attribute__((address_space(1)))
#define LAS __attribute__((address_space(3)))
typedef GAS unsigned gu32;
#define RLX_AGENT __ATOMIC_RELAXED, __HIP_MEMORY_SCOPE_AGENT
#define LDS_WAIT() asm volatile("s_waitcnt lgkmcnt(0)" ::: "memory")
#define VM_WAIT() asm volatile("s_waitcnt vmcnt(0)" ::: "memory")
#define SBAR() __builtin_amdgcn_sched_barrier(0)

typedef __bf16 bf16x2_t __attribute__((ext_vector_type(2)));
__device__ __forceinline__ unsigned cvt_pk_bf16(float lo, float hi) { f32x2 v = {lo, hi}; bf16x2_t b = __builtin_convertvector(v, bf16x2_t); return __builtin_bit_cast(unsigned, b); }
__device__ __forceinline__ unsigned f2bf(float f) { unsigned u = __builtin_bit_cast(unsigned, f); return (u + 0x7fffu + ((u >> 16) & 1u)) >> 16; }
__device__ __forceinline__ unsigned pk2(float lo, float hi) { return f2bf(lo) | (f2bf(hi) << 16); }
__device__ __forceinline__ float bf2f(unsigned short b) { return __builtin_bit_cast(float, ((unsigned)b) << 16); }
__device__ __forceinline__ float bflo(unsigned w) { return __builtin_bit_cast(float, w << 16); }
__device__ __forceinline__ float bfhi(unsigned w) { return __builtin_bit_cast(float, w & 0xffff0000u); }
__device__ __forceinline__ float sigmoidf_(float x) { return __builtin_amdgcn_rcpf(1.f + __builtin_amdgcn_exp2f(-x * LOG2E)); }
__device__ __forceinline__ int fresh_tid() { int t = threadIdx.x; asm volatile("" : "+v"(t)); return t; }
template <int N> __device__ __forceinline__ float sum_slots(const float* p) { f32x4 a = *(const f32x4*)p;
#pragma unroll
    for (int i = 1; i < N / 4; ++i) a = a + *(const f32x4*)(p + 4 * i);
    return (a[0] + a[1]) + (a[2] + a[3]); }
__device__ __forceinline__ float wave_sum(float v) {
#pragma unroll
    for (int o = 1; o < 64; o <<= 1) v += __shfl_xor(v, o);
    return v;
}

constexpr size_t al256(size_t x) { return (x + 255) & ~(size_t)255; }
constexpr size_t CTL_BYTES = 2u << 20;
constexpr int CW_TMO = 0, CW_CODE = 1;
constexpr int CW_BAR = 4096;
constexpr int CW_CNT = 8192;
constexpr int CW_CHK = 12288;
constexpr int SS_X = 0;
constexpr int SS_CQ = 4 * SEQ * 32;
constexpr int SS_CKV = SS_CQ + 2 * SEQ * 8;
constexpr int SS_KR = SS_CKV + 2 * SEQ * 8;
constexpr int SS_FLOATS = SS_KR + 2 * SEQ * 4;

struct WsMap {
    size_t w_in[2], w_glu[2], w_qb[2], w_kvb[2], w_mo[2], w_mkv[2], w_mwo[2], w_out[2], w_gu, w_dn, w_egu, w_edn;
    size_t xb, u, cq, ckv, kr, qm, gt, q, kk, vv, oa, om, ys, es, mf, mb, act, ym, kmem, vmem, memb, ropec, ropes;
    size_t lam[2], bb[2], cp[2], list, toke, toks, tokw, tmm, ssp, xq, rsc, wsc, act8, rsc2, gsc, w_inq[2], rss, end;
};
constexpr WsMap make_map() {
    WsMap m{}; size_t o = CTL_BYTES;
    auto take = [&](size_t bytes) { size_t r = o; o = al256(o + bytes); return r; };
    for (int l = 0; l < 2; ++l) {
        m.w_in[l] = take((size_t)INP * DM * 2); m.w_glu[l] = take((size_t)4096 * S5W * 2); m.w_qb[l] = take((size_t)4096 * 512 * 2); m.w_kvb[l] = take((size_t)4096 * 512 * 2);
        m.w_mo[l] = take((size_t)DM * DM * 2); m.w_mkv[l] = take((size_t)DM * DM * 2); m.w_mwo[l] = take((size_t)DM * MEMW * 2); m.w_out[l] = take((size_t)DM * DM * 2);
        m.lam[l] = take((size_t)S5G * S5P * 8); m.bb[l] = take((size_t)S5G * 128 * 16 * 2); m.cp[l] = take((size_t)S5G * 16 * 128 * 2);
    }
    m.w_gu = take((size_t)2 * DFF * DM * 2); m.w_dn = take((size_t)DM * DFF * 2);
    m.w_egu = take((size_t)NE * 2 * DFF * DM * 2); m.w_edn = take((size_t)NE * DM * DFF * 2);
    m.xb = take((size_t)SEQ * DM * 2); m.u = take((size_t)SEQ * S5W * 2); m.cq = take((size_t)SEQ * 512 * 2); m.ckv = take((size_t)SEQ * 512 * 2);
    m.kr = take((size_t)SEQ * 64 * 4); m.qm = take((size_t)SEQ * MEMW * 2); m.gt = take((size_t)SEQ * 3 * DM * 2);
    m.q = take((size_t)NH * SEQ * DQK * 2); m.kk = take((size_t)NH * SEQ * DQK * 2); m.vv = take((size_t)NH * SEQ * DV * 2);
    m.oa = take((size_t)SEQ * DM * 2); m.om = take((size_t)SEQ * MEMW * 2); m.ys = take((size_t)SEQ * S5W * 2); m.es = take((size_t)S5G * 128 * 128 * 4);
    m.mf = take((size_t)SEQ * DM * 4); m.mb = take((size_t)SEQ * DM * 2);
    m.act = take((size_t)ACT_ROWS * DFF * 2); m.ym = take((size_t)KSPLIT * ACT_ROWS * DM * 2);
    m.kmem = take((size_t)2 * MEMH * NMEM * MEMD * 2); m.vmem = take((size_t)2 * MEMH * NMEM * MEMD * 2); m.memb = take((size_t)NMEM * DM * 2);
    m.ropec = take((size_t)SEQ * 32 * 4); m.ropes = take((size_t)SEQ * 32 * 4);
    m.list = take((size_t)NE * SEQ * 4); m.toke = take((size_t)SEQ * 2 * 4); m.toks = take((size_t)SEQ * 2 * 4); m.tokw = take((size_t)SEQ * 2 * 4); m.tmm = take(2 * 128 * 4); m.ssp = take((size_t)SS_FLOATS * 4); m.xq = take((size_t)SEQ * DM); m.rsc = take((size_t)SEQ * 4); m.wsc = take(256); m.act8 = take((size_t)ACT_ROWS * DFF); m.rsc2 = take((size_t)ACT_ROWS * 4); m.gsc = take((size_t)NE * DM * 4); m.w_inq[0] = take((size_t)7168 * DM); m.w_inq[1] = take((size_t)7168 * DM); m.rss = take((size_t)NE * SEQ * 4);
    m.end = o; return m;
}
constexpr WsMap WS = make_map();

constexpr int RING_BYTES = 131072;
constexpr int XT_OFF = RING_BYTES;
constexpr int RK_OFF = XT_OFF + 4096;
constexpr int MISC_OFF = RK_OFF + 1024;
constexpr int GOFF_OFF = MISC_OFF + 256;
constexpr int TB2_OFF = GOFF_OFF + 8192;
constexpr int LDS_BYTES = 147456;
static_assert(TB2_OFF + 1024 <= LDS_BYTES, "LDS map");

#define XB_TMO      128
#define XB_XCNT(j)  (256  + 64 * (j))
#define XB_XSUB(j)  (1280 + 64 * (j))
#define XB_XGEN(j)  (2304 + 64 * (j))
#define XB_TOP      3328
#define XB_TOPGEN   3392
#define XCD_BAR_WORDS 3456
#define XB_SPIN_CAP (1u << 18)
__device__ __forceinline__ unsigned xb_ld(unsigned* p)              { return __hip_atomic_load(p, __ATOMIC_RELAXED, __HIP_MEMORY_SCOPE_AGENT); }
__device__ __forceinline__ unsigned xb_add(unsigned* p, unsigned v) { return __hip_atomic_fetch_add(p, v, __ATOMIC_RELAXED, __HIP_MEMORY_SCOPE_AGENT); }
__device__ __forceinline__ unsigned xb_xcc_id() { return (unsigned)__builtin_amdgcn_s_getreg((3 << 11) | 20) & 0xFu; }
#define XB_SPIN(cond, bar) do { unsigned _sp = 0; while (cond) { __builtin_amdgcn_s_sleep(1); \
    if ((++_sp & 255u) == 0u) { if (xb_ld(&(bar)[XB_TMO])) break; if (_sp > XB_SPIN_CAP) { atomicAdd(&(bar)[XB_TMO], 1u); break; } } } } while (0)
struct XcdBarrier { unsigned* bar; unsigned x; volatile LAS unsigned* st; };
__device__ __forceinline__ XcdBarrier xcd_barrier_post(unsigned* bar, volatile LAS unsigned* st) {
    XcdBarrier b; b.bar = bar; b.x = xb_xcc_id(); b.st = st;
    if (threadIdx.x == 0) (void)xb_add(&bar[XB_XCNT(b.x)], 1u);
    return b;
}
__device__ __forceinline__ void xcd_barrier_complete(unsigned* bar, unsigned x, unsigned& nloc, unsigned& nx) {
    const unsigned G = gridDim.x * gridDim.y * gridDim.z;
    unsigned sum, cnt, mine, sp = 0u;
    for (;;) {
        sum = 0u; cnt = 0u; mine = 0u;
#pragma unroll
        for (unsigned j = 0; j < 16; ++j) { const unsigned c = xb_ld(&bar[XB_XCNT(j)]); sum += c; cnt += (c > 0u) ? 1u : 0u; mine = (j == x) ? c : mine; }
        if (sum == G) break;
        __builtin_amdgcn_s_sleep(1);
        if ((++sp & 255u) == 0u) { if (xb_ld(&bar[XB_TMO])) break; if (sp > XB_SPIN_CAP) { atomicAdd(&bar[XB_TMO], 1u); break; } }
    }
    nloc = mine > 0u ? mine : 1u; nx = cnt > 0u ? cnt : 1u;
}
__device__ __forceinline__ void xcd_barrier(const XcdBarrier& b) {
    asm volatile("s_waitcnt vmcnt(0)" ::: "memory");
    __syncthreads();
    if (threadIdx.x == 0) {
        unsigned* bar = b.bar;
        __builtin_amdgcn_s_waitcnt(0);
        unsigned nloc = b.st[0], nx = b.st[1];
        if (nloc == 0u) { xcd_barrier_complete(bar, b.x, nloc, nx); b.st[0] = nloc; b.st[1] = nx; }
        const unsigned old = xb_add(&bar[XB_XSUB(b.x)], 1u);
        const unsigned gen = old / nloc;
        if (old + 1u == (gen + 1u) * nloc) {
            __builtin_amdgcn_fence(__ATOMIC_RELEASE, "agent");
            asm volatile("s_waitcnt vmcnt(0)" ::: "memory");
            const unsigned og = xb_add(&bar[XB_TOP], 1u);
            const unsigned tg = og / nx;
            if (og + 1u == (tg + 1u) * nx) xb_add(&bar[XB_TOPGEN], 1u);
            else XB_SPIN(xb_ld(&bar[XB_TOPGEN]) == tg, bar);
            __builtin_amdgcn_fence(__ATOMIC_ACQUIRE, "agent");
            xb_add(&bar[XB_XGEN(b.x)], 1u);
            asm volatile("s_waitcnt vmcnt(0)" ::: "memory");
        } else {
            XB_SPIN(xb_ld(&bar[XB_XGEN(b.x)]) == gen, bar);
            __builtin_amdgcn_fence(__ATOMIC_ACQUIRE, "agent");
            asm volatile("s_waitcnt vmcnt(0)" ::: "memory");
        }
    }
    __syncthreads();
}
namespace pg8 {
constexpr int BM = 256, BK = 64, HALF = 128, HTB = HALF * BK * 2, STAGE_BYTES = 8 * HTB, NXCD = 8, WGM = 8;
__host__ __device__ __forceinline__ int lds_byte(int r, int c) { const int st = (r >> 4) * 2 + (c >> 5), rr = r & 15, cc = c & 31, ob = rr * 64 + cc * 2; return st * 1024 + (ob ^ (((ob >> 9) & 1) << 5)); }
__host__ __device__ __forceinline__ void stage_rc(int b, int& R, int& C) { const int st = b / 1024, sb = b % 1024, swz = sb ^ (((sb >> 9) & 1) << 5); R = (st >> 1) * 16 + swz / 64; C = (st & 1) * 32 + (swz % 64) / 2; }
__host__ __device__ __forceinline__ int perm32(int rho) { const int n = rho >> 4, i = rho & 15; return 8 * (i >> 2) + 4 * n + (i & 3); }

struct Unit { int pm, pn, e, ks, p0, cnt; };
struct Gemm { const void* A; const void* Bt; int lda, ldb, K, es; };

__device__ __forceinline__ bool static_unit(int L, int nM, int nN, Unit& u) {
    const int nwg = nM * nN; if (L >= nwg) return false;
    int wgid = L; { const int q = nwg / NXCD, r = nwg % NXCD, xcd = wgid % NXCD, off = wgid / NXCD; wgid = (xcd < r ? xcd * (q + 1) : r * (q + 1) + (xcd - r) * q) + off; }
    const int nig = WGM * nN, gid = wgid / nig, fm = gid * WGM, gsz = (nM - fm) < WGM ? (nM - fm) : WGM;
    u.pm = fm + ((wgid % nig) % gsz); u.pn = (wgid % nig) / gsz; return true;
}
struct StaticOrder {
    static constexpr bool GATHER = false;
    int nM, nN, G, c;
    __device__ void init(int nM_, int nN_, int G_, int c_) { nM = nM_; nN = nN_; G = G_; c = c_; }
    __device__ bool next(int i, Unit& u) const { u.e = 0; u.ks = 0; u.p0 = 0; u.cnt = 0; return static_unit(i * G + c, nM, nN, u); }
    __device__ __forceinline__ const char* abase(const Gemm& g, const Unit& u) const { return (const char*)g.A + (size_t)u.pm * BM * g.lda * g.es; }
    __device__ __forceinline__ const char* bbase(const Gemm& g, const Unit& u) const { return (const char*)g.Bt + (size_t)u.pn * BM * g.ldb * g.es; }
    __device__ __forceinline__ unsigned tok(const Unit&, int) const { return 0u; }
};
struct BalOrder {
    static constexpr bool GATHER = false;
    int nM, nN, bid;
    __device__ bool next(int i, Unit& u) const { u.e = 0; u.ks = 0; u.p0 = 0; u.cnt = 0; const int x = bid & 7, j = bid >> 3; int k;
        if (j < 4) { if (i >= 2) return false; k = 2 * j + i; } else if (j < 30) { if (i >= 4) return false; k = 8 + 4 * (j - 4) + i; } else return false;
        return static_unit(x + 8 * k, nM, nN, u); }
    __device__ __forceinline__ const char* abase(const Gemm& g, const Unit& u) const { return (const char*)g.A + (size_t)u.pm * BM * g.lda * g.es; }
    __device__ __forceinline__ const char* bbase(const Gemm& g, const Unit& u) const { return (const char*)g.Bt + (size_t)u.pn * BM * g.ldb * g.es; }
    __device__ __forceinline__ unsigned tok(const Unit&, int) const { return 0u; }
};
struct GluOrder : StaticOrder {
    __device__ bool next(int i, Unit& u) const { u.e = 0; u.ks = 0; u.p0 = 0; u.cnt = 0; if (!static_unit((i >> 1) * G + c, nM, nN, u)) return false; u.pn = 2 * u.pn + (i & 1); return true; }
};
struct MemKvOrder {
    static constexpr bool GATHER = false;
    int G, c;
    __device__ bool next(int i, Unit& u) const { const int L = i * G + c; if (L >= 16) return false; u.pm = 0; u.pn = L & 7; u.e = L >> 3; u.ks = 0; u.p0 = 0; u.cnt = 0; return true; }
    __device__ __forceinline__ const char* abase(const Gemm& g, const Unit&) const { return (const char*)g.A; }
    __device__ __forceinline__ const char* bbase(const Gemm& g, const Unit& u) const { return (const char*)g.Bt + ((size_t)u.e * (WS.w_mkv[1] - WS.w_mkv[0])) + (size_t)u.pn * BM * g.ldb * g.es; }
    __device__ __forceinline__ unsigned tok(const Unit&, int) const { return 0u; }
};
template <bool GATHER_, int NKS> struct MoeOrder {
    static constexpr bool GATHER = GATHER_;
    const LAS int* tab; const int* list; int nN, G, c; size_t bstride; int pbase, pcnt;
    __device__ bool next(int i, Unit& u) const {
        int L = i * G + c; if (L >= pcnt * nN * NKS) return false;
        u.ks = L % NKS; L /= NKS;
        static_unit(L, pcnt, nN, u); u.pm += pbase;
        int e = 0;
#pragma unroll
        for (int j = 1; j < 8; ++j) e += (u.pm >= tab[j]) ? 1 : 0;
        u.e = e; u.p0 = tab[e]; u.cnt = tab[16 + e]; return true;
    }
    __device__ __forceinline__ const char* abase(const Gemm& g, const Unit& u) const { return GATHER_ ? (const char*)g.A : (const char*)g.A + ((size_t)u.pm * BM * g.lda + (size_t)u.ks * g.K) * g.es; }
    __device__ __forceinline__ const char* bbase(const Gemm& g, const Unit& u) const { return (const char*)g.Bt + (size_t)u.e * bstride + ((size_t)u.pn * BM * g.ldb + (size_t)u.ks * g.K) * g.es; }
    __device__ __forceinline__ unsigned tok(const Unit& u, int r) const { const int slot = (u.pm - u.p0) * BM + r; const bool in = slot < u.cnt; const unsigned t = (unsigned)list[u.e * SEQ + (in ? slot : 0)]; return in ? t : 0u; }
};

template <class E> __device__ __forceinline__ auto set_next(const E& e, const Unit& n, bool h, int) -> decltype((void)e.hasnx) { e.nx = n; e.hasnx = h; }
template <class E> __device__ __forceinline__ void set_next(const E&, const Unit&, bool, long) {}
typedef f32x4 Acc[2][2][4][2];

typedef int i32x4 __attribute__((ext_vector_type(4)));
typedef int i32x8 __attribute__((ext_vector_type(8)));
template <class Epi, class Sched, int MODE = 0>
__device__ __forceinline__ void gemm_phase(LAS unsigned char* lds, const Gemm g, const Sched& S, const Epi& E) {
    const int tid = fresh_tid(), wid = __builtin_amdgcn_readfirstlane(tid >> 6), lane = tid & 63, wr = wid >> 2, wc = wid & 3, fr = lane & 15, fq = lane >> 4;
    constexpr int ES = MODE == 0 ? 2 : 1; constexpr bool I8 = MODE == 1, F8 = MODE == 2;
    const int K = g.K, nt = K * ES / (BK * 2);
    unsigned voffA[2], voffB[2];
#pragma unroll
    for (int i = 0; i < 2; ++i) { int R, C; stage_rc(tid * 16 + i * 8192, R, C); const int Rb = Epi::PERM ? ((R & ~31) + perm32(R & 31)) : R;
        voffA[i] = (unsigned)(R * g.lda * ES + C * 2); voffB[i] = (unsigned)(Rb * g.ldb * ES + C * 2); }
    const size_t kstep = (size_t)(BK * 2);
    const size_t hstepA = (size_t)HALF * g.lda * ES, hstepB = (size_t)HALF * g.ldb * ES;
    const unsigned ldsw = (unsigned)wid * 1024u;
    const int aoff = F8 ? lds_byte(wr * 64 + fr, fq * 16) : lds_byte(wr * 64 + fr, fq * 8), boff = F8 ? lds_byte(wc * 32 + fr, fq * 16) : lds_byte(wc * 32 + fr, fq * 8);

    const char* const gA = (const char*)g.A;
#define PG8_SA(b, h) (((b) * 2 + (h)) * HTB)
#define PG8_SB(b, h) ((4 + (b) * 2 + (h)) * HTB)
#define PG8_STAGE(bufoff, gbase, voff) do { _Pragma("unroll") for (int _i = 0; _i < 2; ++_i) \
        __builtin_amdgcn_global_load_lds((const unsigned*)((const char*)(gbase) + (voff)[_i]), (LAS unsigned*)(lds + (bufoff) + ldsw + _i * 8192), 16, 0, 0); } while (0)
#define PG8_STA1(bufoff, h) do { if constexpr (Sched::GATHER) PG8_STAGE(bufoff, gA + ka1, vc[h]); else PG8_STAGE(bufoff, a1 + (h) * hstepA, voffA); } while (0)
#define PG8_STA2(bufoff, h) do { if constexpr (Sched::GATHER) PG8_STAGE(bufoff, gA + ka2, vc[h]); else PG8_STAGE(bufoff, a2 + (h) * hstepA, voffA); } while (0)
#define PG8_STA3(bufoff, h) do { if constexpr (Sched::GATHER) PG8_STAGE(bufoff, gA + ka2 + kstep, vc[h]); else PG8_STAGE(bufoff, a3 + (h) * hstepA, voffA); } while (0)
#define PG8_LDA(dst, b, h) do { if constexpr (F8) { _Pragma("unroll") for (int m = 0; m < 4; ++m) dst##8[m] = *(const LAS i32x8*)(lds + PG8_SA(b, h) + aoff + m * 2048); } \
        else { _Pragma("unroll") for (int m = 0; m < 4; ++m) _Pragma("unroll") for (int k = 0; k < 2; ++k) dst[m][k] = *(const LAS bf16x8*)(lds + PG8_SA(b, h) + aoff + m * 2048 + k * 1024); } } while (0)
#define PG8_LDB(dst, b, h) do { if constexpr (F8) { _Pragma("unroll") for (int n = 0; n < 2; ++n) dst##8[n] = *(const LAS i32x8*)(lds + PG8_SB(b, h) + boff + n * 2048); } \
        else { _Pragma("unroll") for (int n = 0; n < 2; ++n) _Pragma("unroll") for (int k = 0; k < 2; ++k) dst[n][k] = *(const LAS bf16x8*)(lds + PG8_SB(b, h) + boff + n * 2048 + k * 1024); } } while (0)
#define PG8_MMA(ai, bj, At, Bt) do { __builtin_amdgcn_s_setprio(1); \
        if constexpr (F8) { _Pragma("unroll") for (int m = 0; m < 4; ++m) _Pragma("unroll") for (int n = 0; n < 2; ++n) \
            acc[ai][bj][m][n] = __builtin_amdgcn_mfma_scale_f32_16x16x128_f8f6f4(Bt##8[n], At##8[m], acc[ai][bj][m][n], 0, 0, 0, 0x7f7f7f7f, 0, 0x7f7f7f7f); } \
        else { _Pragma("unroll") for (int m = 0; m < 4; ++m) _Pragma("unroll") for (int n = 0; n < 2; ++n) _Pragma("unroll") for (int k = 0; k < 2; ++k) \
        { if constexpr (I8) acc[ai][bj][m][n] = __builtin_bit_cast(f32x4, __builtin_amdgcn_mfma_i32_16x16x64_i8(__builtin_bit_cast(i32x4, Bt[n][k]), __builtin_bit_cast(i32x4, At[m][k]), __builtin_bit_cast(i32x4, acc[ai][bj][m][n]), 0, 0, 0)); \
          else acc[ai][bj][m][n] = __builtin_amdgcn_mfma_f32_16x16x32_bf16(Bt[n][k], At[m][k], acc[ai][bj][m][n], 0, 0, 0); } } __builtin_amdgcn_s_setprio(0); } while (0)
#define PG8_WAIT_V(n) asm volatile("s_waitcnt vmcnt(" #n ")" ::: "memory")
#define PG8_WAIT_L(n) asm volatile("s_waitcnt lgkmcnt(" #n ")" ::: "memory")
#define PG8_BAR __builtin_amdgcn_s_barrier()
#define PG8_SCHED __builtin_amdgcn_sched_barrier(0)
#define PG8_GOFF(dst, u) do { const int _t = fresh_tid(); _Pragma("unroll") for (int _i = 0; _i < 2; ++_i) { int _R, _C; stage_rc(_t * 16 + _i * 8192, _R, _C); _Pragma("unroll") for (int _h = 0; _h < 2; ++_h) \
        dst[_h][_i] = S.tok(u, _h * HALF + _R) * (unsigned)(g.lda * ES) + (unsigned)(_C * 2); } } while (0)
    __builtin_amdgcn_s_waitcnt(0);
    Unit cur, nxt; int ui = 0;
    if (!S.next(0, cur)) return;
    Acc acc;
#pragma unroll
    for (int a = 0; a < 2; ++a)
#pragma unroll
        for (int b = 0; b < 2; ++b)
#pragma unroll
            for (int m = 0; m < 4; ++m)
#pragma unroll
                for (int n = 0; n < 2; ++n) acc[a][b][m][n] = (f32x4){0.f, 0.f, 0.f, 0.f};
    bf16x8 At[4][2], B0[2][2], B1[2][2]; i32x8 At8[4], B08[2], B18[2];
    const char* cA = S.abase(g, cur); const char* cB = S.bbase(g, cur);
    unsigned vc[2][2] = {{0u, 0u}, {0u, 0u}};
    if constexpr (Sched::GATHER) PG8_GOFF(vc, cur);
    {
        const char* a1 = cA; const size_t ka1 = 0;
        PG8_STAGE(PG8_SB(0, 0), cB, voffB); PG8_STAGE(PG8_SB(0, 1), cB + hstepB, voffB); PG8_STA1(PG8_SA(0, 0), 0); PG8_STA1(PG8_SA(0, 1), 1);
        if (wr == 1) PG8_BAR;
        PG8_WAIT_V(2); PG8_BAR;
    }
    {
        const char* a1 = cA + kstep; const size_t ka1 = kstep;
        PG8_STAGE(PG8_SB(1, 0), cB + kstep, voffB); PG8_STA1(PG8_SA(1, 0), 0); PG8_STAGE(PG8_SB(1, 1), cB + hstepB + kstep, voffB);
        PG8_WAIT_V(6); PG8_BAR;
    }
    for (;;) {
        const bool has_next = S.next(ui + 1, nxt);
        const char* nA = has_next ? S.abase(g, nxt) : cA; const char* nB = has_next ? S.bbase(g, nxt) : cB;
        if constexpr (Sched::GATHER) {
            unsigned tn[2][2];
            if (has_next) PG8_GOFF(tn, nxt); else {
#pragma unroll
                for (int _h = 0; _h < 2; ++_h) { tn[_h][0] = vc[_h][0]; tn[_h][1] = vc[_h][1]; } }
            *(LAS u32x4*)(lds + GOFF_OFF + fresh_tid() * 16) = (u32x4){tn[0][0], tn[0][1], tn[1][0], tn[1][1]}; }
        for (int t = 0; t < nt; t += 2) {
            const bool last = (t == nt - 2);
            const char* a1 = cA + (size_t)(t + 1) * kstep; const size_t ka1 = (size_t)(t + 1) * kstep;
            const char* a2 = last ? nA : cA + (size_t)(t + 2) * kstep; const char* b2 = last ? nB : cB + (size_t)(t + 2) * kstep;
            const size_t ka2 = last ? (size_t)0 : (size_t)(t + 2) * kstep;
            const char* a3 = a2 + kstep; const char* b3 = b2 + kstep;
            u32x4 nx_ = {0u, 0u, 0u, 0u};
            if constexpr (Sched::GATHER) { if (last) { nx_ = *(const LAS u32x4*)(lds + GOFF_OFF + fresh_tid() * 16); vc[0][0] = nx_[0]; vc[0][1] = nx_[1]; } }
            PG8_LDB(B0, 0, 0); PG8_LDB(B1, 0, 1); PG8_SCHED; PG8_LDA(At, 0, 0); PG8_STA1(PG8_SA(1, 1), 1);
            if constexpr (Sched::GATHER) { if (last) { vc[1][0] = nx_[2]; vc[1][1] = nx_[3]; } }
            PG8_WAIT_V(8); PG8_WAIT_L(0); PG8_BAR; PG8_MMA(0, 0, At, B0); PG8_MMA(0, 1, At, B1); PG8_BAR; PG8_SCHED;
            PG8_LDA(At, 0, 1); PG8_STAGE(PG8_SB(0, 0), b2, voffB); PG8_STAGE(PG8_SB(0, 1), b2 + hstepB, voffB); PG8_STA2(PG8_SA(0, 0), 0);
            PG8_WAIT_V(8); PG8_WAIT_L(0); PG8_BAR; PG8_MMA(1, 0, At, B0); PG8_MMA(1, 1, At, B1); PG8_BAR; PG8_SCHED;
            PG8_LDB(B0, 1, 0); PG8_LDB(B1, 1, 1); PG8_SCHED; PG8_LDA(At, 1, 0); PG8_STA2(PG8_SA(0, 1), 1);
            PG8_WAIT_V(8); PG8_WAIT_L(0); PG8_BAR; PG8_MMA(0, 0, At, B0); PG8_MMA(0, 1, At, B1); PG8_BAR; PG8_SCHED;
            PG8_LDA(At, 1, 1); PG8_STAGE(PG8_SB(1, 0), b3, voffB); PG8_STAGE(PG8_SB(1, 1), b3 + hstepB, voffB); PG8_STA3(PG8_SA(1, 0), 0);
            PG8_WAIT_V(8); PG8_WAIT_L(0); PG8_BAR; PG8_MMA(1, 0, At, B0); PG8_MMA(1, 1, At, B1); PG8_BAR; PG8_SCHED;
        }
        if (wr == 0) PG8_BAR;
        if constexpr (I8) {
#pragma unroll
            for (int a = 0; a < 2; ++a)
#pragma unroll
                for (int b = 0; b < 2; ++b)
#pragma unroll
                    for (int m = 0; m < 4; ++m)
#pragma unroll
                        for (int n = 0; n < 2; ++n) acc[a][b][m][n] = __builtin_convertvector(__builtin_bit_cast(i32x4, acc[a][b][m][n]), f32x4); }
        { const int t2_ = fresh_tid(), l2_ = t2_ & 63; set_next(E, nxt, has_next, 0); E(acc, cur, wr, wc, l2_ & 15, l2_ >> 4, lds, t2_); }
        if (!has_next) break;
#pragma unroll
        for (int a = 0; a < 2; ++a)
#pragma unroll
            for (int b = 0; b < 2; ++b)
#pragma unroll
                for (int m = 0; m < 4; ++m)
#pragma unroll
                    for (int n = 0; n < 2; ++n) acc[a][b][m][n] = (f32x4){0.f, 0.f, 0.f, 0.f};
        cur = nxt; cA = nA; cB = nB; ++ui;
        if (wr == 1) PG8_BAR;
    }
    PG8_WAIT_V(0);
    PG8_BAR;
#undef PG8_SA
#undef PG8_SB
#undef PG8_STAGE
#undef PG8_STA1
#undef PG8_STA2
#undef PG8_STA3
#undef PG8_LDA
#undef PG8_LDB
#undef PG8_MMA
#undef PG8_WAIT_V
#undef PG8_WAIT_L
#undef PG8_BAR
#undef PG8_SCHED
#undef PG8_GOFF
}

__device__ __forceinline__ unsigned lds_addr(LAS unsigned char* lds, int off) { return (unsigned)(size_t)lds + (unsigned)off; }
__device__ __forceinline__ void lds_w32(unsigned a, float v) { asm volatile("ds_write_b32 %0, %1" :: "v"(a), "v"(v) : "memory"); }
__device__ __forceinline__ float lds_r32(unsigned a) { float r; asm volatile("ds_read_b32 %0, %1\n\ts_waitcnt lgkmcnt(0)" : "=v"(r) : "v"(a) : "memory"); return r; }
__device__ __forceinline__ f32x4 lds_r128(unsigned a) { f32x4 r; asm volatile("ds_read_b128 %0, %1\n\ts_waitcnt lgkmcnt(0)" : "=v"(r) : "v"(a) : "memory"); return r; }
#define EPI_BAR() do { asm volatile("s_waitcnt lgkmcnt(0)" ::: "memory"); __builtin_amdgcn_s_barrier(); asm volatile("" ::: "memory"); } while (0)
__device__ __forceinline__ void rows_allreduce(float (&part)[2][4], LAS unsigned char* lds, int wr, int wc, int fr, int fq) {
    const unsigned xt = lds_addr(lds, XT_OFF);
#pragma unroll
    for (int ai = 0; ai < 2; ++ai)
#pragma unroll
        for (int m = 0; m < 4; ++m) { float s = part[ai][m]; s += __shfl_xor(s, 16); s += __shfl_xor(s, 32);
            if (fq == 0) lds_w32(xt + ((ai * HALF + wr * 64 + m * 16 + fr) * 4 + wc) * 4, s); }
    EPI_BAR();
#pragma unroll
    for (int ai = 0; ai < 2; ++ai)
#pragma unroll
        for (int m = 0; m < 4; ++m) { const f32x4 v = lds_r128(xt + (ai * HALF + wr * 64 + m * 16 + fr) * 16); part[ai][m] = (v[0] + v[1]) + (v[2] + v[3]); }
}
template <int NS> __device__ __forceinline__ void rows_slots(float (&part)[2][4], float* ssp, int row0, int fq, int slot) {
#pragma unroll
    for (int ai = 0; ai < 2; ++ai)
#pragma unroll
        for (int m = 0; m < 4; ++m) { float s = part[ai][m]; s += __shfl_xor(s, 16); s += __shfl_xor(s, 32);
            if (fq == 0) ssp[(size_t)(row0 + ai * HALF + m * 16) * NS + slot] = s; }
}
template <int NS> __device__ __forceinline__ void fill_row_table(LAS unsigned char* lds, int off, const float* ssp, size_t row_base, int tid, float inv_n, bool rsq) {
    const unsigned tb = lds_addr(lds, off);
    { if (tid < 256) { const float s = sum_slots<NS>(ssp + (row_base + tid) * NS); lds_w32(tb + tid * 4, rsq ? 1.0f / sqrtf(s * inv_n + EPS) : s); } }
    EPI_BAR();
}
__device__ __forceinline__ float sq4(f32x4 v) { return (v[0] * v[0] + v[1] * v[1]) + (v[2] * v[2] + v[3] * v[3]); }
__device__ __forceinline__ u32x4 pack8(f32x4 a, f32x4 b) { u32x4 w; w.x = cvt_pk_bf16(a[0], a[1]); w.y = cvt_pk_bf16(a[2], a[3]); w.z = cvt_pk_bf16(b[0], b[1]); w.w = cvt_pk_bf16(b[2], b[3]); return w; }
__device__ __forceinline__ u32x4 from_rowmajor(u32x4 v, int lane) { const int a = ((((lane & 15) << 2) | (lane >> 4)) << 2); u32x4 r;
    r.x = (unsigned)__builtin_amdgcn_ds_bpermute(a, (int)v.x); r.y = (unsigned)__builtin_amdgcn_ds_bpermute(a, (int)v.y); r.z = (unsigned)__builtin_amdgcn_ds_bpermute(a, (int)v.z); r.w = (unsigned)__builtin_amdgcn_ds_bpermute(a, (int)v.w); return r; }
__device__ __forceinline__ u32x2 from_rowmajor2(u32x2 v, int lane) { const int a = ((((lane & 15) << 2) | (lane >> 4)) << 2); u32x2 r;
    r.x = (unsigned)__builtin_amdgcn_ds_bpermute(a, (int)v.x); r.y = (unsigned)__builtin_amdgcn_ds_bpermute(a, (int)v.y); return r; }
__device__ __forceinline__ f32x4 from_rowmajor_f(f32x4 v, int lane) { return __builtin_bit_cast(f32x4, from_rowmajor(__builtin_bit_cast(u32x4, v), lane)); }
__device__ __forceinline__ u32x2 pack4(f32x4 a) { u32x2 w; w.x = cvt_pk_bf16(a[0], a[1]); w.y = cvt_pk_bf16(a[2], a[3]); return w; }
__device__ __forceinline__ f32x4 unpack4(u32x2 w) { return (f32x4){bflo(w.x), bfhi(w.x), bflo(w.y), bfhi(w.y)}; }
__device__ __forceinline__ unsigned pack4_u8(f32x4 g) { const float M = 8388608.0f;
    const unsigned u0 = __builtin_bit_cast(unsigned, __builtin_fmaf(g[0], 255.0f, M)), u1 = __builtin_bit_cast(unsigned, __builtin_fmaf(g[1], 255.0f, M)), u2 = __builtin_bit_cast(unsigned, __builtin_fmaf(g[2], 255.0f, M)), u3 = __builtin_bit_cast(unsigned, __builtin_fmaf(g[3], 255.0f, M));
    return __builtin_amdgcn_perm(u1, u0, 0x0c0c0400u) | __builtin_amdgcn_perm(u3, u2, 0x04000c0cu); }
__device__ __forceinline__ f32x4 unpack4_u8(unsigned w) { return (f32x4){(float)(w & 0xffu), (float)((w >> 8) & 0xffu), (float)((w >> 16) & 0xffu), (float)(w >> 24)} * (1.0f / 255.0f); }

struct EpiInProj {
    static constexpr bool PERM = true;
    const float* ssx; bf16 *U, *CQ, *CKV, *QM; unsigned char* GT; float* KR; float *ss_cq, *ss_ckv, *ss_kr; const float* qm_gain;
    __device__ __forceinline__ void operator()(Acc& acc, const Unit& u, int wr, int wc, int fr, int fq, LAS unsigned char* lds, int tid) const {
        asm volatile("" : "+v"(fr), "+v"(fq), "+v"(tid));
        const int pn = u.pn, row0 = u.pm * BM + wr * 64 + fr, cl = wc * 32 + 8 * fq;
        fill_row_table<32>(lds, RK_OFF, ssx, (size_t)u.pm * BM, tid, 1.0f / DM, true);
        float rs[2][4];
#pragma unroll
        for (int ai = 0; ai < 2; ++ai)
#pragma unroll
            for (int m = 0; m < 4; ++m) rs[ai][m] = lds_r32(lds_addr(lds, RK_OFF) + (ai * HALF + wr * 64 + m * 16 + fr) * 4);
#pragma unroll
        for (int ai = 0; ai < 2; ++ai)
#pragma unroll
            for (int bj = 0; bj < 2; ++bj)
#pragma unroll
                for (int m = 0; m < 4; ++m)
#pragma unroll
                    for (int n = 0; n < 2; ++n) acc[ai][bj][m][n] = acc[ai][bj][m][n] * rs[ai][m];
        if (pn < 4 || (pn >= 4 && pn < 8)) {
            bf16* dst; int ld, c0; float* ss = nullptr; int tl = 0;
            if (pn < 4) { dst = U; ld = S5W; c0 = pn * 256; } else if (pn < 6) { dst = CQ; ld = 512; c0 = (pn - 4) * 256; ss = ss_cq; tl = pn - 4; } else { dst = CKV; ld = 512; c0 = (pn - 6) * 256; ss = ss_ckv; tl = pn - 6; }
            float part[2][4];
#pragma unroll
            for (int ai = 0; ai < 2; ++ai)
#pragma unroll
                for (int m = 0; m < 4; ++m) { bf16* rp = dst + (size_t)(row0 + ai * HALF + m * 16) * ld + c0 + cl; float s = 0.f;
#pragma unroll
                    for (int bj = 0; bj < 2; ++bj) { *(u32x4*)(rp + bj * HALF) = pack8(acc[ai][bj][m][0], acc[ai][bj][m][1]); s += sq4(acc[ai][bj][m][0]) + sq4(acc[ai][bj][m][1]); }
                    part[ai][m] = s; }
            if (ss) rows_slots<8>(part, ss, row0, fq, tl * 4 + wc);
        } else if (pn == 8) {
            float part[2][4];
#pragma unroll
            for (int ai = 0; ai < 2; ++ai)
#pragma unroll
                for (int m = 0; m < 4; ++m) { float s = 0.f;
                    if (wc < 2) { float* rp = KR + (size_t)(row0 + ai * HALF + m * 16) * 64 + cl; *(f32x4*)rp = acc[ai][0][m][0]; *(f32x4*)(rp + 4) = acc[ai][0][m][1]; s = sq4(acc[ai][0][m][0]) + sq4(acc[ai][0][m][1]); }
                    part[ai][m] = s; }
            rows_slots<4>(part, ss_kr, row0, fq, wc);
        } else if (pn < 13) {
            float part[2][4];
#pragma unroll
            for (int ai = 0; ai < 2; ++ai)
#pragma unroll
                for (int m = 0; m < 4; ++m) { float s = 0.f;
#pragma unroll
                    for (int bj = 0; bj < 2; ++bj) s += sq4(acc[ai][bj][m][0]) + sq4(acc[ai][bj][m][1]);
                    part[ai][m] = s; }
            rows_allreduce(part, lds, wr, wc, fr, fq);
            f32x4 gn[2][2];
#pragma unroll
            for (int bj = 0; bj < 2; ++bj)
#pragma unroll
                for (int n = 0; n < 2; ++n) gn[bj][n] = *(const f32x4*)(qm_gain + bj * HALF + cl + 4 * n) * (0.0625f * LOG2E);
#pragma unroll
            for (int ai = 0; ai < 2; ++ai)
#pragma unroll
                for (int m = 0; m < 4; ++m) { const float rq = 1.0f / sqrtf(part[ai][m] * (1.0f / MEMD) + EPS); bf16* rp = QM + (size_t)(row0 + ai * HALF + m * 16) * MEMW + (pn - 9) * 256 + cl;
#pragma unroll
                    for (int bj = 0; bj < 2; ++bj) *(u32x4*)(rp + bj * HALF) = pack8(acc[ai][bj][m][0] * gn[bj][0] * rq, acc[ai][bj][m][1] * gn[bj][1] * rq); }
        } else {
#pragma unroll
            for (int ai = 0; ai < 2; ++ai)
#pragma unroll
                for (int m = 0; m < 4; ++m) { unsigned char* rp = GT + (size_t)(row0 + ai * HALF + m * 16) * (3 * DM) + (pn - 13) * 256 + cl;
#pragma unroll
                    for (int bj = 0; bj < 2; ++bj) { f32x4 a = acc[ai][bj][m][0], b = acc[ai][bj][m][1];
#pragma unroll
                        for (int e = 0; e < 4; ++e) { a[e] = sigmoidf_(a[e]); b[e] = sigmoidf_(b[e]); }
                        *(u32x2*)(rp + bj * HALF) = (u32x2){pack4_u8(a), pack4_u8(b)}; } }
        }
    }
};

struct EpiGates {
    static constexpr bool PERM = true;
    const float* rsc; float wstep; unsigned char* GT;
    float wstep_q; bf16* QM; const float* qm_gain;
    __device__ __forceinline__ void operator()(Acc& acc, const Unit& u, int wr, int wc, int fr, int fq, LAS unsigned char* lds, int tid) const {
        asm volatile("" : "+v"(fr), "+v"(fq), "+v"(tid));
        const int row0 = u.pm * BM + wr * 64 + fr, cl = wc * 32 + 8 * fq;
        if (u.pn < 4) {
            float part[2][4];
#pragma unroll
            for (int ai = 0; ai < 2; ++ai)
#pragma unroll
                for (int m = 0; m < 4; ++m) { const float rs = rsc[row0 + ai * HALF + m * 16] * wstep_q; float s = 0.f;
#pragma unroll
                    for (int bj = 0; bj < 2; ++bj)
#pragma unroll
                        for (int n = 0; n < 2; ++n) { acc[ai][bj][m][n] = acc[ai][bj][m][n] * rs; s += sq4(acc[ai][bj][m][n]); }
                    part[ai][m] = s; }
            rows_allreduce(part, lds, wr, wc, fr, fq);
            f32x4 gn[2][2];
#pragma unroll
            for (int bj = 0; bj < 2; ++bj)
#pragma unroll
                for (int n = 0; n < 2; ++n) gn[bj][n] = *(const f32x4*)(qm_gain + bj * HALF + cl + 4 * n) * (0.0625f * LOG2E);
#pragma unroll
            for (int ai = 0; ai < 2; ++ai)
#pragma unroll
                for (int m = 0; m < 4; ++m) { const float rq = 1.0f / sqrtf(part[ai][m] * (1.0f / MEMD) + EPS); bf16* rp = QM + (size_t)(row0 + ai * HALF + m * 16) * MEMW + u.pn * 256 + cl;
#pragma unroll
                    for (int bj = 0; bj < 2; ++bj) *(u32x4*)(rp + bj * HALF) = pack8(acc[ai][bj][m][0] * gn[bj][0] * rq, acc[ai][bj][m][1] * gn[bj][1] * rq); }
            return;
        }
        float rgv[2][4];
#pragma unroll
        for (int ai = 0; ai < 2; ++ai)
#pragma unroll
            for (int m = 0; m < 4; ++m) { const float* rp_ = rsc + row0 + ai * HALF + m * 16; asm volatile("global_load_dword %0, %1, off" : "=v"(rgv[ai][m]) : "v"(rp_) : "memory"); }
        asm volatile("s_waitcnt vmcnt(0)" : "+v"(rgv[0][0]), "+v"(rgv[0][1]), "+v"(rgv[0][2]), "+v"(rgv[0][3]), "+v"(rgv[1][0]), "+v"(rgv[1][1]), "+v"(rgv[1][2]), "+v"(rgv[1][3]) :: "memory");
#pragma unroll
        for (int ai = 0; ai < 2; ++ai)
#pragma unroll
            for (int m = 0; m < 4; ++m) { const int row = row0 + ai * HALF + m * 16; const float rs = rgv[ai][m] * wstep; unsigned char* rp = GT + (size_t)row * (3 * DM) + (u.pn - 4) * 256 + cl;
#pragma unroll
                for (int bj = 0; bj < 2; ++bj) { f32x4 a = acc[ai][bj][m][0] * rs, b = acc[ai][bj][m][1] * rs;
#pragma unroll
                    for (int e = 0; e < 4; ++e) { a[e] = sigmoidf_(a[e]); b[e] = sigmoidf_(b[e]); }
                    *(u32x2*)(rp + bj * HALF) = (u32x2){pack4_u8(a), pack4_u8(b)}; } }
    }
};
struct EpiQ {
    static constexpr bool PERM = true;
    const float* ss_cq; const float* qn; const float* ropec; const float* ropes; bf16* Q;
    __device__ __forceinline__ void operator()(Acc& acc, const Unit& u, int wr, int wc, int fr, int fq, LAS unsigned char* lds, int tid) const {
        asm volatile("" : "+v"(fr), "+v"(fq), "+v"(tid));
        const int row0 = u.pm * BM + wr * 64 + fr, cl = wc * 32 + 8 * fq;
        fill_row_table<8>(lds, RK_OFF, ss_cq, (size_t)u.pm * BM, tid, 1.0f / QRANK, true);
        float part[2][4];
#pragma unroll
        for (int ai = 0; ai < 2; ++ai)
#pragma unroll
            for (int m = 0; m < 4; ++m) { const float a = lds_r32(lds_addr(lds, RK_OFF) + (ai * HALF + wr * 64 + m * 16 + fr) * 4); float s = 0.f;
#pragma unroll
                for (int bj = 0; bj < 2; ++bj)
#pragma unroll
                    for (int n = 0; n < 2; ++n) { acc[ai][bj][m][n] = acc[ai][bj][m][n] * a; s += sq4(acc[ai][bj][m][n]); }
                part[ai][m] = s; }
        rows_allreduce(part, lds, wr, wc, fr, fq);
        const float SC = 0.07216878364870322f * LOG2E;
        { f32x4 g0 = *(const f32x4*)(qn + cl), g1 = *(const f32x4*)(qn + cl + 4);
#pragma unroll
          for (int ai = 0; ai < 2; ++ai)
#pragma unroll
            for (int m = 0; m < 4; ++m) { const float rq = SC / sqrtf(part[ai][m] * (1.0f / DQK) + EPS); bf16* rp = Q + ((size_t)u.pn * SEQ + row0 + ai * HALF + m * 16) * DQK + cl;
                *(u32x4*)rp = pack8(acc[ai][0][m][0] * g0 * rq, acc[ai][0][m][1] * g1 * rq); asm volatile("" ::: "memory"); } }
        if (wc < 2) {
            const int i0 = cl >> 1; float g1v[4], g2v[4];
#pragma unroll
            for (int j = 0; j < 4; ++j) { g1v[j] = qn[128 + i0 + j]; g2v[j] = qn[160 + i0 + j]; }
#pragma unroll
            for (int ai = 0; ai < 2; ++ai) { f32x4 csv[4], snv[4];
#pragma unroll
                for (int m = 0; m < 4; ++m) { const int row = row0 + ai * HALF + m * 16; csv[m] = *(const f32x4*)(ropec + (size_t)row * 32 + i0); snv[m] = *(const f32x4*)(ropes + (size_t)row * 32 + i0); }
#pragma unroll
                for (int m = 0; m < 4; ++m) { const int row = row0 + ai * HALF + m * 16; const float rq = SC / sqrtf(part[ai][m] * (1.0f / DQK) + EPS);
                    const f32x4 cs = csv[m], sn = snv[m];
                    f32x4 o0, o1;
                    { const float x1 = acc[ai][1][m][0][0] * g1v[0] * rq, x2 = acc[ai][1][m][0][1] * g2v[0] * rq; o0[0] = x1 * cs[0] - x2 * sn[0]; o0[1] = x2 * cs[0] + x1 * sn[0]; }
                    { const float x1 = acc[ai][1][m][0][2] * g1v[1] * rq, x2 = acc[ai][1][m][0][3] * g2v[1] * rq; o0[2] = x1 * cs[1] - x2 * sn[1]; o0[3] = x2 * cs[1] + x1 * sn[1]; }
                    { const float x1 = acc[ai][1][m][1][0] * g1v[2] * rq, x2 = acc[ai][1][m][1][1] * g2v[2] * rq; o1[0] = x1 * cs[2] - x2 * sn[2]; o1[1] = x2 * cs[2] + x1 * sn[2]; }
                    { const float x1 = acc[ai][1][m][1][2] * g1v[3] * rq, x2 = acc[ai][1][m][1][3] * g2v[3] * rq; o1[2] = x1 * cs[3] - x2 * sn[3]; o1[3] = x2 * cs[3] + x1 * sn[3]; }
                    *(u32x4*)(Q + ((size_t)u.pn * SEQ + row) * DQK + 128 + cl) = pack8(o0, o1); } }
        }
    }
};

struct EpiKV {
    static constexpr bool PERM = true;
    const float* ss_ckv; const float* ss_kr; const float* kn; const float* KR; const float* ropec; const float* ropes; bf16* Kc; bf16* Vc;
    __device__ __forceinline__ void operator()(Acc& acc, const Unit& u, int wr, int wc, int fr, int fq, LAS unsigned char* lds, int tid) const {
        asm volatile("" : "+v"(fr), "+v"(fq), "+v"(tid));
        const int row0 = u.pm * BM + wr * 64 + fr, cl = wc * 32 + 8 * fq;
        { if (tid < 256) lds_w32(lds_addr(lds, TB2_OFF) + tid * 4, sum_slots<4>(ss_kr + ((size_t)u.pm * BM + tid) * 4)); }
        fill_row_table<8>(lds, RK_OFF, ss_ckv, (size_t)u.pm * BM, tid, 1.0f / KVRANK, true);
        float part[2][4];
#pragma unroll
        for (int ai = 0; ai < 2; ++ai)
#pragma unroll
            for (int m = 0; m < 4; ++m) { const float a = lds_r32(lds_addr(lds, RK_OFF) + (ai * HALF + wr * 64 + m * 16 + fr) * 4);
#pragma unroll
                for (int bj = 0; bj < 2; ++bj)
#pragma unroll
                    for (int n = 0; n < 2; ++n) acc[ai][bj][m][n] = acc[ai][bj][m][n] * a;
                part[ai][m] = sq4(acc[ai][0][m][0]) + sq4(acc[ai][0][m][1]); }
        rows_allreduce(part, lds, wr, wc, fr, fq);
        const unsigned rkt = lds_addr(lds, RK_OFF);
        const f32x4 g0 = *(const f32x4*)(kn + cl), g1 = *(const f32x4*)(kn + cl + 4);
#pragma unroll
        for (int ai = 0; ai < 2; ++ai)
#pragma unroll
            for (int m = 0; m < 4; ++m) { const int row = row0 + ai * HALF + m * 16; const float rk = 1.0f / sqrtf((part[ai][m] + lds_r32(lds_addr(lds, TB2_OFF) + (ai * HALF + wr * 64 + m * 16 + fr) * 4)) * (1.0f / DQK) + EPS);
                *(u32x4*)(Kc + ((size_t)u.pn * SEQ + row) * DQK + cl) = pack8(acc[ai][0][m][0] * g0 * rk, acc[ai][0][m][1] * g1 * rk);
                *(u32x4*)(Vc + ((size_t)u.pn * SEQ + row) * DV + cl) = pack8(acc[ai][1][m][0], acc[ai][1][m][1]);
                if (wc == 0 && fq == 0) lds_w32(rkt + (ai * HALF + wr * 64 + m * 16 + fr) * 4, rk); }
        EPI_BAR();
        {
            const int rl = tid >> 1, i0 = (tid & 1) * 16, row = u.pm * BM + rl; const float rk = lds_r32(rkt + rl * 4);
            const float* kr = KR + (size_t)row * 64; bf16* dst = Kc + ((size_t)u.pn * SEQ + row) * DQK + 128 + 2 * i0;
#pragma unroll
            for (int j4 = 0; j4 < 4; ++j4) { const int i = i0 + 4 * j4;
                const f32x4 x1 = *(const f32x4*)(kr + i) * *(const f32x4*)(kn + 128 + i) * rk, x2 = *(const f32x4*)(kr + 32 + i) * *(const f32x4*)(kn + 160 + i) * rk;
                const f32x4 cs = *(const f32x4*)(ropec + (size_t)row * 32 + i), sn = *(const f32x4*)(ropes + (size_t)row * 32 + i);
                const f32x4 a = x1 * cs - x2 * sn, b = x2 * cs + x1 * sn;
                *(u32x4*)(dst + 8 * j4) = pack8((f32x4){a[0], b[0], a[1], b[1]}, (f32x4){a[2], b[2], a[3], b[3]}); }
        }
    }
};

struct EpiMemKV {
    static constexpr bool PERM = true;
    const float* kng[2]; bf16* KM; bf16* VM;
    __device__ __forceinline__ void operator()(Acc& acc, const Unit& u, int wr, int wc, int fr, int fq, LAS unsigned char* lds, int tid) const {
        asm volatile("" : "+v"(fr), "+v"(fq), "+v"(tid));
        const int rl0 = wr * 64 + fr, cl = wc * 32 + 8 * fq;
        float part[2][4];
#pragma unroll
        for (int ai = 0; ai < 2; ++ai)
#pragma unroll
            for (int m = 0; m < 4; ++m) { float s = 0.f;
#pragma unroll
                for (int bj = 0; bj < 2; ++bj) s += sq4(acc[ai][bj][m][0]) + sq4(acc[ai][bj][m][1]);
                part[ai][m] = s; }
        rows_allreduce(part, lds, wr, wc, fr, fq);
        const bool isk = u.pn < 4; const float* kg = u.e ? kng[1] : kng[0];
        bf16* dst = (isk ? KM : VM) + ((size_t)u.e * MEMH + (u.pn & 3)) * NMEM * MEMD;
#pragma unroll
        for (int ai = 0; ai < 2; ++ai)
#pragma unroll
            for (int m = 0; m < 4; ++m) { const float rk = isk ? 1.0f / sqrtf(part[ai][m] * (1.0f / MEMD) + EPS) : 1.0f;
#pragma unroll
                for (int bj = 0; bj < 2; ++bj) { f32x4 g0 = (f32x4){1.f, 1.f, 1.f, 1.f}, g1 = g0; if (isk) { g0 = *(const f32x4*)(kg + bj * HALF + cl); g1 = *(const f32x4*)(kg + bj * HALF + cl + 4); }
                    *(u32x4*)(dst + (size_t)(rl0 + ai * HALF + m * 16) * MEMD + bj * HALF + cl) = pack8(acc[ai][bj][m][0] * g0 * rk, acc[ai][bj][m][1] * g1 * rk); } }
    }
};

template <int MODE> struct EpiMerge {
    static constexpr bool PERM = true;
    const unsigned char* GT; bf16* MF;
    __device__ __forceinline__ void operator()(Acc& acc, const Unit& u, int wr, int wc, int fr, int fq, LAS unsigned char* lds, int tid) const {
        asm volatile("" : "+v"(fr), "+v"(fq), "+v"(tid));
        const int ln_ = tid & 63, dr_ = (ln_ >> 2) - fr, dq_ = (ln_ & 3) - fq;
        const int row0 = u.pm * BM + wr * 64 + fr, col0 = u.pn * BM + wc * 32 + 8 * fq;
#pragma unroll
        for (int ai = 0; ai < 2; ++ai) { u32x2 gv[4][2]; u32x4 ov[4][2];
#pragma unroll
            for (int m = 0; m < 4; ++m) { const size_t row = row0 + ai * HALF + m * 16;
#pragma unroll
                for (int bj = 0; bj < 2; ++bj) { const int c = col0 + bj * HALF; gv[m][bj] = *(const u32x2*)(GT + (row + dr_) * (3 * DM) + MODE * DM + c + dq_ * 8);
                    if (MODE == 2) ov[m][bj] = *(const u32x4*)(MF + (row + dr_) * DM + c + dq_ * 8); } }
#pragma unroll
            for (int m = 0; m < 4; ++m) { const size_t row = row0 + ai * HALF + m * 16;
#pragma unroll
                for (int bj = 0; bj < 2; ++bj) { const int c = col0 + bj * HALF; const u32x2 g = from_rowmajor2(gv[m][bj], ln_);
                    bf16* p = MF + row * DM + c; f32x4 lo = acc[ai][bj][m][0] * unpack4_u8(g.x), hi = acc[ai][bj][m][1] * unpack4_u8(g.y);
                    if (MODE == 2) { const u32x4 o = from_rowmajor(ov[m][bj], ln_); lo = lo + unpack4((u32x2){o.x, o.y}); hi = hi + unpack4((u32x2){o.z, o.w}); }
                    *(u32x4*)p = pack8(lo, hi); } } }
    }
};
struct EpiGlu {
    static constexpr bool PERM = true;
    const unsigned char* GT; const bf16* MF; bf16* MB;
    __device__ __forceinline__ void operator()(Acc& acc, const Unit& u, int wr, int wc, int fr, int fq, LAS unsigned char* lds, int tid) const {
        asm volatile("" : "+v"(fr), "+v"(fq), "+v"(tid));
        const int ln_ = tid & 63, dr_ = (ln_ >> 2) - fr, dq_ = (ln_ & 3) - fq;
        const int row0 = u.pm * BM + wr * 64 + fr, col0 = u.pn * HALF + wc * 32 + 8 * fq;
        u32x2 gv[2][4]; u32x4 ov[2][4];
#pragma unroll
        for (int ai = 0; ai < 2; ++ai)
#pragma unroll
            for (int m = 0; m < 4; ++m) { const size_t row = row0 + ai * HALF + m * 16;
                gv[ai][m] = *(const u32x2*)(GT + (row + dr_) * (3 * DM) + col0 + dq_ * 8); ov[ai][m] = *(const u32x4*)(MF + (row + dr_) * DM + col0 + dq_ * 8); }
#pragma unroll
        for (int ai = 0; ai < 2; ++ai)
#pragma unroll
            for (int m = 0; m < 4; ++m) { const size_t row = row0 + ai * HALF + m * 16;
                const u32x2 g = from_rowmajor2(gv[ai][m], ln_); const u32x4 o = from_rowmajor(ov[ai][m], ln_);
                f32x4 v[2] = {unpack4((u32x2){o.x, o.y}), unpack4((u32x2){o.z, o.w})}; const f32x4 gg[2] = {unpack4_u8(g.x), unpack4_u8(g.y)};
#pragma unroll
                for (int n = 0; n < 2; ++n) { const f32x4 ga = acc[ai][0][m][n], gb = acc[ai][1][m][n];
#pragma unroll
                    for (int e = 0; e < 4; ++e) v[n][e] += gg[n][e] * ga[e] * sigmoidf_(gb[e]); }
                *(u32x4*)(MB + row * DM + col0) = pack8(v[0], v[1]); }
    }
};
template <bool BASE16, bool WOUT> struct EpiResid {
    static constexpr bool PERM = true;
    const void* base; float* OUT; bf16* XBo; float* ss;
    __device__ __forceinline__ void operator()(Acc& acc, const Unit& u, int wr, int wc, int fr, int fq, LAS unsigned char* lds, int tid) const {
        asm volatile("" : "+v"(fr), "+v"(fq), "+v"(tid));
        const int ln_ = tid & 63, dr_ = (ln_ >> 2) - fr, dq_ = (ln_ & 3) - fq;
        const int row0 = u.pm * BM + wr * 64 + fr, col0 = u.pn * BM + wc * 32 + 8 * fq;
        float part[2][4];
#pragma unroll
        for (int ai = 0; ai < 2; ++ai) { u32x4 wv[4][2]; f32x4 fv[4][2][2];
#pragma unroll
            for (int m = 0; m < 4; ++m) { const size_t row = row0 + ai * HALF + m * 16;
#pragma unroll
                for (int bj = 0; bj < 2; ++bj) { const size_t o = row * DM + col0 + bj * HALF;
                    if constexpr (BASE16) wv[m][bj] = *(const u32x4*)((const bf16*)base + o + dr_ * DM + dq_ * 8);
                    else { fv[m][bj][0] = *(const f32x4*)((const float*)base + o + dr_ * DM + dq_ * 8); fv[m][bj][1] = *(const f32x4*)((const float*)base + o + dr_ * DM + dq_ * 8 + 4); } } }
#pragma unroll
            for (int m = 0; m < 4; ++m) { const size_t row = row0 + ai * HALF + m * 16; float s = 0.f;
#pragma unroll
                for (int bj = 0; bj < 2; ++bj) { const size_t o = row * DM + col0 + bj * HALF; f32x4 b0, b1;
                    if constexpr (BASE16) { const u32x4 w = from_rowmajor(wv[m][bj], ln_); b0 = unpack4((u32x2){w.x, w.y}); b1 = unpack4((u32x2){w.z, w.w}); }
                    else { b0 = from_rowmajor_f(fv[m][bj][0], ln_); b1 = from_rowmajor_f(fv[m][bj][1], ln_); }
                    const f32x4 v0 = acc[ai][bj][m][0] + b0, v1 = acc[ai][bj][m][1] + b1;
                    if constexpr (WOUT) { *(f32x4*)(OUT + o) = v0; *(f32x4*)(OUT + o + 4) = v1; }
                    if (XBo) *(u32x4*)(XBo + o) = pack8(v0, v1);
                    s += sq4(v0) + sq4(v1); }
                part[ai][m] = s; } }
        if (ss) rows_slots<32>(part, ss, row0, fq, u.pn * 4 + wc);
    }
};
constexpr float ACT_FP8_SCALE = 8.0f;
template <class Sched> struct EpiSwiGLU {
    static constexpr bool PERM = true;
    const float* ssx; bf16* ACT; const Sched* S; bool moe; const float* rsc; const float* wsc; unsigned char* ACT8;
    mutable Unit nx; mutable bool hasnx; mutable float pv[8]; mutable bool have;
    __device__ __forceinline__ void operator()(Acc& acc, const Unit& u, int wr, int wc, int fr, int fq, LAS unsigned char* lds, int tid) const {
        asm volatile("" : "+v"(fr), "+v"(fq), "+v"(tid));
        const int rl0 = wr * 64 + fr, cl = wc * 32 + 8 * fq;
        if (!moe) fill_row_table<32>(lds, RK_OFF, ssx, (size_t)u.pm * BM, tid, 1.0f / DM, true);
        float rsv[2][4];
        if (moe && have) {
            asm volatile("s_waitcnt vmcnt(0)" : "+v"(pv[0]), "+v"(pv[1]), "+v"(pv[2]), "+v"(pv[3]), "+v"(pv[4]), "+v"(pv[5]), "+v"(pv[6]), "+v"(pv[7]) :: "memory");
#pragma unroll
            for (int i = 0; i < 8; ++i) rsv[i >> 2][i & 3] = pv[i];
        } else {
#pragma unroll
            for (int ai = 0; ai < 2; ++ai)
#pragma unroll
                for (int m = 0; m < 4; ++m) { const int rl = rl0 + ai * HALF + m * 16; rsv[ai][m] = moe ? rsc[(size_t)u.e * SEQ + (u.pm - u.p0) * BM + rl] : lds_r32(lds_addr(lds, RK_OFF) + rl * 4); }
        }
        if (moe) { have = hasnx;
            if (hasnx) { const float* nb_ = rsc + (size_t)nx.e * SEQ + (nx.pm - nx.p0) * BM + rl0;
#pragma unroll
                for (int i = 0; i < 8; ++i) { const float* np_ = nb_ + (i >> 2) * HALF + (i & 3) * 16; asm volatile("global_load_dword %0, %1, off" : "=v"(pv[i]) : "v"(np_) : "memory"); } } }
        const float wse = moe ? wsc[u.e] : 1.0f;
#pragma unroll
        for (int ai = 0; ai < 2; ++ai)
#pragma unroll
            for (int m = 0; m < 4; ++m) { const int rl = rl0 + ai * HALF + m * 16;
                const float rs = rsv[ai][m] * wse;
                f32x4 o[2];
#pragma unroll
                for (int n = 0; n < 2; ++n) { const f32x4 gg = acc[ai][0][m][n] * rs, uu = acc[ai][1][m][n] * rs;
#pragma unroll
                    for (int e = 0; e < 4; ++e) o[n][e] = gg[e] * sigmoidf_(gg[e]) * uu[e]; }
                if (ACT8) { int w0 = 0, w1 = 0; w0 = __builtin_amdgcn_cvt_pk_fp8_f32(o[0][0] * ACT_FP8_SCALE, o[0][1] * ACT_FP8_SCALE, w0, false); w0 = __builtin_amdgcn_cvt_pk_fp8_f32(o[0][2] * ACT_FP8_SCALE, o[0][3] * ACT_FP8_SCALE, w0, true);
                    w1 = __builtin_amdgcn_cvt_pk_fp8_f32(o[1][0] * ACT_FP8_SCALE, o[1][1] * ACT_FP8_SCALE, w1, false); w1 = __builtin_amdgcn_cvt_pk_fp8_f32(o[1][2] * ACT_FP8_SCALE, o[1][3] * ACT_FP8_SCALE, w1, true);
                    *(u32x2*)(ACT8 + (size_t)(u.pm * BM + rl) * DFF + u.pn * HALF + cl) = (u32x2){(unsigned)w0, (unsigned)w1}; }
                else *(u32x4*)(ACT + (size_t)(u.pm * BM + rl) * DFF + u.pn * HALF + cl) = pack8(o[0], o[1]); }
    }
};
struct EpiMoeDown {
    static constexpr bool PERM = true;
    bf16* YM; const float* dsc; const float* rsc2;
    __device__ __forceinline__ void operator()(Acc& acc, const Unit& u, int wr, int wc, int fr, int fq, LAS unsigned char* lds, int tid) const {
        asm volatile("" : "+v"(fr), "+v"(fq), "+v"(tid));
        const int rl0 = wr * 64 + fr, cl = wc * 32 + 8 * fq;
        bf16* dst = YM + (size_t)u.ks * ACT_ROWS * DM; const float ds = dsc[u.e];
        float r2v[2][4];
#pragma unroll
        for (int ai = 0; ai < 2; ++ai)
#pragma unroll
            for (int m = 0; m < 4; ++m) r2v[ai][m] = rsc2[(size_t)(u.pm * BM + rl0 + ai * HALF + m * 16)];
#pragma unroll
        for (int ai = 0; ai < 2; ++ai)
#pragma unroll
            for (int m = 0; m < 4; ++m) { const size_t row = (size_t)(u.pm * BM + rl0 + ai * HALF + m * 16); bf16* rp = dst + row * DM + u.pn * BM + cl; const float dr = ds * r2v[ai][m];
#pragma unroll
                for (int bj = 0; bj < 2; ++bj) *(u32x4*)(rp + bj * HALF) = pack8(acc[ai][bj][m][0] * dr, acc[ai][bj][m][1] * dr); }
    }
};
}
namespace attn {
constexpr int A_KOFF = 0, A_VOFF = 65536, A_WS = 114688, A_POSK = 116736, A_LIST = 117248;
__device__ __forceinline__ int v_st(int k, int c) { const int kk = (k & ~0xC) | ((k & 4) << 1) | ((k & 8) >> 1); return ((kk >> 3) * 4 + (c >> 5)) * 512 + ((kk & 7) * 32 + (c & 31)) * 2; }
__device__ __forceinline__ int v_rd_base(int lane) { return ((lane & 3) << 3) | (((lane >> 2) & 3) << 6) | (((lane >> 4) & 1) << 5) | (((lane >> 5) & 1) << 8); }
constexpr int v_rd_off(int d0, int ks, int half) { return d0 * 512 + ks * 4096 + half * 2048; }
__device__ __forceinline__ int crow(int r, int hi) { return (r & 3) + 8 * (r >> 2) + 4 * hi; }
__device__ __forceinline__ void glds16(const void* gsrc, unsigned lds_dst) { unsigned keep;
    asm volatile("s_mov_b32 %0, m0\n\ts_mov_b32 m0, %2\n\ts_nop 0\n\tglobal_load_lds_dwordx4 %1, off\n\ts_mov_b32 m0, %0" : "=&s"(keep) : "v"(gsrc), "s"(lds_dst) : "memory"); }

template <int VBOFF>
__device__ __forceinline__ void pv_tile(f32x16* o, int vb0, bf16x8 pa0, bf16x8 pa1, bf16x8 pa2, bf16x8 pa3) {
#define TRRD(dst, off) asm volatile("ds_read_b64_tr_b16 %0, %1 offset:%2" : "=&v"(dst) : "v"(vb0), "i"(off) : "memory")
#define PV_RD(S, d0) do { constexpr int b_ = VBOFF + v_rd_off(d0, 0, 0); \
        TRRD(l##S[0], b_); TRRD(h##S[0], b_ + 2048); TRRD(l##S[1], b_ + 4096); TRRD(h##S[1], b_ + 6144); TRRD(l##S[2], b_ + 8192); TRRD(h##S[2], b_ + 10240); TRRD(l##S[3], b_ + 12288); TRRD(h##S[3], b_ + 14336); } while (0)
#define PV_MM(S, d0) do { \
        o[d0] = __builtin_amdgcn_mfma_f32_32x32x16_bf16(pa0, (bf16x8){l##S[0][0], l##S[0][1], l##S[0][2], l##S[0][3], h##S[0][0], h##S[0][1], h##S[0][2], h##S[0][3]}, o[d0], 0, 0, 0);   \
        o[d0] = __builtin_amdgcn_mfma_f32_32x32x16_bf16(pa1, (bf16x8){l##S[1][0], l##S[1][1], l##S[1][2], l##S[1][3], h##S[1][0], h##S[1][1], h##S[1][2], h##S[1][3]}, o[d0], 0, 0, 0);   \
        o[d0] = __builtin_amdgcn_mfma_f32_32x32x16_bf16(pa2, (bf16x8){l##S[2][0], l##S[2][1], l##S[2][2], l##S[2][3], h##S[2][0], h##S[2][1], h##S[2][2], h##S[2][3]}, o[d0], 0, 0, 0);   \
        o[d0] = __builtin_amdgcn_mfma_f32_32x32x16_bf16(pa3, (bf16x8){l##S[3][0], l##S[3][1], l##S[3][2], l##S[3][3], h##S[3][0], h##S[3][1], h##S[3][2], h##S[3][3]}, o[d0], 0, 0, 0); } while (0)
#define PV_W(n) do { asm volatile("s_waitcnt lgkmcnt(" #n ")" ::: "memory"); SBAR(); } while (0)
    s16x4 lA[4], hA[4], lB[4], hB[4];
    PV_RD(A, 0); PV_RD(B, 1); PV_W(8); PV_MM(A, 0); SBAR();
    PV_RD(A, 2); PV_W(8); PV_MM(B, 1); SBAR();
    PV_RD(B, 3); PV_W(8); PV_MM(A, 2); SBAR();
    PV_W(0); PV_MM(B, 3);
#undef PV_W
#undef PV_MM
#undef PV_RD
#undef TRRD
}

template <int DQ, bool CAUSAL, int qstride, int vstride, int ostride, bool QREG, class CV>
__device__ __forceinline__ void attn_item(CV& cv, char* lds, LAS unsigned char* ldsl, const bf16* Qb, const bf16* Kh, const bf16* Vh, bf16* Ob,
                                          const int* pos, int q0, int nkt, const int* tmin, const int* tmax) {
    constexpr int KSTR = DQ * 2, KBYTES = 64 * KSTR, NCH = DQ / 64, CPR = DQ / 8, ND0 = DQ / 16;
#define KSW(r) (DQ == 192 ? (((r) >> 1) & 7) : ((r) & 7))
    const int tid = fresh_tid(), wid = __builtin_amdgcn_readfirstlane(tid >> 6), lane = tid & 63, r32 = lane & 31, hi = lane >> 5;
    char* K_lds = lds + A_KOFF; char* V_lds = lds + A_VOFF;
    float* wsf = (float*)(lds + A_WS) + wid * 64; float* li_l = wsf; float* al_l = wsf + 32;
    int* posk = (int*)(lds + A_POSK); int* tlist = (int*)(lds + A_LIST); int* tmxl = tlist + 132;
    int NT = nkt;
    if constexpr (CAUSAL) {
        if (wid == 0) {
            const int qt = q0 >> 6; int qmax = tmax[qt]; qmax = max(qmax, tmax[qt + 1]); qmax = max(qmax, tmax[qt + 2]); qmax = max(qmax, tmax[qt + 3]);
            const bool n0 = lane < nkt && tmin[lane] <= qmax, n1 = lane + 64 < nkt && tmin[lane + 64] <= qmax;
            const unsigned long long b0 = __ballot(n0), b1 = __ballot(n1); const int c0 = __popcll(b0);
            const unsigned long long below = (lane == 0) ? 0ull : (~0ull >> (64 - lane));
            if (n0) { const int ix = __popcll(b0 & below); tlist[ix] = lane; tmxl[ix] = tmax[lane]; }
            if (n1) { const int ix = c0 + __popcll(b1 & below); tlist[ix] = lane + 64; tmxl[ix] = tmax[lane + 64]; }
            if (lane == 0) tlist[128] = c0 + __popcll(b1);
        }
        __syncthreads();
        NT = tlist[128];
    }
#define TILE(t) (CAUSAL ? __builtin_amdgcn_readfirstlane(tlist[t]) : (t))
    int ksrc[NCH], vsrc[2];
#pragma unroll
    for (int jj = 0; jj < NCH; ++jj) { const int p = jj * 512 + tid, row = p / CPR, cs = p % CPR, cc = (cs & ~7) | ((cs & 7) ^ KSW(row)); ksrc[jj] = row * DQ + cc * 8; }
#pragma unroll
    for (int jj = 0; jj < 2; ++jj) { const int p = jj * 512 + tid, kk = (p >> 7) * 8 + ((p & 31) >> 2), k = (kk & ~0xC) | ((kk & 4) << 1) | ((kk & 8) >> 1), cv = ((p >> 5) & 3) * 32 + (p & 3) * 8; vsrc[jj] = k * vstride + cv; }
    int stP = 0;
    const unsigned ldsbase = (unsigned)__builtin_amdgcn_readfirstlane((int)(unsigned)(size_t)ldsl + wid * 1024);
#define A_STAGE(tile_, bf, vbf) do { const int kb_ = (tile_) * 64; \
        _Pragma("unroll") for (int jj = 0; jj < NCH; ++jj) glds16(Kh + (size_t)kb_ * DQ + ksrc[jj], ldsbase + A_KOFF + (bf) * KBYTES + jj * 8192); \
        _Pragma("unroll") for (int jj = 0; jj < 2; ++jj) glds16(Vh + (size_t)kb_ * vstride + vsrc[jj], ldsbase + A_VOFF + (vbf) * 16384 + jj * 8192); \
        if (CAUSAL && tid < 64) stP = pos[kb_ + tid]; } while (0)
#define A_POSW(bf) do { if (CAUSAL && tid < 64) posk[(bf) * 64 + tid] = stP; } while (0)
    A_STAGE(TILE(0), 0, 0);
    bf16x8 qr[QREG ? ND0 : 1];
    if constexpr (QREG) {
#pragma unroll
        for (int d0 = 0; d0 < ND0; ++d0) qr[d0] = *(const bf16x8*)(Qb + (size_t)(wid * 32 + r32) * qstride + d0 * 16 + hi * 8); }
    int wminq = 0;
    if constexpr (CAUSAL) { int v = pos[q0 + wid * 32 + r32];
#pragma unroll
        for (int o_ = 1; o_ < 32; o_ <<= 1) v = min(v, __shfl_xor(v, o_));
        wminq = __builtin_amdgcn_readfirstlane(v); }
    A_POSW(0);
    asm volatile("s_waitcnt vmcnt(0)" ::: "memory");
    if constexpr (QREG) {
#pragma unroll
        for (int d0 = 0; d0 < ND0; ++d0) asm volatile("" : "+v"(qr[d0]));
    }
    __syncthreads();
    float m_reg = -1e30f, l_reg = 0.f; f32x16 o[4] = {};
    const int vb0 = (int)(uintptr_t)V_lds + v_rd_base(lane);
    int kbv[4];
#pragma unroll
    for (int dd = 0; dd < 4; ++dd) kbv[dd] = r32 * KSTR + (((dd * 2 + hi) ^ KSW(r32)) << 4);
    bf16x8 pa0 = {}, pa1 = {}, pa2 = {}, pa3 = {};
    int vcur = 0;
    if (wid >= 4) __builtin_amdgcn_s_setprio(1);
#define PK4(P, B_, OUT) do { unsigned a0 = cvt_pk_bf16(P[B_+0], P[B_+1]), a1 = cvt_pk_bf16(P[B_+2], P[B_+3]); \
        unsigned b0 = cvt_pk_bf16(P[B_+4], P[B_+5]), b1 = cvt_pk_bf16(P[B_+6], P[B_+7]); \
        auto r0 = __builtin_amdgcn_permlane32_swap(a0, b0, false, false); auto r1 = __builtin_amdgcn_permlane32_swap(a1, b1, false, false); \
        u32x4 w = {r0[0], r1[0], r0[1], r1[1]}; OUT = *reinterpret_cast<bf16x8*>(&w); } while (0)
#define SM_SLICE(b_) do { \
        if ((b_) == 0) { pmax_ = p0[0]; _Pragma("unroll") for (int r = 1; r < 16; ++r) pmax_ = fmaxf(pmax_, p0[r]); _Pragma("unroll") for (int r = 0; r < 16; ++r) pmax_ = fmaxf(pmax_, p1[r]); } \
        else if ((b_) == 1) { auto rr = __builtin_amdgcn_permlane32_swap(__float_as_uint(pmax_), __float_as_uint(pmax_), false, false); pmax_ = fmaxf(__uint_as_float(rr[0]), __uint_as_float(rr[1])); \
            const bool keep_ = __all(pmax_ - m_reg <= 8.0f); mn_ = keep_ ? m_reg : fmaxf(m_reg, pmax_); alpha_ = keep_ ? 1.0f : __builtin_amdgcn_exp2f(m_reg - mn_); m_reg = mn_; \
            _Pragma("unroll") for (int r = 0; r < 16; ++r) { p0[r] = __builtin_amdgcn_exp2f(p0[r] - mn_); ps_ += p0[r]; } } \
        else if ((b_) == 2) { _Pragma("unroll") for (int r = 0; r < 16; ++r) { p1[r] = __builtin_amdgcn_exp2f(p1[r] - mn_); ps_ += p1[r]; } } \
        else { auto rr = __builtin_amdgcn_permlane32_swap(__float_as_uint(ps_), __float_as_uint(ps_), false, false); l_reg = l_reg * alpha_ + (__uint_as_float(rr[0]) + __uint_as_float(rr[1])); } } while (0)
#define TRRD(dst, off) asm volatile("ds_read_b64_tr_b16 %0, %1 offset:%2" : "=&v"(dst) : "v"(vbx_), "i"(off) : "memory")
#define PV_RD(S, d0) do { constexpr int b_ = v_rd_off(d0, 0, 0); \
        TRRD(l##S[0], b_); TRRD(h##S[0], b_ + 2048); TRRD(l##S[1], b_ + 4096); TRRD(h##S[1], b_ + 6144); TRRD(l##S[2], b_ + 8192); TRRD(h##S[2], b_ + 10240); TRRD(l##S[3], b_ + 12288); TRRD(h##S[3], b_ + 14336); } while (0)
#define PV_MM(S, d0) do { \
        o[d0] = __builtin_amdgcn_mfma_f32_32x32x16_bf16(pa0, (bf16x8){l##S[0][0], l##S[0][1], l##S[0][2], l##S[0][3], h##S[0][0], h##S[0][1], h##S[0][2], h##S[0][3]}, o[d0], 0, 0, 0);   \
        o[d0] = __builtin_amdgcn_mfma_f32_32x32x16_bf16(pa1, (bf16x8){l##S[1][0], l##S[1][1], l##S[1][2], l##S[1][3], h##S[1][0], h##S[1][1], h##S[1][2], h##S[1][3]}, o[d0], 0, 0, 0);   \
        o[d0] = __builtin_amdgcn_mfma_f32_32x32x16_bf16(pa2, (bf16x8){l##S[2][0], l##S[2][1], l##S[2][2], l##S[2][3], h##S[2][0], h##S[2][1], h##S[2][2], h##S[2][3]}, o[d0], 0, 0, 0);   \
        o[d0] = __builtin_amdgcn_mfma_f32_32x32x16_bf16(pa3, (bf16x8){l##S[3][0], l##S[3][1], l##S[3][2], l##S[3][3], h##S[3][0], h##S[3][1], h##S[3][2], h##S[3][3]}, o[d0], 0, 0, 0); } while (0)
#define PV_W(n) do { asm volatile("s_waitcnt lgkmcnt(" #n ")" ::: "memory"); SBAR(); } while (0)
#define TILE_ITER(DOPV_) do { \
        const int buf = t & 1; \
        const int vnext = vcur == 2 ? 0 : vcur + 1, vprev = vcur == 0 ? 2 : vcur - 1; \
        cv.finish();                                                   \
        if (t + 1 < NT) { if (buf == 0) A_STAGE(TILE(t + 1), 1, vnext); else A_STAGE(TILE(t + 1), 0, vnext); } \
        cv.issue();                                                    \
        SBAR(); \
        f32x16 p0 = {}, p1 = {}; \
        { const char* kb_ = K_lds + buf * KBYTES; int qo = (wid * 32 + r32) * qstride + hi * 8; if (!QREG) asm volatile("" : "+v"(qo)); \
          bf16x8 ka[2][2];                                             \
          bf16x8 qn_ = {}; if constexpr (!QREG) qn_ = *(const bf16x8*)(Qb + qo);        \
          KRD(0); SBAR(); \
          _Pragma("unroll") for (int d0 = 0; d0 < ND0; ++d0) { \
              if (d0 + 1 < ND0) KRD(d0 + 1); \
              bf16x8 qf; if constexpr (QREG) qf = qr[d0]; else { qf = qn_; if (d0 + 1 < ND0) qn_ = *(const bf16x8*)(Qb + qo + (d0 + 1) * 16); } \
              SBAR(); \
              p0 = __builtin_amdgcn_mfma_f32_32x32x16_bf16(ka[d0 & 1][0], qf, p0, 0, 0, 0); \
              p1 = __builtin_amdgcn_mfma_f32_32x32x16_bf16(ka[d0 & 1][1], qf, p1, 0, 0, 0); SBAR(); } } \
        if constexpr (CAUSAL) { \
            if (__builtin_amdgcn_readfirstlane(tmxl[t]) > wminq) {                         \
                const float NEG = -__builtin_inff(); const int* pk = posk + buf * 64 + 4 * hi; const int posq = pos[q0 + wid * 32 + (fresh_tid() & 31)];        \
                _Pragma("unroll") for (int g = 0; g < 4; ++g) { const int4 k0 = *(const int4*)(pk + 8 * g), k1 = *(const int4*)(pk + 32 + 8 * g); \
                    if (k0.x > posq) p0[4 * g + 0] = NEG; if (k0.y > posq) p0[4 * g + 1] = NEG; if (k0.z > posq) p0[4 * g + 2] = NEG; if (k0.w > posq) p0[4 * g + 3] = NEG; \
                    if (k1.x > posq) p1[4 * g + 0] = NEG; if (k1.y > posq) p1[4 * g + 1] = NEG; if (k1.z > posq) p1[4 * g + 2] = NEG; if (k1.w > posq) p1[4 * g + 3] = NEG; } \
            } } \
        SBAR(); \
        float pmax_ = 0.f, mn_ = 0.f, alpha_ = 1.f, ps_ = 0.f; \
        if (DOPV_) { const int vbx_ = vb0 + vprev * 16384; s16x4 lA[4], hA[4], lB[4], hB[4]; \
            PV_RD(A, 0); PV_RD(B, 1); PV_W(8); PV_MM(A, 0); SM_SLICE(0); SBAR(); \
            PV_RD(A, 2); PV_W(8); PV_MM(B, 1); SM_SLICE(1); SBAR(); \
            PV_RD(B, 3); PV_W(8); PV_MM(A, 2); SM_SLICE(2); SBAR(); \
            PV_W(0); PV_MM(B, 3); SM_SLICE(3); SBAR(); } \
        else { SM_SLICE(0); SM_SLICE(1); SM_SLICE(2); SM_SLICE(3); SBAR(); } \
        if (__any(alpha_ < 1.f)) { if (hi == 0) al_l[r32] = alpha_; asm volatile("s_waitcnt lgkmcnt(0)" ::: "memory"); \
            _Pragma("unroll") for (int r = 0; r < 16; ++r) { const float a = al_l[crow(r, hi)]; \
                _Pragma("unroll") for (int d_ = 0; d_ < 4; ++d_) o[d_][r] *= a; } } \
        PK4(p0, 0, pa0); PK4(p0, 8, pa1); PK4(p1, 0, pa2); PK4(p1, 8, pa3);        \
        SBAR(); \
        vcur = vnext; \
        if (t + 1 < NT) { if (buf == 0) A_POSW(1); else A_POSW(0); } \
        if (cv.pending()) asm volatile("s_waitcnt vmcnt(16)" ::: "memory"); else asm volatile("s_waitcnt vmcnt(0)" ::: "memory");        \
        __syncthreads(); } while (0)
#define KRD(d0_) do { const char* a_ = kb_ + kbv[(d0_) & 3] + ((d0_) >> 2) * 128; ka[(d0_) & 1][0] = *(const bf16x8*)a_; ka[(d0_) & 1][1] = *(const bf16x8*)(a_ + 32 * KSTR); } while (0)
    { const int t = 0; TILE_ITER(false); }
    for (int t = 1; t < NT; ++t) TILE_ITER(true);
    {
        const int vlast = vcur == 0 ? 2 : vcur - 1; const int vbx_ = vb0 + vlast * 16384; s16x4 lA[4], hA[4], lB[4], hB[4];
        PV_RD(A, 0); PV_RD(B, 1); PV_W(8); PV_MM(A, 0); SBAR();
        PV_RD(A, 2); PV_W(8); PV_MM(B, 1); SBAR();
        PV_RD(B, 3); PV_W(8); PV_MM(A, 2); SBAR();
        PV_W(0); PV_MM(B, 3); }
#undef KRD
#undef TILE_ITER
#undef PV_W
#undef PV_MM
#undef PV_RD
#undef TRRD
#undef SM_SLICE
#undef PK4
    __builtin_amdgcn_s_setprio(0);
    if (hi == 0) li_l[r32] = l_reg; asm volatile("s_waitcnt lgkmcnt(0)" ::: "memory");
    int oofs = (wid * 32 + 4 * hi) * ostride + r32; asm volatile("" : "+v"(oofs));
    bf16* Ow = Ob + oofs;
#pragma unroll
    for (int r = 0; r < 16; ++r) { constexpr int dummy = 0; (void)dummy; const int orow = crow(r, hi); const float rl = __builtin_amdgcn_rcpf(li_l[orow]);
#pragma unroll
        for (int d0 = 0; d0 < 4; ++d0) { const float v = o[d0][r] * rl; const float vn = __shfl_xor(v, 1);
            if ((r32 & 1) == 0) *(unsigned*)(Ow + ((r & 3) + 8 * (r >> 2)) * ostride + d0 * 32) = cvt_pk_bf16(v, vn); } }
    __syncthreads();
#undef A_STAGE
#undef A_POSW
#undef KSW
#undef TILE
}
}
namespace s5 {
constexpr int TROW = 136;
constexpr int WAVE_LDS = 32 * TROW * 2;
__device__ __forceinline__ void cmul(float ar, float ai, float br, float bi, float& cr, float& ci) { cr = ar * br - ai * bi; ci = ar * bi + ai * br; }
__device__ __forceinline__ float gelu_tanh(float x) { const float z = 1.5957691216057308f * (x + 0.044715f * x * x * x); return x * sigmoidf_(z); }

template <int PART>
__device__ __forceinline__ void s5_wave(char* ldsw, int g, int c0, const bf16* U, const f32x2* LAM, const bf16* BB, const bf16* CP, const float* Dd, float* ES, bf16* YS, int lane) {
    const int c = lane & 31, hi = lane >> 5;
    float l1r[2], l1i[2], l2r[2], l2i[2], l3r[2], l3i[2], l4r[2], l4i[2];
    bf16x8 bfrag[2][2];
#pragma unroll
    for (int sb = 0; sb < 2; ++sb) { const f32x2 lm = LAM[g * 64 + 32 * sb + c]; l1r[sb] = lm.x; l1i[sb] = lm.y;
        cmul(l1r[sb], l1i[sb], l1r[sb], l1i[sb], l2r[sb], l2i[sb]); cmul(l2r[sb], l2i[sb], l1r[sb], l1i[sb], l3r[sb], l3i[sb]); cmul(l2r[sb], l2i[sb], l2r[sb], l2i[sb], l4r[sb], l4i[sb]);
#pragma unroll
        for (int ri = 0; ri < 2; ++ri) bfrag[sb][ri] = *(const bf16x8*)(BB + ((size_t)(g * 128 + 64 * ri + 32 * sb + c)) * 16 + 8 * hi); }
    float sr[2] = {0.f, 0.f}, si[2] = {0.f, 0.f};
    bf16x8 cpf[8];
    if constexpr (PART == 2) {
        float l64r[2], l64i[2];
#pragma unroll
        for (int sb = 0; sb < 2; ++sb) { float ar = l4r[sb], ai = l4i[sb];
#pragma unroll
            for (int k = 0; k < 4; ++k) { float tr, ti; cmul(ar, ai, ar, ai, tr, ti); ar = tr; ai = ti; }
            l64r[sb] = ar; l64i[sb] = ai; }
        for (int cc = 0; cc < c0; ++cc) { const float* e = ES + ((size_t)g * 128 + cc) * 128;
#pragma unroll
            for (int sb = 0; sb < 2; ++sb) { const float er = e[32 * sb + c], ei = e[64 + 32 * sb + c]; float tr, ti; cmul(l64r[sb], l64i[sb], sr[sb], si[sb], tr, ti); sr[sb] = tr + er; si[sb] = ti + ei; } }
#pragma unroll
        for (int ks = 0; ks < 8; ++ks) { cpf[ks] = (bf16x8){0, 0, 0, 0, 0, 0, 0, 0}; if (c < 16) cpf[ks] = *(const bf16x8*)(CP + ((size_t)(g * 16 + c)) * 128 + 16 * ks + 8 * hi); }
    }
    bf16* T = (bf16*)ldsw;
    bf16x8 afn = *(const bf16x8*)(U + (size_t)(c0 * 2 * 32 + c) * S5W + g * 16 + 8 * hi);
    f32x4 da = {}, db = {};
    if constexpr (PART == 2) { da = *(const f32x4*)(Dd + g * 16 + 4 * hi); db = *(const f32x4*)(Dd + g * 16 + 8 + 4 * hi); }
    for (int blk = 0; blk < 8; ++blk) {
        const int t0 = (c0 * 2 + blk) * 32;
        if (PART == 1 && (blk & 1) == 0) { sr[0] = 0.f; si[0] = 0.f; sr[1] = 0.f; si[1] = 0.f; }
        const bf16x8 af = afn;
        if (blk + 1 < 8) afn = *(const bf16x8*)(U + (size_t)(t0 + 32 + c) * S5W + g * 16 + 8 * hi);
#pragma unroll
        for (int sb = 0; sb < 2; ++sb) {
            f32x16 br = {}, bi = {};
            br = __builtin_amdgcn_mfma_f32_32x32x16_bf16(af, bfrag[sb][0], br, 0, 0, 0);
            bi = __builtin_amdgcn_mfma_f32_32x32x16_bf16(af, bfrag[sb][1], bi, 0, 0, 0);
#pragma unroll
            for (int q4 = 0; q4 < 4; ++q4)
#pragma unroll
                for (int k = 1; k < 4; ++k) { const int r = 4 * q4 + k; float tr, ti; cmul(l1r[sb], l1i[sb], br[r - 1], bi[r - 1], tr, ti); br[r] += tr; bi[r] += ti; }
            float per[4], pei[4];
#pragma unroll
            for (int q4 = 0; q4 < 4; ++q4) { per[q4] = __shfl_xor(br[4 * q4 + 3], 32); pei[q4] = __shfl_xor(bi[4 * q4 + 3], 32); }
            float cr = sr[sb], ci = si[sb], cinr[4], cini[4];
#pragma unroll
            for (int q = 0; q < 8; ++q) { const bool own = ((q & 1) == hi); const int q4 = q >> 1;
                if ((q & 1) == 0) { if (hi == 0) { cinr[q4] = cr; cini[q4] = ci; } } else { if (hi == 1) { cinr[q4] = cr; cini[q4] = ci; } }
                const float er = own ? br[4 * q4 + 3] : per[q4], ei = own ? bi[4 * q4 + 3] : pei[q4];
                float tr, ti; cmul(l4r[sb], l4i[sb], cr, ci, tr, ti); cr = tr + er; ci = ti + ei; }
            sr[sb] = cr; si[sb] = ci;
            if constexpr (PART == 2) {
#pragma unroll
                for (int q4 = 0; q4 < 4; ++q4) { float tr, ti;
                    cmul(l1r[sb], l1i[sb], cinr[q4], cini[q4], tr, ti); br[4 * q4 + 0] += tr; bi[4 * q4 + 0] += ti;
                    cmul(l2r[sb], l2i[sb], cinr[q4], cini[q4], tr, ti); br[4 * q4 + 1] += tr; bi[4 * q4 + 1] += ti;
                    cmul(l3r[sb], l3i[sb], cinr[q4], cini[q4], tr, ti); br[4 * q4 + 2] += tr; bi[4 * q4 + 2] += ti;
                    cmul(l4r[sb], l4i[sb], cinr[q4], cini[q4], tr, ti); br[4 * q4 + 3] += tr; bi[4 * q4 + 3] += ti; }
#pragma unroll
                for (int r = 0; r < 16; ++r) { const int tok = (r & 3) + 8 * (r >> 2) + 4 * hi;
                    T[tok * TROW + 32 * sb + c] = (bf16)f2bf(br[r]); T[tok * TROW + 64 + 32 * sb + c] = (bf16)f2bf(bi[r]); }
            }
        }
        if constexpr (PART == 1) {
            if ((blk & 1) == 1 && hi == 0) { float* e = ES + ((size_t)g * 128 + c0 + (blk >> 1)) * 128;
#pragma unroll
                for (int sb = 0; sb < 2; ++sb) { e[32 * sb + c] = sr[sb]; e[64 + 32 * sb + c] = si[sb]; } }
        } else {
            asm volatile("s_waitcnt lgkmcnt(0)" ::: "memory"); __builtin_amdgcn_wave_barrier(); asm volatile("" ::: "memory");
            f32x16 acc = {};
#pragma unroll
            for (int ks = 0; ks < 8; ++ks) { const bf16x8 sfrag = *(const bf16x8*)(T + c * TROW + 16 * ks + 8 * hi);
                acc = __builtin_amdgcn_mfma_f32_32x32x16_bf16(cpf[ks], sfrag, acc, 0, 0, 0); }
            const size_t ro = (size_t)(t0 + c) * S5W + g * 16;
            const f32x4 ua = pg8::unpack4(*(const u32x2*)(U + ro + 4 * hi)), ub = pg8::unpack4(*(const u32x2*)(U + ro + 8 + 4 * hi));
            f32x4 ya, yb;
#pragma unroll
            for (int e = 0; e < 4; ++e) { ya[e] = gelu_tanh(acc[e] + da[e] * ua[e]); yb[e] = gelu_tanh(acc[4 + e] + db[e] * ub[e]); }
            *(u32x2*)(YS + ro + 4 * hi) = pg8::pack4(ya); *(u32x2*)(YS + ro + 8 + 4 * hi) = pg8::pack4(yb);
            asm volatile("" ::: "memory"); __builtin_amdgcn_wave_barrier();
        }
    }
}
}
struct MapId   { __device__ __forceinline__ int operator()(int n) const { return n; } };
struct MapInProj { __device__ __forceinline__ int operator()(int n) const { return n < 1472 ? n : (n < 1536 ? -1 : (n < 2112 ? n - 64 : (n < 2304 ? -1 : n - 256))); } };
struct MapGlu  { int half; __device__ __forceinline__ int operator()(int n) const { const int j = n >> 8, r = n & 255; return r < 128 ? 128 * j + r : half + 128 * j + (r - 128); } };
struct MapQB   { __device__ __forceinline__ int operator()(int n) const { const int h = n >> 8, j = n & 255; if (j < 128) return 192 * h + j; if (j >= 192) return -1; const int jj = j - 128; return 192 * h + 128 + 32 * (jj & 1) + (jj >> 1); } };

template <class Map>
__device__ __forceinline__ void transpose_item(const float* W, int N, int K, bf16* WT, int Kd, const float* gain, const Map& map, LAS float* scr, int kb, int nb, int lane) {
    const int k0 = 64 * kb, n0 = 64 * nb; const int scol = map(n0 + lane);
    const bool kin = k0 < K;
    float v[64];
    const float* src = W + (size_t)k0 * N + (scol >= 0 ? scol : 0);
    if (kin && scol >= 0) {
#pragma unroll
        for (int kk = 0; kk < 64; ++kk) v[kk] = __builtin_nontemporal_load(src + (size_t)kk * N);
        if (gain) {
#pragma unroll
            for (int kk = 0; kk < 64; ++kk) v[kk] *= gain[k0 + kk];
        }
    } else {
#pragma unroll
        for (int kk = 0; kk < 64; ++kk) v[kk] = 0.f;
    }
    LAS unsigned char* sb = (LAS unsigned char*)scr;
#pragma unroll
    for (int c = 0; c < 8; ++c) { u32x4 o; o.x = cvt_pk_bf16(v[8 * c], v[8 * c + 1]); o.y = cvt_pk_bf16(v[8 * c + 2], v[8 * c + 3]); o.z = cvt_pk_bf16(v[8 * c + 4], v[8 * c + 5]); o.w = cvt_pk_bf16(v[8 * c + 6], v[8 * c + 7]);
        *(LAS u32x4*)(sb + lane * 144 + c * 16) = o; }
    const int rr = lane >> 3, cc = lane & 7;
#pragma unroll
    for (int i = 0; i < 8; ++i) { const u32x4 w = *(const LAS u32x4*)(sb + (8 * i + rr) * 144 + cc * 16);
        *(GAS u32x4*)(WT + (size_t)(n0 + 8 * i + rr) * Kd + k0 + 8 * cc) = w; }
}
template <class Map>
__device__ __forceinline__ void transpose_item_i8(const float* W, int N, signed char* WT, int Kd, const float* gain, float inv_step, const Map& map, int kb, int nb, int lane, bool nostore = false) {
    const int k0 = 64 * kb, n0 = 64 * nb; const int scol = map(n0 + lane);
    float v[64];
    const float* src = W + (size_t)k0 * N + scol;
#pragma unroll
    for (int kk = 0; kk < 64; ++kk) v[kk] = __builtin_nontemporal_load(src + (size_t)kk * N);
    signed char* dst = WT + (size_t)(n0 + lane) * Kd + k0;
#pragma unroll
    for (int c = 0; c < 4; ++c) { u32x4 o;
#pragma unroll
        for (int d = 0; d < 4; ++d) { unsigned w = 0;
#pragma unroll
            for (int b = 0; b < 4; ++b) { const int kk = 16 * c + 4 * d + b; const float q = fminf(fmaxf(rintf(v[kk] * (gain ? gain[k0 + kk] : 1.0f) * inv_step), -127.f), 127.f); w |= ((unsigned)(int)q & 0xffu) << (8 * b); }
            o[d] = w; }
        if (nostore) asm volatile("" :: "v"(o)); else *(GAS u32x4*)(dst + 16 * c) = o; }
}
__device__ __forceinline__ void transpose_item_f8(const float* W, int N, unsigned char* WT, int Kd, float scale, int kb, int nb, int lane) {
    const int k0 = 64 * kb, n0 = 64 * nb;
    float v[64];
    const float* src = W + (size_t)k0 * N + n0 + lane;
#pragma unroll
    for (int kk = 0; kk < 64; ++kk) v[kk] = __builtin_nontemporal_load(src + (size_t)kk * N);
    unsigned char* dst = WT + (size_t)(n0 + lane) * Kd + k0;
#pragma unroll
    for (int c = 0; c < 4; ++c) { u32x4 o;
#pragma unroll
        for (int d = 0; d < 4; ++d) { const int kk = 16 * c + 4 * d; int w = 0; w = __builtin_amdgcn_cvt_pk_fp8_f32(v[kk] * scale, v[kk + 1] * scale, w, false); w = __builtin_amdgcn_cvt_pk_fp8_f32(v[kk + 2] * scale, v[kk + 3] * scale, w, true); o[d] = (unsigned)w; }
        *(GAS u32x4*)(dst + 16 * c) = o; }
}
__device__ __forceinline__ float sample_step(const float* W, int N, int K, const float* gain, int lane, int ncols = 0) {
    float mx = 0.f; if (ncols == 0) ncols = N;
#pragma unroll
    for (int i = 0; i < 16; ++i) { const int k = (i * 131 + 7) % K, n = (lane * 211 + i * 1319) % ncols; mx = fmaxf(mx, fabsf(W[(size_t)k * N + n] * (gain ? gain[k] : 1.0f))); }
#pragma unroll
    for (int o = 1; o < 64; o <<= 1) mx = fmaxf(mx, __shfl_xor(mx, o));
    return fmaxf(mx, 1e-20f) * (2.0f / 127.0f);
}
__device__ __forceinline__ float sample_scale_f8(const float* W, int N, int K, int lane) {
    float mx = 0.f;
#pragma unroll
    for (int i = 0; i < 16; ++i) { const int k = (i * 131 + 7) % K, n = (lane * 211 + i * 1319) % N; mx = fmaxf(mx, fabsf(W[(size_t)k * N + n])); }
#pragma unroll
    for (int o = 1; o < 64; o <<= 1) mx = fmaxf(mx, __shfl_xor(mx, o));
    return exp2f(floorf(log2f(224.0f / fmaxf(mx, 1e-20f))));
}
template <class Map>
__device__ __forceinline__ void transpose_job(const float* W, size_t wstride, int N, int K, bf16* WT, size_t wtstride, int Kd, int Nd, const float* gain, int gstride, int ninst, const Map& map,
                                              LAS float* scr, int gw, int NGW, int lane) {
    const int nkb = Kd / 64, nnb = Nd / 64, per = nkb * nnb;
    for (int it = gw; it < per * ninst; it += NGW) { const int inst = it / per, r = it - inst * per, nb = r / nkb, kb = r - nb * nkb;
        transpose_item(W + (size_t)inst * wstride, N, K, WT + (size_t)inst * wtstride, Kd, gain ? gain + (size_t)inst * gstride : nullptr, map, scr, kb, nb, lane); }
}
__device__ __forceinline__ float row_to_bf16(const float* xrow, bf16* orow, bool normalize, int lane) {
    const GAS f32x4* xr = (const GAS f32x4*)xrow + lane;
    f32x4 v[8]; float s = 0.f;
#pragma unroll
    for (int j = 0; j < 8; ++j) { v[j] = xr[64 * j]; s += pg8::sq4(v[j]); }
    s = wave_sum(s);
    const float sc = normalize ? 1.0f / sqrtf(s * (1.0f / DM) + EPS) : 1.0f;
    GAS u32x2* o8 = (GAS u32x2*)orow + lane;
#pragma unroll
    for (int j = 0; j < 8; ++j) o8[64 * j] = pg8::pack4(v[j] * sc);
    return s;
}
__device__ __forceinline__ void router_token(const float* xrow, const float* gain, const float* R, const float* rb, int tok, unsigned* cnt, int* list, int* toke, int* toks, float* tokw, signed char* XQ, float* rscale, float* rss, int lane) {
    float lg[8] = {0.f, 0.f, 0.f, 0.f, 0.f, 0.f, 0.f, 0.f}; float ssq = 0.f, amax = 0.f;
#pragma unroll 2
    for (int j = 0; j < 8; ++j) { const int k0 = 256 * j + 4 * lane; const f32x4 xv = *(const f32x4*)(xrow + k0), gv = *(const f32x4*)(gain + k0); ssq += pg8::sq4(xv); { const f32x4 hv = xv * gv; amax = fmaxf(fmaxf(amax, fmaxf(fabsf(hv[0]), fabsf(hv[1]))), fmaxf(fabsf(hv[2]), fabsf(hv[3]))); }
#pragma unroll
        for (int e = 0; e < 4; ++e) { const float h = xv[e] * gv[e]; const f32x4 r0 = *(const f32x4*)(R + (size_t)(k0 + e) * 8), r1 = *(const f32x4*)(R + (size_t)(k0 + e) * 8 + 4);
            lg[0] += h * r0[0]; lg[1] += h * r0[1]; lg[2] += h * r0[2]; lg[3] += h * r0[3]; lg[4] += h * r1[0]; lg[5] += h * r1[1]; lg[6] += h * r1[2]; lg[7] += h * r1[3]; } }
    ssq = wave_sum(ssq); const float rstd = 1.0f / sqrtf(ssq * (1.0f / DM) + EPS);
#pragma unroll
    for (int o = 1; o < 64; o <<= 1) amax = fmaxf(amax, __shfl_xor(amax, o));
    amax = fmaxf(amax, 1e-20f);
    {
        const float qs = 127.0f / amax;
        f32x4 xg[8];
#pragma unroll
        for (int j = 0; j < 8; ++j) { const int k0 = 256 * j + 4 * lane; xg[j] = *(const f32x4*)(xrow + k0) * *(const f32x4*)(gain + k0); }
#pragma unroll
        for (int j = 0; j < 8; ++j) { const int k0 = 256 * j + 4 * lane; unsigned w = 0;
#pragma unroll
            for (int e = 0; e < 4; ++e) w |= ((unsigned)(int)rintf(xg[j][e] * qs) & 0xffu) << (8 * e);
            *(unsigned*)(XQ + (size_t)tok * DM + k0) = w; }
        if (lane == 0) rscale[tok] = rstd * amax * (1.0f / 127.0f);
    }
    const float rowscale = rstd * amax * (1.0f / 127.0f);
#pragma unroll
    for (int e = 0; e < 8; ++e) lg[e] = wave_sum(lg[e]) * rstd + rb[e];
    if (lane == 0) {
        int i1 = 0; float v1 = lg[0];
#pragma unroll
        for (int e = 1; e < 8; ++e) if (lg[e] > v1) { v1 = lg[e]; i1 = e; }
        int i2 = -1; float v2 = -3.0e38f;
#pragma unroll
        for (int e = 0; e < 8; ++e) if (e != i1 && lg[e] > v2) { v2 = lg[e]; i2 = e; }
        const float w1 = 1.0f / (1.0f + expf(v2 - v1)), w2 = 1.0f - w1;
        const int s1 = (int)atomicAdd(cnt + 64 * i1, 1u), s2 = (int)atomicAdd(cnt + 64 * i2, 1u);
        list[i1 * SEQ + s1] = tok; list[i2 * SEQ + s2] = tok; rss[i1 * SEQ + s1] = rowscale; rss[i2 * SEQ + s2] = rowscale;
        toke[2 * tok] = i1; toke[2 * tok + 1] = i2; toks[2 * tok] = s1; toks[2 * tok + 1] = s2; tokw[2 * tok] = w1; tokw[2 * tok + 1] = w2;
    }
}

__device__ __forceinline__ void quant_row_i8(const bf16* arow, signed char* qrow, float* rstep, int lane) {
    u32x4 v[14]; float amax = 0.f;
#pragma unroll
    for (int j = 0; j < 14; ++j) { v[j] = *(const u32x4*)(arow + (size_t)(j * 64 + lane) * 8);
#pragma unroll
        for (int e = 0; e < 4; ++e) amax = fmaxf(amax, fmaxf(fabsf(bflo(v[j][e])), fabsf(bfhi(v[j][e])))); }
#pragma unroll
    for (int o = 1; o < 64; o <<= 1) amax = fmaxf(amax, __shfl_xor(amax, o));
    amax = fmaxf(amax, 1e-20f); const float qs = 127.0f / amax;
#pragma unroll
    for (int j = 0; j < 14; ++j) { u32x2 w;
#pragma unroll
        for (int h = 0; h < 2; ++h) { unsigned x = 0;
#pragma unroll
            for (int e = 0; e < 2; ++e) { const unsigned d = v[j][2 * h + e]; x |= ((unsigned)(int)rintf(bflo(d) * qs) & 0xffu) << (16 * e); x |= ((unsigned)(int)rintf(bfhi(d) * qs) & 0xffu) << (16 * e + 8); }
            w[h] = x; }
        *(u32x2*)(qrow + (size_t)(j * 64 + lane) * 8) = w; }
    if (lane == 0) *rstep = amax * (1.0f / 127.0f);
}

__device__ __forceinline__ const float* uniform_ptr(const float* p) { const unsigned long long v = (unsigned long long)p; const unsigned lo = __builtin_amdgcn_readfirstlane((unsigned)v), hi = __builtin_amdgcn_readfirstlane((unsigned)(v >> 32));
    return (const float*)(((unsigned long long)hi << 32) | lo); }
struct NoConv { __device__ __forceinline__ void issue() {} __device__ __forceinline__ void finish() {} __device__ __forceinline__ bool pending() const { return false; } };
struct MoeConv {
    const float* gu; const float* dn; const float* gain; signed char* wgu; signed char* wdn; const float* wsc;
    int gwv, NGW, lane_unused, j, jend; bool active;
    float v[16]; signed char* dstu; int kbytes; float istep; int ie; unsigned lbuf;
    static constexpr int M_GU = NE * (DM / 16) * (2 * DFF / 64), M_DN = NE * (DFF / 16) * (DM / 64), M_ALL = M_GU + M_DN;
    static constexpr int SLOT = 1056;
    static_assert(M_GU % 4 == 0 && (DM / 16) % 4 == 0 && (DFF / 16) % 4 == 0, "groups of 4 consecutive k blocks stay inside one (expert, row block)");
    __device__ __forceinline__ void issue() {
        active = false; if (j >= jend) return;
        const int m = __builtin_amdgcn_readfirstlane(((j >> 2) * NGW + gwv) * 4 + (j & 3)); if (m >= M_ALL) { j = jend; return; }
        active = true; const float* src; int N;
        if (m < M_GU) { constexpr int per = (DM / 16) * (2 * DFF / 64); const int e = m / per, r = m - e * per, nb = r / (DM / 16), kb = r - nb * (DM / 16);
            const int lane = fresh_tid() & 63; const int nd = 64 * nb + lane, jt = nd >> 8, rr = nd & 255, scol = rr < 128 ? 128 * jt + rr : DFF + 128 * jt + (rr - 128);
            N = 2 * DFF; src = gu + ((size_t)e * DM + 16 * kb) * N + scol; dstu = (signed char*)uniform_ptr((const float*)(wgu + ((size_t)e * 2 * DFF + 64 * nb) * DM + 16 * kb)); kbytes = DM; ie = 32 + e; }
        else { const int m2 = m - M_GU; constexpr int per = (DFF / 16) * (DM / 64); const int e = m2 / per, r = m2 - e * per, nb = r / (DFF / 16), kb = r - nb * (DFF / 16);
            N = DM; src = dn + ((size_t)e * DFF + 16 * kb) * N + 64 * nb + (fresh_tid() & 63); dstu = (signed char*)uniform_ptr((const float*)(wdn + ((size_t)e * DM + 64 * nb) * DFF + 16 * kb)); kbytes = DFF; ie = 24 + e; }
        istep = ((const __attribute__((address_space(4))) float*)wsc)[ie];
#pragma unroll
        for (int kk = 0; kk < 16; ++kk) v[kk] = __builtin_nontemporal_load(src + (size_t)kk * N);
    }
    __device__ __forceinline__ bool pending() const { return active; }
    __device__ __forceinline__ void finish() {
        if (!active) return;
        constexpr float MAGIC = 12582912.0f + 128.0f, LO = 12582913.0f, HI = 12583167.0f;
        u32x4 o;
#pragma unroll
        for (int d = 0; d < 4; ++d) { int t[4];
#pragma unroll
            for (int b = 0; b < 4; ++b) { const int kk = 4 * d + b;
                t[b] = __builtin_bit_cast(int, __builtin_amdgcn_fmed3f(fmaf(v[kk], istep, MAGIC), LO, HI)); }
            const unsigned p0 = __builtin_amdgcn_perm((unsigned)t[1], (unsigned)t[0], 0x0c0c0400u), p1 = __builtin_amdgcn_perm((unsigned)t[3], (unsigned)t[2], 0x04000c0cu);
            o[d] = (p0 | p1) ^ 0x80808080u; }
        const int q = j & 3; const int lane = fresh_tid() & 63;
        { const unsigned la = lbuf + (unsigned)(q * SLOT) + (unsigned)lane * 16u; asm volatile("ds_write_b128 %0, %1" :: "v"(la), "v"(o) : "memory"); }
        if (q == 3) {
            const signed char* gb = dstu - 48;
            const int r0 = lane >> 2, qq = lane & 3; const unsigned ra = lbuf + (unsigned)(qq * SLOT) + (unsigned)r0 * 16u;
            const unsigned go_ = (unsigned)(r0 * kbytes + qq * 16);
            asm volatile("s_waitcnt lgkmcnt(0)" ::: "memory");
#pragma unroll
            for (int i = 0; i < 4; ++i) { u32x4 w; asm volatile("ds_read_b128 %0, %1 offset:%2\n\ts_waitcnt lgkmcnt(0)" : "=v"(w) : "v"(ra), "i"(256 * i) : "memory");
                *(GAS u32x4*)(gb + (size_t)(go_ + (unsigned)(16 * i * kbytes))) = w; }
        }
        ++j;
    }
};

template <class T> __device__ __forceinline__ void quant_xrow_i8(const T* xrow, signed char* qrow, float* rscale, int lane) {
    f32x4 v[8]; float ssq = 0.f, amax = 0.f;
#pragma unroll
    for (int j = 0; j < 8; ++j) { if constexpr (sizeof(T) == 2) v[j] = pg8::unpack4(*(const u32x2*)(xrow + 256 * j + 4 * lane)); else v[j] = *(const f32x4*)(xrow + 256 * j + 4 * lane); ssq += pg8::sq4(v[j]); amax = fmaxf(fmaxf(amax, fmaxf(fabsf(v[j][0]), fabsf(v[j][1]))), fmaxf(fabsf(v[j][2]), fabsf(v[j][3]))); }
    ssq = wave_sum(ssq);
#pragma unroll
    for (int o = 1; o < 64; o <<= 1) amax = fmaxf(amax, __shfl_xor(amax, o));
    amax = fmaxf(amax, 1e-20f); const float qs = 127.0f / amax;
#pragma unroll
    for (int j = 0; j < 8; ++j) { unsigned w = 0;
#pragma unroll
        for (int e = 0; e < 4; ++e) w |= ((unsigned)(int)rintf(v[j][e] * qs) & 0xffu) << (8 * e);
        *(unsigned*)(qrow + 256 * j + 4 * lane) = w; }
    if (lane == 0) *rscale = amax * (1.0f / 127.0f) / sqrtf(ssq * (1.0f / DM) + EPS);
}

__device__ __forceinline__ void quant_row2_i8(const bf16* a0, const bf16* a1, signed char* q0, signed char* q1, float* s0, float* s1, int lane) {
    u32x4 v[2][14]; float amax[2] = {0.f, 0.f};
#pragma unroll
    for (int j = 0; j < 14; ++j) { v[0][j] = __builtin_nontemporal_load((const u32x4*)(a0 + (size_t)(j * 64 + lane) * 8)); v[1][j] = __builtin_nontemporal_load((const u32x4*)(a1 + (size_t)(j * 64 + lane) * 8)); }
#pragma unroll
    for (int w = 0; w < 2; ++w) {
#pragma unroll
        for (int j = 0; j < 14; ++j)
#pragma unroll
            for (int e = 0; e < 4; ++e) amax[w] = fmaxf(amax[w], fmaxf(fabsf(bflo(v[w][j][e])), fabsf(bfhi(v[w][j][e]))));
#pragma unroll
        for (int o = 1; o < 64; o <<= 1) amax[w] = fmaxf(amax[w], __shfl_xor(amax[w], o));
        amax[w] = fmaxf(amax[w], 1e-20f); const float qs = 127.0f / amax[w]; signed char* q = w ? q1 : q0;
#pragma unroll
        for (int j = 0; j < 14; ++j) { u32x2 o2;
#pragma unroll
            for (int h = 0; h < 2; ++h) { unsigned x = 0;
#pragma unroll
                for (int e = 0; e < 2; ++e) { const unsigned d = v[w][j][2 * h + e]; x |= ((unsigned)(int)rintf(bflo(d) * qs) & 0xffu) << (16 * e); x |= ((unsigned)(int)rintf(bfhi(d) * qs) & 0xffu) << (16 * e + 8); }
                o2[h] = x; }
            *(u32x2*)(q + (size_t)(j * 64 + lane) * 8) = o2; }
        if (lane == 0) *(w ? s1 : s0) = amax[w] * (1.0f / 127.0f); }
}
#ifndef MK_STAMP
#define MK_STAMP 0
#endif
#ifndef MK_STAMP_A
#define MK_STAMP_A 0x1u
#define MK_STAMP_B 0x408u
#endif
#ifndef MK_PROBE_NOSTORE
#define MK_PROBE_NOSTORE 0
#endif
#ifndef MK_REPEAT
#define MK_REPEAT 0u
#endif
#define NREP(k) (1 + (int)(((MK_REPEAT) >> (k)) & 1u))
#ifndef MK_PHMASK
#define MK_PHMASK 0xFFFFFFFFu
#endif
#define PH_ON(id) (((MK_PHMASK) >> (id)) & 1u)
constexpr int NWAVES = 8;
constexpr int NPH = 19;
struct Args { const void* in[34]; float* out; unsigned char* ws; int ph_lo, ph_hi; };
static_assert(sizeof(Args) == 34 * 8 + 8 + 8 + 8, "Args has no padding");


__device__ __forceinline__ const void* argp(int i) { const __attribute__((address_space(4))) char* ka = (const __attribute__((address_space(4))) char*)__builtin_amdgcn_kernarg_segment_ptr();
    return *(const void* const volatile __attribute__((address_space(4)))*)(ka + 8 * i); }
__global__ void __launch_bounds__(NWAVES * 64, 2) fwd(Args args) {
    extern __shared__ __attribute__((aligned(16))) unsigned char lds_raw[];
    LAS unsigned char* lds = (LAS unsigned char*)lds_raw;
    volatile LAS unsigned* MISC = (volatile LAS unsigned*)(lds + MISC_OFF);
    const int tid = threadIdx.x, lane = tid & 63, wave = __builtin_amdgcn_readfirstlane(tid >> 6);
    const int G = gridDim.x, bid = blockIdx.x, vcu = (G % 8 == 0) ? (bid % 8) * (G / 8) + bid / 8 : bid;
    const int gw = vcu * NWAVES + wave, NGW = G * NWAVES;
    unsigned char* ws = args.ws;
    gu32* ctl = (gu32*)ws;
    for (int i = tid; i < 64; i += NWAVES * 64) MISC[i] = 0u;
    __syncthreads();
    XcdBarrier bar; bar.bar = (unsigned*)ctl + CW_BAR; bar.x = 0; bar.st = nullptr;
#if !MK_PER_PHASE
    bar = xcd_barrier_post((unsigned*)ctl + CW_BAR, MISC + 8);
#define GRID_BAR() xcd_barrier(bar)
#else
#define GRID_BAR() do { } while (0)
#endif
#if MK_PER_PHASE
    const int lo = args.ph_lo, hi = args.ph_hi;
#else
    constexpr int lo = 0, hi = NPH;
#endif
#define IN(k) (lo <= (k) && (k) < hi)
#define BOTH(k) (IN(k) && IN((k) + 1))
#if MK_STAMP
    unsigned long long* STP = (unsigned long long*)(ws + WS.end);
#define STAMP(k) do { if (bid == 0 && tid == 0) STP[k] = __builtin_amdgcn_s_memrealtime(); } while (0)
    STAMP(0);
#else
#define STAMP(k) do { } while (0)
#endif
#define x_in ((const float*)argp(0))
#define mem_in ((const float*)argp(1))
#define pos ((const int*)argp(2))
#define norm_mix ((const float*)argp(3))
#define w_in_f32 ((const float*)argp(4))
#define s5_a_re ((const float*)argp(5))
#define s5_a_im ((const float*)argp(6))
#define s5_log_dt ((const float*)argp(7))
#define s5_b_re ((const float*)argp(8))
#define s5_b_im ((const float*)argp(9))
#define s5_c_re ((const float*)argp(10))
#define s5_c_im ((const float*)argp(11))
#define s5_d ((const float*)argp(12))
#define s5_w_glu ((const float*)argp(13))
#define q_a_norm ((const float*)argp(14))
#define w_q_b ((const float*)argp(15))
#define kv_norm ((const float*)argp(16))
#define w_kv_b ((const float*)argp(17))
#define q_norm ((const float*)argp(18))
#define k_norm ((const float*)argp(19))
#define mla_w_o ((const float*)argp(20))
#define mem_norm ((const float*)argp(21))
#define mem_w_kv ((const float*)argp(22))
#define mem_q_norm ((const float*)argp(23))
#define mem_k_norm ((const float*)argp(24))
#define mem_w_o ((const float*)argp(25))
#define w_out_f32 ((const float*)argp(26))
#define norm_ffn ((const float*)argp(27))
#define ffn_gu ((const float*)argp(28))
#define ffn_dn ((const float*)argp(29))
#define moe_router ((const float*)argp(30))
#define moe_rb ((const float*)argp(31))
#define moe_gu ((const float*)argp(32))
#define moe_dn ((const float*)argp(33))
    float* OUT = args.out;
#define WSP ((unsigned char*)argp(35))
#define XB ((bf16*)(WSP + WS.xb))
#define Ub ((bf16*)(WSP + WS.u))
#define CQ ((bf16*)(WSP + WS.cq))
#define CKV ((bf16*)(WSP + WS.ckv))
#define KR ((float*)(WSP + WS.kr))
#define QM ((bf16*)(WSP + WS.qm))
#define GT ((unsigned char*)(WSP + WS.gt))
#define Qh ((bf16*)(WSP + WS.q))
#define Kh ((bf16*)(WSP + WS.kk))
#define Vh ((bf16*)(WSP + WS.vv))
#define OA ((bf16*)(WSP + WS.oa))
#define OM ((bf16*)(WSP + WS.om))
#define YS ((bf16*)(WSP + WS.ys))
#define ES ((float*)(WSP + WS.es))
#define MF ((bf16*)(WSP + WS.mf))
#define MB ((bf16*)(WSP + WS.mb))
#define ACT ((bf16*)(WSP + WS.act))
#define YM ((bf16*)(WSP + WS.ym))
#define KMEM ((bf16*)(WSP + WS.kmem))
#define VMEM ((bf16*)(WSP + WS.vmem))
#define MEMB ((bf16*)(WSP + WS.memb))
#define ROPEC ((float*)(WSP + WS.ropec))
#define ROPES ((float*)(WSP + WS.ropes))
#define LIST ((int*)(WSP + WS.list))
#define TOKE ((int*)(WSP + WS.toke))
#define TOKS ((int*)(WSP + WS.toks))
#define TOKW ((float*)(WSP + WS.tokw))
#define TMIN ((int*)(WSP + WS.tmm))
#define XQ ((signed char*)(WSP + WS.xq))
#define RSC ((float*)(WSP + WS.rsc))
#define WSC ((float*)(WSP + WS.wsc))
#define ACT8 ((signed char*)(WSP + WS.act8))
#define RSC2 ((float*)(WSP + WS.rsc2))
#define TMAX (TMIN + 128)
#define CNT ((unsigned*)WSP + CW_CNT)
#define SS ((float*)(WSP + WS.ssp))
    for (int rep_ = 0; rep_ < ((PH_ON(0) && IN(0)) ? NREP(0) : 0); ++rep_) {
        const int lane = fresh_tid() & 63;
        LAS float* scr = (LAS float*)(lds + wave * 16640);
        transpose_job(w_in_f32, (size_t)DM * IN_COLS, IN_COLS, DM, (bf16*)(ws + WS.w_in[0]), (WS.w_in[1] - WS.w_in[0]) / 2, DM, 2304, norm_mix, DM, 2, MapInProj{}, scr, gw, NGW, lane);
        {
            LAS float* stp = (LAS float*)(lds + XT_OFF) + 32;
            if (wave < 2) { const float st = sample_step(w_in_f32 + (size_t)wave * DM * IN_COLS + 3072, IN_COLS, DM, norm_mix + wave * DM, lane, 3 * DM); if (lane == 0) { stp[wave] = st; if (bid == 0) WSC[16 + wave] = st; } }
            else if (wave < 4) { const int w2 = wave - 2; const float st = sample_step(w_in_f32 + (size_t)w2 * DM * IN_COLS + 2048, IN_COLS, DM, norm_mix + w2 * DM, lane, MEMW); if (lane == 0) { stp[wave] = st; if (bid == 0) WSC[18 + w2] = st; } }
            __syncthreads();
            const int nkb = DM / 64, nnb = 7168 / 64, per = nkb * nnb; const MapId mp{};
            for (int it = gw; it < per * 2; it += NGW) { const int inst = it / per, r = it - inst * per, nb = r / nkb, kb = r - nb * nkb;
                transpose_item_i8(w_in_f32 + (size_t)inst * DM * IN_COLS + 2048, IN_COLS, (signed char*)(WSP + WS.w_inq[inst]), DM, norm_mix + inst * DM, 1.0f / stp[nb < 16 ? 2 + inst : inst], mp, kb, nb, lane); }
        }
        transpose_job(s5_w_glu, (size_t)S5W * 4096, 4096, S5W, (bf16*)(ws + WS.w_glu[0]), (WS.w_glu[1] - WS.w_glu[0]) / 2, S5W, 4096, nullptr, 0, 2, MapGlu{2048}, scr, gw, NGW, lane);
        transpose_job(w_q_b, (size_t)QRANK * 3072, 3072, QRANK, (bf16*)(ws + WS.w_qb[0]), (WS.w_qb[1] - WS.w_qb[0]) / 2, 512, 4096, q_a_norm, QRANK, 2, MapQB{}, scr, gw, NGW, lane);
        transpose_job(w_kv_b, (size_t)KVRANK * 4096, 4096, KVRANK, (bf16*)(ws + WS.w_kvb[0]), (WS.w_kvb[1] - WS.w_kvb[0]) / 2, 512, 4096, kv_norm, KVRANK, 2, MapId{}, scr, gw, NGW, lane);
        transpose_job(mla_w_o, (size_t)DM * DM, DM, DM, (bf16*)(ws + WS.w_mo[0]), (WS.w_mo[1] - WS.w_mo[0]) / 2, DM, DM, nullptr, 0, 2, MapId{}, scr, gw, NGW, lane);
        transpose_job(mem_w_kv, (size_t)DM * DM, DM, DM, (bf16*)(ws + WS.w_mkv[0]), (WS.w_mkv[1] - WS.w_mkv[0]) / 2, DM, DM, mem_norm, DM, 2, MapId{}, scr, gw, NGW, lane);
        transpose_job(mem_w_o, (size_t)MEMW * DM, DM, MEMW, (bf16*)(ws + WS.w_mwo[0]), (WS.w_mwo[1] - WS.w_mwo[0]) / 2, MEMW, DM, nullptr, 0, 2, MapId{}, scr, gw, NGW, lane);
        transpose_job(w_out_f32, (size_t)DM * DM, DM, DM, (bf16*)(ws + WS.w_out[0]), (WS.w_out[1] - WS.w_out[0]) / 2, DM, DM, nullptr, 0, 2, MapId{}, scr, gw, NGW, lane);
        transpose_job(ffn_gu, 0, 2 * DFF, DM, (bf16*)(ws + WS.w_gu), 0, DM, 2 * DFF, norm_ffn, 0, 1, MapGlu{DFF}, scr, gw, NGW, lane);
        transpose_job(ffn_dn, 0, DM, DFF, (bf16*)(ws + WS.w_dn), 0, DFF, DM, nullptr, 0, 1, MapId{}, scr, gw, NGW, lane);
        {
            LAS float* stp = (LAS float*)(lds + XT_OFF);
            { const float st = sample_step(moe_gu + (size_t)wave * DM * 2 * DFF, 2 * DFF, DM, nullptr, lane); if (lane == 0) { stp[wave] = st; if (bid == 0) { WSC[wave] = st; WSC[32 + wave] = 1.0f / st; } } }
            __syncthreads();
        }
        {
            LAS float* stp = (LAS float*)(lds + XT_OFF) + 16;
            { const float st = sample_step(moe_dn + (size_t)wave * DFF * DM, DM, DFF, nullptr, lane); if (lane == 0) { stp[wave] = st; if (bid == 0) { WSC[8 + wave] = st; WSC[24 + wave] = 1.0f / st; } } }
            __syncthreads();
        }
        for (int i = gw * 64 + lane; i < SEQ * 32; i += NGW * 64) { const int t = i >> 5, j = i & 31; const float inv = powf(10000.0f, -(float)(2 * j) / 64.0f); const float ang = (float)pos[t] * inv;
            ROPEC[i] = cosf(ang); ROPES[i] = sinf(ang); }
        for (int t = gw; t < 128; t += NGW) { int v = pos[64 * t + lane], mn = v, mx = v;
#pragma unroll
            for (int o_ = 1; o_ < 64; o_ <<= 1) { mn = min(mn, __shfl_xor(mn, o_)); mx = max(mx, __shfl_xor(mx, o_)); }
            if (lane == 0) { TMIN[t] = mn; TMAX[t] = mx; } }
        for (int i = gw * 64 + lane; i < 2 * S5G * S5P; i += NGW * 64) { const int l = i / (S5G * S5P), gp = i % (S5G * S5P), g = gp / S5P, p = gp % S5P;
            const float are = s5_a_re[i], aim = s5_a_im[i], dt = expf(s5_log_dt[l * S5G + g]);
            const float mag = expf(dt * are), lr = mag * cosf(dt * aim), li = mag * sinf(dt * aim);
            ((f32x2*)(ws + WS.lam[l]))[gp] = (f32x2){lr, li};
            const float den = are * are + aim * aim, nr = lr - 1.0f, ni = li, fr = (nr * are + ni * aim) / den, fi = (ni * are - nr * aim) / den;
            bf16* bbr = (bf16*)(ws + WS.bb[l]) + ((size_t)(g * 128 + p)) * 16; bf16* bbi = bbr + 64 * 16;
            const float* bre = s5_b_re + (size_t)i * S5H; const float* bim = s5_b_im + (size_t)i * S5H;
#pragma unroll
            for (int h = 0; h < S5H; ++h) { bbr[h] = (bf16)f2bf(fr * bre[h] - fi * bim[h]); bbi[h] = (bf16)f2bf(fr * bim[h] + fi * bre[h]); }
            bf16* cp = (bf16*)(ws + WS.cp[l]) + (size_t)g * 16 * 128;
#pragma unroll
            for (int h = 0; h < S5H; ++h) { const size_t ci = ((size_t)(l * S5G + g) * S5H + h) * S5P + p; cp[h * 128 + p] = (bf16)f2bf(s5_c_re[ci]); cp[h * 128 + 64 + p] = (bf16)f2bf(-s5_c_im[ci]); } }
        for (int m = gw; m < SEQ; m += NGW) { const float s = row_to_bf16(x_in + (size_t)m * DM, XB + (size_t)m * DM, false, lane); if (lane < 32) SS[SS_X + (size_t)m * 32 + lane] = lane == 0 ? s : 0.f;
            quant_xrow_i8(x_in + (size_t)m * DM, XQ + (size_t)m * DM, RSC + m, lane); }
        for (int m = gw; m < NMEM; m += NGW) (void)row_to_bf16(mem_in + (size_t)m * DM, MEMB + (size_t)m * DM, true, lane);
        if (BOTH(0)) GRID_BAR();
        STAMP(1);
    }

    for (int l = 0; l < DEPTH; ++l) {
        const int pb = 1 + 8 * l;
        const float* ssx_mix = SS + SS_X + (size_t)(2 * l) * SEQ * 32; float* ssx_ffn = SS + SS_X + (size_t)(2 * l + 1) * SEQ * 32;
        for (int rep_ = 0; rep_ < (IN(pb + 0) ? NREP(pb + 0) : 0); ++rep_) {
            if constexpr (PH_ON(1)) { pg8::Gemm g{XB, (const bf16*)(ws + WS.w_in[l]), DM, DM, DM, 2}; pg8::StaticOrder S; S.init(SEQ / 256, 9, G, bid);
              pg8::EpiInProj E{ssx_mix, Ub, CQ, CKV, QM, GT, KR, SS + SS_CQ + (size_t)l * SEQ * 8, SS + SS_CKV + (size_t)l * SEQ * 8, SS + SS_KR + (size_t)l * SEQ * 4, mem_q_norm + l * MEMD};
              pg8::gemm_phase(lds, g, S, E); }
            if constexpr (PH_ON(1)) { pg8::Gemm g{XQ, (const void*)(WSP + WS.w_inq[l]), DM, DM, DM, 1}; pg8::BalOrder S{SEQ / 256, 28, bid};
              pg8::EpiGates E{RSC, WSC[16 + l], GT, WSC[18 + l], QM, mem_q_norm + l * MEMD};
              pg8::gemm_phase<pg8::EpiGates, pg8::BalOrder, 1>(lds, g, S, E); }
            if constexpr (PH_ON(18)) if (l == 0) { pg8::Gemm g{MEMB, (const bf16*)(ws + WS.w_mkv[0]), DM, DM, DM, 2}; pg8::MemKvOrder S{G, G - 1 - bid};
              pg8::EpiMemKV E{{mem_k_norm, mem_k_norm + MEMD}, KMEM, VMEM};
              pg8::gemm_phase(lds, g, S, E); }
            if (BOTH(pb + 0)) GRID_BAR();
            STAMP(pb + 0 + 1);
        }
        for (int rep_ = 0; rep_ < (IN(pb + 1) ? NREP(pb + 1) : 0); ++rep_) {
            if constexpr (PH_ON(12)) { pg8::Gemm g{CQ, (const bf16*)(ws + WS.w_qb[l]), 512, 512, 512, 2}; pg8::StaticOrder S; S.init(SEQ / 256, NH, G, bid);
              pg8::EpiQ E{SS + SS_CQ + (size_t)l * SEQ * 8, q_norm + l * DQK, ROPEC, ROPES, Qh};
              pg8::gemm_phase(lds, g, S, E); }
            if constexpr (PH_ON(13)) { pg8::Gemm g{CKV, (const bf16*)(ws + WS.w_kvb[l]), 512, 512, 512, 2}; pg8::StaticOrder S; S.init(SEQ / 256, NH, G, bid);
              pg8::EpiKV E{SS + SS_CKV + (size_t)l * SEQ * 8, SS + SS_KR + (size_t)l * SEQ * 4, k_norm + l * DQK, KR, ROPEC, ROPES, Kh, Vh};
              pg8::gemm_phase(lds, g, S, E); }
            if constexpr (PH_ON(14)) for (int it = gw; it < S5G * 32; it += NGW)
                s5::s5_wave<1>((char*)lds_raw + wave * s5::WAVE_LDS, it >> 5, (it & 31) * 4, Ub, (const f32x2*)(ws + WS.lam[l]), (const bf16*)(ws + WS.bb[l]), (const bf16*)(ws + WS.cp[l]), s5_d + l * S5W, ES, YS, fresh_tid() & 63);
            __syncthreads();
            NoConv nocv;
            if constexpr (PH_ON(15)) for (int it = vcu; it < MEMH * 32 * 2; it += G) { const int h = it >> 6, qb = (it & 63) >> 1, dvh = it & 1;
                attn::attn_item<MEMD, false, MEMW, MEMD, MEMW, false>(nocv, (char*)lds_raw, lds, QM + (size_t)qb * 256 * MEMW + h * MEMD, KMEM + ((size_t)l * MEMH + h) * NMEM * MEMD, VMEM + ((size_t)l * MEMH + h) * NMEM * MEMD + dvh * 128,
                                             OM + (size_t)qb * 256 * MEMW + h * MEMD + dvh * 128, nullptr, qb * 256, NMEM / 64, nullptr, nullptr); }
            if (BOTH(pb + 1)) GRID_BAR();
            STAMP(pb + 1 + 1);
        }
        for (int rep_ = 0; rep_ < (IN(pb + 2) ? NREP(pb + 2) : 0); ++rep_) {
            constexpr int CV_J0 = 132;
            MoeConv mcv{moe_gu, moe_dn, (const float*)(WSP + WS.gsc), (signed char*)(WSP + WS.w_egu), (signed char*)(WSP + WS.w_edn), WSC, gw, NGW, fresh_tid() & 63, l == 0 ? 0 : CV_J0, l == 0 ? CV_J0 : (1 << 30), false, {}, nullptr, 0, 0.f, 0,
                        (unsigned)__builtin_amdgcn_readfirstlane((int)((unsigned)(size_t)lds + (wave < 3 ? 49152u + wave * 4224u : (wave < 6 ? 118400u + (wave - 3) * 4224u : (unsigned)GOFF_OFF + (wave - 6) * 4224u))))};
            if constexpr (PH_ON(16)) for (int it = vcu; it < NH * 16; it += G) { const int h = it >> 4, pr = it & 15;
#pragma unroll 1
                for (int pass = 0; pass < 2; ++pass) { const int qb = pass ? pr : 31 - pr;
                    attn::attn_item<DQK, true, DQK, DV, DM, true>(mcv, (char*)lds_raw, lds, Qh + ((size_t)h * SEQ + qb * 256) * DQK, Kh + (size_t)h * SEQ * DQK, Vh + (size_t)h * SEQ * DV,
                                               OA + (size_t)qb * 256 * DM + h * DV, pos, qb * 256, SEQ / 64, TMIN, TMAX); } }
            if constexpr (PH_ON(16)) { mcv.finish(); while (mcv.j < mcv.jend) { mcv.issue(); mcv.finish(); } }
            if constexpr (PH_ON(17)) for (int it = gw; it < S5G * 32; it += NGW)
                s5::s5_wave<2>((char*)lds_raw + wave * s5::WAVE_LDS, it >> 5, (it & 31) * 4, Ub, (const f32x2*)(ws + WS.lam[l]), (const bf16*)(ws + WS.bb[l]), (const bf16*)(ws + WS.cp[l]), s5_d + l * S5W, ES, YS, fresh_tid() & 63);
            __syncthreads();
            if (BOTH(pb + 2)) GRID_BAR();
            STAMP(pb + 2 + 1);
        }
        for (int rep_ = 0; rep_ < (IN(pb + 3) ? NREP(pb + 3) : 0); ++rep_) {
            if constexpr (PH_ON(4)) { pg8::Gemm g{OA, (const bf16*)(ws + WS.w_mo[l]), DM, DM, DM, 2}; pg8::StaticOrder S; S.init(SEQ / 256, DM / 256, G, bid); pg8::EpiMerge<1> E{GT, MF}; pg8::gemm_phase(lds, g, S, E); }
            if constexpr (PH_ON(19)) { pg8::Gemm g{OM, (const bf16*)(ws + WS.w_mwo[l]), MEMW, MEMW, MEMW, 2}; pg8::StaticOrder S; S.init(SEQ / 256, DM / 256, G, bid); pg8::EpiMerge<2> E{GT, MF}; pg8::gemm_phase(lds, g, S, E); }
            if constexpr (PH_ON(20)) { pg8::Gemm g{YS, (const bf16*)(ws + WS.w_glu[l]), S5W, S5W, S5W, 2}; pg8::GluOrder S; S.init(SEQ / 256, DM / 256, G, bid); pg8::EpiGlu E{GT, MF, MB}; pg8::gemm_phase(lds, g, S, E); }
            if (BOTH(pb + 3)) GRID_BAR();
            STAMP(pb + 3 + 1);
        }
        if (PH_ON(5) && IN(pb + 4)) {
            pg8::Gemm g{MB, (const bf16*)(ws + WS.w_out[l]), DM, DM, DM, 2}; pg8::StaticOrder S; S.init(SEQ / 256, DM / 256, G, bid);
            if (l == 0) { pg8::EpiResid<false, false> E{x_in, nullptr, XB, ssx_ffn}; pg8::gemm_phase(lds, g, S, E); }
            else { pg8::EpiResid<true, true> E{XB, OUT, nullptr, ssx_ffn}; pg8::gemm_phase(lds, g, S, E); }
            if (BOTH(pb + 4)) GRID_BAR();
            STAMP(pb + 4 + 1);
        }
        if (l == 0) {
            for (int rep_ = 0; rep_ < ((PH_ON(6) && IN(pb + 5)) ? NREP(pb + 5) : 0); ++rep_) {
                pg8::Gemm g{XB, (const bf16*)(ws + WS.w_gu), DM, DM, DM, 2}; pg8::StaticOrder S; S.init(SEQ / 256, 2 * DFF / 256, G, bid);
                pg8::EpiSwiGLU<pg8::StaticOrder> E{ssx_ffn, ACT, &S, false, nullptr, nullptr, nullptr}; pg8::gemm_phase(lds, g, S, E);
                if (BOTH(pb + 5)) GRID_BAR();
                STAMP(pb + 5 + 1);
            }
            if (PH_ON(7) && IN(pb + 6)) {
                pg8::Gemm g{ACT, (const bf16*)(ws + WS.w_dn), DFF, DFF, DFF, 2}; pg8::StaticOrder S; S.init(SEQ / 256, DM / 256, G, bid);
                pg8::EpiResid<true, false> E{XB, nullptr, XB, SS + SS_X + (size_t)2 * SEQ * 32}; pg8::gemm_phase(lds, g, S, E);
                if (BOTH(pb + 6)) GRID_BAR();
                STAMP(pb + 6 + 1);
            }
            if (PH_ON(22) && IN(pb + 7)) {
                const int lane = fresh_tid() & 63;
                for (int t = gw; t < SEQ; t += NGW) quant_xrow_i8(XB + (size_t)t * DM, XQ + (size_t)t * DM, RSC + t, lane);
                if (BOTH(pb + 7)) GRID_BAR();
                STAMP(pb + 7 + 1);
            }
        } else {
            LAS int* MT = (LAS int*)(lds + MISC_OFF + 64);
#define MOE_TABLE() do { if (tid == 0) { int p = 0; for (int e = 0; e < NE; ++e) { const int c_ = (int)__hip_atomic_load(CNT + 64 * e, RLX_AGENT); MT[e] = p; MT[16 + e] = c_; p += (c_ + 255) >> 8; } MT[8] = p; } __syncthreads(); } while (0)
            if (PH_ON(8) && IN(pb + 5)) {
                const int lane = fresh_tid() & 63;
                for (int t = gw; t < SEQ; t += NGW) router_token(OUT + (size_t)t * DM, norm_ffn + DM, moe_router, moe_rb, t, CNT, LIST, TOKE, TOKS, TOKW, XQ, RSC, (float*)(WSP + WS.rss), lane);
                if (BOTH(pb + 5)) GRID_BAR();
                STAMP(pb + 5 + 1);
            }
            for (int rep_ = 0; rep_ < ((PH_ON(9) && IN(pb + 6)) ? NREP(pb + 6) : 0); ++rep_) {
                MOE_TABLE();
                typedef pg8::MoeOrder<true, 1> Ord;
                pg8::Gemm g{XQ, (const void*)(ws + WS.w_egu), DM, DM, DM, 1}; Ord S{MT, LIST, 2 * DFF / 256, G, bid, (size_t)2 * DFF * DM, 0, MT[8]};
                pg8::EpiSwiGLU<Ord> E{ssx_ffn, ACT, &S, true, (const float*)(WSP + WS.rss), WSC, nullptr}; pg8::gemm_phase<pg8::EpiSwiGLU<Ord>, Ord, 1>(lds, g, S, E);
                if (BOTH(pb + 6)) GRID_BAR();
                STAMP(pb + 6 + 1);
            }
            for (int rep_ = 0; rep_ < ((PH_ON(21) && IN(pb + 7)) ? NREP(pb + 7) : 0); ++rep_) {
                MOE_TABLE();
                const int lane = fresh_tid() & 63; const int nrows = MT[8] * 256;
                for (int r = gw; r < nrows; r += 2 * NGW) { const int r2 = r + NGW < nrows ? r + NGW : r;
                    quant_row2_i8(ACT + (size_t)r * DFF, ACT + (size_t)r2 * DFF, ACT8 + (size_t)r * DFF, ACT8 + (size_t)r2 * DFF, RSC2 + r, RSC2 + r2, lane); }
                if (BOTH(pb + 7)) GRID_BAR();
                STAMP(pb + 7 + 1);
            }
            for (int rep_ = 0; rep_ < ((PH_ON(10) && IN(pb + 8)) ? NREP(pb + 8) : 0); ++rep_) {
                MOE_TABLE();
                const int P_ = MT[8], Pf = ((P_ * (DM / 256)) / G) * G / (DM / 256);
                { typedef pg8::MoeOrder<false, 1> Ord; pg8::Gemm g{ACT8, (const void*)(WSP + WS.w_edn), DFF, DFF, DFF, 1}; Ord S{MT, LIST, DM / 256, G, bid, (size_t)DM * DFF, 0, Pf};
                  pg8::EpiMoeDown E{YM, WSC + 8, RSC2}; pg8::gemm_phase<pg8::EpiMoeDown, Ord, 1>(lds, g, S, E); }
                { typedef pg8::MoeOrder<false, KSPLIT> Ord; pg8::Gemm g{ACT8, (const void*)(WSP + WS.w_edn), DFF, DFF, DFF / KSPLIT, 1}; Ord S{MT, LIST, DM / 256, G, bid, (size_t)DM * DFF, Pf, P_ - Pf};
                  pg8::EpiMoeDown E{YM, WSC + 8, RSC2}; pg8::gemm_phase<pg8::EpiMoeDown, Ord, 1>(lds, g, S, E); }
                if (BOTH(pb + 8)) GRID_BAR();
                STAMP(pb + 8 + 1);
            }
            if (PH_ON(11) && IN(pb + 9)) {
                MOE_TABLE();
                const int lane = fresh_tid() & 63;
                for (int t = gw; t < SEQ; t += NGW) {
                    const int e1 = TOKE[2 * t], e2 = TOKE[2 * t + 1]; const size_t r1 = (size_t)MT[e1] * 256 + TOKS[2 * t], r2 = (size_t)MT[e2] * 256 + TOKS[2 * t + 1];
                    const float w1 = TOKW[2 * t], w2 = TOKW[2 * t + 1];
                    const int P_ = MT[8], Pf = ((P_ * (DM / 256)) / G) * G / (DM / 256); const int n1 = (int)(r1 >> 8) >= Pf ? KSPLIT : 1, n2 = (int)(r2 >> 8) >= Pf ? KSPLIT : 1;
                    f32x4 av[4], bv[4]; u32x4 y1v[4], y2v[4];
#pragma unroll
                    for (int j = 0; j < 4; ++j) { const int c = 512 * j + 8 * lane; const float* op = OUT + (size_t)t * DM + c; av[j] = *(const f32x4*)op; bv[j] = *(const f32x4*)(op + 4);
                        y1v[j] = *(const u32x4*)(YM + r1 * DM + c); y2v[j] = *(const u32x4*)(YM + r2 * DM + c); }
#define CMB_ADD(a_, b_, w_, y_) do { a_[0] += w_ * bflo(y_.x); a_[1] += w_ * bfhi(y_.x); a_[2] += w_ * bflo(y_.y); a_[3] += w_ * bfhi(y_.y); b_[0] += w_ * bflo(y_.z); b_[1] += w_ * bfhi(y_.z); b_[2] += w_ * bflo(y_.w); b_[3] += w_ * bfhi(y_.w); } while (0)
#pragma unroll
                    for (int j = 0; j < 4; ++j) { CMB_ADD(av[j], bv[j], w1, y1v[j]); CMB_ADD(av[j], bv[j], w2, y2v[j]); }
                    for (int ks = 1; ks < n1; ++ks) {
#pragma unroll
                        for (int j = 0; j < 4; ++j) { const u32x4 y = *(const u32x4*)(YM + ((size_t)ks * ACT_ROWS + r1) * DM + 512 * j + 8 * lane); CMB_ADD(av[j], bv[j], w1, y); } }
                    for (int ks = 1; ks < n2; ++ks) {
#pragma unroll
                        for (int j = 0; j < 4; ++j) { const u32x4 y = *(const u32x4*)(YM + ((size_t)ks * ACT_ROWS + r2) * DM + 512 * j + 8 * lane); CMB_ADD(av[j], bv[j], w2, y); } }
#undef CMB_ADD
#pragma unroll
                    for (int j = 0; j < 4; ++j) { float* op = OUT + (size_t)t * DM + 512 * j + 8 * lane; *(f32x4*)op = av[j]; *(f32x4*)(op + 4) = bv[j]; } }
            }
        }
    }
#if MK_STAMP
    STAMP(19);
    GRID_BAR();
    {   float ta = 0.f, tb = 0.f;
        for (int k = 0; k < 19; ++k) { const float dt = (float)(STP[k + 1] - STP[k]) * 0.01f; if ((MK_STAMP_A >> k) & 1u) ta += dt; if ((MK_STAMP_B >> k) & 1u) tb += dt; }
        for (size_t i = (size_t)bid * 512 + tid; i < (size_t)SEQ * DM; i += (size_t)G * 512) OUT[i] = (i & 1) ? ta : tb; }
#endif
#undef x_in
#undef mem_in
#undef pos
#undef norm_mix
#undef w_in_f32
#undef s5_a_re
#undef s5_a_im
#undef s5_log_dt
#undef s5_b_re
#undef s5_b_im
#undef s5_c_re
#undef s5_c_im
#undef s5_d
#undef s5_w_glu
#undef q_a_norm
#undef w_q_b
#undef kv_norm
#undef w_kv_b
#undef q_norm
#undef k_norm
#undef mla_w_o
#undef mem_norm
#undef mem_w_kv
#undef mem_q_norm
#undef mem_k_norm
#undef mem_w_o
#undef w_out_f32
#undef norm_ffn
#undef ffn_gu
#undef ffn_dn
#undef moe_router
#undef moe_rb
#undef moe_gu
#undef moe_dn
#undef XB
#undef Ub
#undef CQ
#undef CKV
#undef KR
#undef QM
#undef GT
#undef Qh
#undef Kh
#undef Vh
#undef OA
#undef OM
#undef YS
#undef ES
#undef MF
#undef MB
#undef ACT
#undef YM
#undef KMEM
#undef VMEM
#undef MEMB
#undef ROPEC
#undef ROPES
#undef LIST
#undef TOKE
#undef TOKS
#undef TOKW
#undef TMIN
#undef XQ
#undef RSC
#undef WSC
#undef ACT8
#undef RSC2
#undef TMAX
#undef CNT
#undef SS
#undef WSP
#undef IN
#undef BOTH
}

extern "C" void kernel_launch(void* const* d_in, const int* in_sizes, int n_in, void* d_out, int out_size, void* d_ws, size_t ws_size, hipStream_t stream) {
    static int grid = 0;
    if (grid == 0) {
        if (n_in != 34 || in_sizes[0] != SEQ * DM || out_size != SEQ * DM || ws_size < WS.end) {
            fprintf(stderr, "kernel_launch: shape mismatch: n_in %d in0 %d out %d ws %zu (need %zu)\n", n_in, n_in > 0 ? in_sizes[0] : -1, out_size, ws_size, (size_t)WS.end); grid = -1; return; }
        int dev = 0, cus = 0;
        if (hipGetDevice(&dev) != hipSuccess || hipDeviceGetAttribute(&cus, hipDeviceAttributeMultiprocessorCount, dev) != hipSuccess) { grid = -1; return; }
        if (hipFuncSetAttribute((const void*)fwd, hipFuncAttributeMaxDynamicSharedMemorySize, LDS_BYTES) != hipSuccess) { fprintf(stderr, "kernel_launch: hipFuncSetAttribute failed\n"); grid = -1; return; }
        int per_cu = 0;
        if (hipOccupancyMaxActiveBlocksPerMultiprocessor(&per_cu, (const void*)fwd, NWAVES * 64, LDS_BYTES) != hipSuccess || per_cu < 1) fprintf(stderr, "kernel_launch: occupancy query says %d\n", per_cu);
        (void)hipGetLastError();
        grid = cus;
    }
    if (grid < 0) return;
    (void)hipMemsetAsync(d_ws, 0, CTL_BYTES, stream);
    Args a{};
    for (int i = 0; i < 34; ++i) a.in[i] = d_in[i];
    a.out = (float*)d_out; a.ws = (unsigned char*)d_ws;
#if MK_PER_PHASE
#if MK_CHECK == 2
    (void)hipMemsetAsync((unsigned char*)d_ws + WS.end, 0, 4096, stream);
    for (int pass = 0; pass < 2; ++pass) {
        if (pass) (void)hipMemsetAsync(d_ws, 0, CTL_BYTES, stream);
        for (int p = 0; p < NPH; ++p) { a.ph_lo = p; a.ph_hi = p + 1; hipLaunchKernelGGL(fwd, dim3(grid), dim3(NWAVES * 64), LDS_BYTES, stream, a); diff_after_phase(pass, p, a, ws_size, stream); }
    }
    hipLaunchKernelGGL(diff_final, dim3(1024), dim3(256), 0, stream, (const float*)((unsigned char*)d_ws + WS.end), (float*)d_out);
#else
    for (int p = 0; p < NPH; ++p) { a.ph_lo = p; a.ph_hi = p + 1;
#if MK_CHECK == 1
        launch_checks_pre(p, a, stream);
#endif
        hipLaunchKernelGGL(fwd, dim3(grid), dim3(NWAVES * 64), LDS_BYTES, stream, a);
#if MK_CHECK == 1
        launch_checks(p, a, stream);
#endif
    }
#if MK_CHECK == 1
    launch_check_final(a, stream);
#endif
#endif
#else
    a.ph_lo = 0; a.ph_hi = NPH; hipLaunchKernelGGL(fwd, dim3(grid), dim3(NWAVES * 64), LDS_BYTES, stream, a);
#endif
    const hipError_t le = hipPeekAtLastError();
    if (le != hipSuccess) fprintf(stderr, "kernel_launch: launch failed: %s\n", hipGetErrorName(le));
}
```

```cpp
#include <hip/hip_runtime.h>
#include <cstdio>
#include <cstdint>

#ifndef MK_PER_PHASE
#define MK_PER_PHASE 0
#endif
#ifndef MK_CHECK
#define MK_CHECK 0
#endif

constexpr int SEQ = 8192, DM = 2048, DEPTH = 2, NMEM = 256;
constexpr int S5W = 1024, S5G = 64, S5H = 16, S5P = 64;
constexpr int NH = 16, QRANK = 448, KVRANK = 512, DNOPE = 128, DROPE = 64, DQK = 192, DV = 128;
constexpr int MEMH = 4, MEMD = 256, MEMW = 1024;
constexpr int DFF = 7168, NE = 8;
constexpr int INP = 9472;
constexpr int IN_COLS = 9216;
constexpr float EPS = 1e-6f;
constexpr float LOG2E = 1.4426950408889634f;
constexpr int ACT_ROWS = 2 * SEQ + NE * 256;
constexpr int KSPLIT = 4;

typedef unsigned short bf16;
typedef short bf16x8 __attribute__((ext_vector_type(8)));
typedef short s16x4 __attribute__((ext_vector_type(4)));
typedef float f32x4 __attribute__((ext_vector_type(4)));
typedef float f32x2 __attribute__((ext_vector_type(2)));
typedef float f32x16 __attribute__((ext_vector_type(16)));
typedef unsigned u32x4 __attribute__((ext_vector_type(4)));
typedef unsigned u32x2 __attribute__((ext_vector_type(2)));
#define GAS __attribute__((address_space(1)))
#define LAS __attribute__((address_space(3)))
typedef GAS unsigned gu32;
#define RLX_AGENT __ATOMIC_RELAXED, __HIP_MEMORY_SCOPE_AGENT
#define LDS_WAIT() asm volatile("s_waitcnt lgkmcnt(0)" ::: "memory")
#define VM_WAIT() asm volatile("s_waitcnt vmcnt(0)" ::: "memory")
#define SBAR() __builtin_amdgcn_sched_barrier(0)

typedef __bf16 bf16x2_t __attribute__((ext_vector_type(2)));
__device__ __forceinline__ unsigned cvt_pk_bf16(float lo, float hi) { f32x2 v = {lo, hi}; bf16x2_t b = __builtin_convertvector(v, bf16x2_t); return __builtin_bit_cast(unsigned, b); }
__device__ __forceinline__ unsigned f2bf(float f) { unsigned u = __builtin_bit_cast(unsigned, f); return (u + 0x7fffu + ((u >> 16) & 1u)) >> 16; }
__device__ __forceinline__ unsigned pk2(float lo, float hi) { return f2bf(lo) | (f2bf(hi) << 16); }
__device__ __forceinline__ float bf2f(unsigned short b) { return __builtin_bit_cast(float, ((unsigned)b) << 16); }
__device__ __forceinline__ float bflo(unsigned w) { return __builtin_bit_cast(float, w << 16); }
__device__ __forceinline__ float bfhi(unsigned w) { return __builtin_bit_cast(float, w & 0xffff0000u); }
__device__ __forceinline__ float sigmoidf_(float x) { return __builtin_amdgcn_rcpf(1.f + __builtin_amdgcn_exp2f(-x * LOG2E)); }
__device__ __forceinline__ int fresh_tid() { int t = threadIdx.x; asm volatile("" : "+v"(t)); return t; }
template <int N> __device__ __forceinline__ float sum_slots(const float* p) { f32x4 a = *(const f32x4*)p;
#pragma unroll
    for (int i = 1; i < N / 4; ++i) a = a + *(const f32x4*)(p + 4 * i);
    return (a[0] + a[1]) + (a[2] + a[3]); }
__device__ __forceinline__ float wave_sum(float v) {
#pragma unroll
    for (int o = 1; o < 64; o <<= 1) v += __shfl_xor(v, o);
    return v;
}

constexpr size_t al256(size_t x) { return (x + 255) & ~(size_t)255; }
constexpr size_t CTL_BYTES = 2u << 20;
constexpr int CW_TMO = 0, CW_CODE = 1;
constexpr int CW_BAR = 4096;
constexpr int CW_CNT = 8192;
constexpr int CW_CHK = 12288;
constexpr int SS_X = 0;
constexpr int SS_CQ = 4 * SEQ * 32;
constexpr int SS_CKV = SS_CQ + 2 * SEQ * 8;
constexpr int SS_KR = SS_CKV + 2 * SEQ * 8;
constexpr int SS_FLOATS = SS_KR + 2 * SEQ * 4;

struct WsMap {
    size_t w_in[2], w_glu[2], w_qb[2], w_kvb[2], w_mo[2], w_mkv[2], w_mwo[2], w_out[2], w_gu, w_dn, w_egu, w_edn;
    size_t xb, u, cq, ckv, kr, qm, gt, q, kk, vv, oa, om, ys, es, mf, mb, act, ym, kmem, vmem, memb, ropec, ropes;
    size_t lam[2], bb[2], cp[2], list, toke, toks, tokw, tmm, ssp, xq, rsc, wsc, act8, rsc2, gsc, w_inq[2], rss, end;
};
constexpr WsMap make_map() {
    WsMap m{}; size_t o = CTL_BYTES;
    auto take = [&](size_t bytes) { size_t r = o; o = al256(o + bytes); return r; };
    for (int l = 0; l < 2; ++l) {
        m.w_in[l] = take((size_t)INP * DM * 2); m.w_glu[l] = take((size_t)4096 * S5W * 2); m.w_qb[l] = take((size_t)4096 * 512 * 2); m.w_kvb[l] = take((size_t)4096 * 512 * 2);
        m.w_mo[l] = take((size_t)DM * DM * 2); m.w_mkv[l] = take((size_t)DM * DM * 2); m.w_mwo[l] = take((size_t)DM * MEMW * 2); m.w_out[l] = take((size_t)DM * DM * 2);
        m.lam[l] = take((size_t)S5G * S5P * 8); m.bb[l] = take((size_t)S5G * 128 * 16 * 2); m.cp[l] = take((size_t)S5G * 16 * 128 * 2);
    }
    m.w_gu = take((size_t)2 * DFF * DM * 2); m.w_dn = take((size_t)DM * DFF * 2);
    m.w_egu = take((size_t)NE * 2 * DFF * DM * 2); m.w_edn = take((size_t)NE * DM * DFF * 2);
    m.xb = take((size_t)SEQ * DM * 2); m.u = take((size_t)SEQ * S5W * 2); m.cq = take((size_t)SEQ * 512 * 2); m.ckv = take((size_t)SEQ * 512 * 2);
    m.kr = take((size_t)SEQ * 64 * 4); m.qm = take((size_t)SEQ * MEMW * 2); m.gt = take((size_t)SEQ * 3 * DM * 2);
    m.q = take((size_t)NH * SEQ * DQK * 2); m.kk = take((size_t)NH * SEQ * DQK * 2); m.vv = take((size_t)NH * SEQ * DV * 2);
    m.oa = take((size_t)SEQ * DM * 2); m.om = take((size_t)SEQ * MEMW * 2); m.ys = take((size_t)SEQ * S5W * 2); m.es = take((size_t)S5G * 128 * 128 * 4);
    m.mf = take((size_t)SEQ * DM * 4); m.mb = take((size_t)SEQ * DM * 2);
    m.act = take((size_t)ACT_ROWS * DFF * 2); m.ym = take((size_t)KSPLIT * ACT_ROWS * DM * 2);
    m.kmem = take((size_t)2 * MEMH * NMEM * MEMD * 2); m.vmem = take((size_t)2 * MEMH * NMEM * MEMD * 2); m.memb = take((size_t)NMEM * DM * 2);
    m.ropec = take((size_t)SEQ * 32 * 4); m.ropes = take((size_t)SEQ * 32 * 4);
    m.list = take((size_t)NE * SEQ * 4); m.toke = take((size_t)SEQ * 2 * 4); m.toks = take((size_t)SEQ * 2 * 4); m.tokw = take((size_t)SEQ * 2 * 4); m.tmm = take(2 * 128 * 4); m.ssp = take((size_t)SS_FLOATS * 4); m.xq = take((size_t)SEQ * DM); m.rsc = take((size_t)SEQ * 4); m.wsc = take(256); m.act8 = take((size_t)ACT_ROWS * DFF); m.rsc2 = take((size_t)ACT_ROWS * 4); m.gsc = take((size_t)NE * DM * 4); m.w_inq[0] = take((size_t)7168 * DM); m.w_inq[1] = take((size_t)7168 * DM); m.rss = take((size_t)NE * SEQ * 4);
    m.end = o; return m;
}
constexpr WsMap WS = make_map();

constexpr int RING_BYTES = 131072;
constexpr int XT_OFF = RING_BYTES;
constexpr int RK_OFF = XT_OFF + 4096;
constexpr int MISC_OFF = RK_OFF + 1024;
constexpr int GOFF_OFF = MISC_OFF + 256;
constexpr int TB2_OFF = GOFF_OFF + 8192;
constexpr int LDS_BYTES = 147456;
static_assert(TB2_OFF + 1024 <= LDS_BYTES, "LDS map");

#define XB_TMO      128
#define XB_XCNT(j)  (256  + 64 * (j))
#define XB_XSUB(j)  (1280 + 64 * (j))
#define XB_XGEN(j)  (2304 + 64 * (j))
#define XB_TOP      3328
#define XB_TOPGEN   3392
#define XCD_BAR_WORDS 3456
#define XB_SPIN_CAP (1u << 18)
__device__ __forceinline__ unsigned xb_ld(unsigned* p)              { return __hip_atomic_load(p, __ATOMIC_RELAXED, __HIP_MEMORY_SCOPE_AGENT); }
__device__ __forceinline__ unsigned xb_add(unsigned* p, unsigned v) { return __hip_atomic_fetch_add(p, v, __ATOMIC_RELAXED, __HIP_MEMORY_SCOPE_AGENT); }
__device__ __forceinline__ unsigned xb_xcc_id() { return (unsigned)__builtin_amdgcn_s_getreg((3 << 11) | 20) & 0xFu; }
#define XB_SPIN(cond, bar) do { unsigned _sp = 0; while (cond) { __builtin_amdgcn_s_sleep(1); \
    if ((++_sp & 255u) == 0u) { if (xb_ld(&(bar)[XB_TMO])) break; if (_sp > XB_SPIN_CAP) { atomicAdd(&(bar)[XB_TMO], 1u); break; } } } } while (0)
struct XcdBarrier { unsigned* bar; unsigned x; volatile LAS unsigned* st; };
__device__ __forceinline__ XcdBarrier xcd_barrier_post(unsigned* bar, volatile LAS unsigned* st) {
    XcdBarrier b; b.bar = bar; b.x = xb_xcc_id(); b.st = st;
    if (threadIdx.x == 0) (void)xb_add(&bar[XB_XCNT(b.x)], 1u);
    return b;
}
__device__ __forceinline__ void xcd_barrier_complete(unsigned* bar, unsigned x, unsigned& nloc, unsigned& nx) {
    const unsigned G = gridDim.x * gridDim.y * gridDim.z;
    unsigned sum, cnt, mine, sp = 0u;
    for (;;) {
        sum = 0u; cnt = 0u; mine = 0u;
#pragma unroll
        for (unsigned j = 0; j < 16; ++j) { const unsigned c = xb_ld(&bar[XB_XCNT(j)]); sum += c; cnt += (c > 0u) ? 1u : 0u; mine = (j == x) ? c : mine; }
        if (sum == G) break;
        __builtin_amdgcn_s_sleep(1);
        if ((++sp & 255u) == 0u) { if (xb_ld(&bar[XB_TMO])) break; if (sp > XB_SPIN_CAP) { atomicAdd(&bar[XB_TMO], 1u); break; } }
    }
    nloc = mine > 0u ? mine : 1u; nx = cnt > 0u ? cnt : 1u;
}
__device__ __forceinline__ void xcd_barrier(const XcdBarrier& b) {
    asm volatile("s_waitcnt vmcnt(0)" ::: "memory");
    __syncthreads();
    if (threadIdx.x == 0) {
        unsigned* bar = b.bar;
        __builtin_amdgcn_s_waitcnt(0);
        unsigned nloc = b.st[0], nx = b.st[1];
        if (nloc == 0u) { xcd_barrier_complete(bar, b.x, nloc, nx); b.st[0] = nloc; b.st[1] = nx; }
        const unsigned old = xb_add(&bar[XB_XSUB(b.x)], 1u);
        const unsigned gen = old / nloc;
        if (old + 1u == (gen + 1u) * nloc) {
            __builtin_amdgcn_fence(__ATOMIC_RELEASE, "agent");
            asm volatile("s_waitcnt vmcnt(0)" ::: "memory");
            const unsigned og = xb_add(&bar[XB_TOP], 1u);
            const unsigned tg = og / nx;
            if (og + 1u == (tg + 1u) * nx) xb_add(&bar[XB_TOPGEN], 1u);
            else XB_SPIN(xb_ld(&bar[XB_TOPGEN]) == tg, bar);
            __builtin_amdgcn_fence(__ATOMIC_ACQUIRE, "agent");
            xb_add(&bar[XB_XGEN(b.x)], 1u);
            asm volatile("s_waitcnt vmcnt(0)" ::: "memory");
        } else {
            XB_SPIN(xb_ld(&bar[XB_XGEN(b.x)]) == gen, bar);
            __builtin_amdgcn_fence(__ATOMIC_ACQUIRE, "agent");
            asm volatile("s_waitcnt vmcnt(0)" ::: "memory");
        }
    }
    __syncthreads();
}
namespace pg8 {
constexpr int BM = 256, BK = 64, HALF = 128, HTB = HALF * BK * 2, STAGE_BYTES = 8 * HTB, NXCD = 8, WGM = 8;
__host__ __device__ __forceinline__ int lds_byte(int r, int c) { const int st = (r >> 4) * 2 + (c >> 5), rr = r & 15, cc = c & 31, ob = rr * 64 + cc * 2; return st * 1024 + (ob ^ (((ob >> 9) & 1) << 5)); }
__host__ __device__ __forceinline__ void stage_rc(int b, int& R, int& C) { const int st = b / 1024, sb = b % 1024, swz = sb ^ (((sb >> 9) & 1) << 5); R = (st >> 1) * 16 + swz / 64; C = (st & 1) * 32 + (swz % 64) / 2; }
__host__ __device__ __forceinline__ int perm32(int rho) { const int n = rho >> 4, i = rho & 15; return 8 * (i >> 2) + 4 * n + (i & 3); }

struct Unit { int pm, pn, e, ks, p0, cnt; };
struct Gemm { const void* A; const void* Bt; int lda, ldb, K, es; };

__device__ __forceinline__ bool static_unit(int L, int nM, int nN, Unit& u) {
    const int nwg = nM * nN; if (L >= nwg) return false;
    int wgid = L; { const int q = nwg / NXCD, r = nwg % NXCD, xcd = wgid % NXCD, off = wgid / NXCD; wgid = (xcd < r ? xcd * (q + 1) : r * (q + 1) + (xcd - r) * q) + off; }
    const int nig = WGM * nN, gid = wgid / nig, fm = gid * WGM, gsz = (nM - fm) < WGM ? (nM - fm) : WGM;
    u.pm = fm + ((wgid % nig) % gsz); u.pn = (wgid % nig) / gsz; return true;
}
struct StaticOrder {
    static constexpr bool GATHER = false;
    int nM, nN, G, c;
    __device__ void init(int nM_, int nN_, int G_, int c_) { nM = nM_; nN = nN_; G = G_; c = c_; }
    __device__ bool next(int i, Unit& u) const { u.e = 0; u.ks = 0; u.p0 = 0; u.cnt = 0; return static_unit(i * G + c, nM, nN, u); }
    __device__ __forceinline__ const char* abase(const Gemm& g, const Unit& u) const { return (const char*)g.A + (size_t)u.pm * BM * g.lda * g.es; }
    __device__ __forceinline__ const char* bbase(const Gemm& g, const Unit& u) const { return (const char*)g.Bt + (size_t)u.pn * BM * g.ldb * g.es; }
    __device__ __forceinline__ unsigned tok(const Unit&, int) const { return 0u; }
};
struct BalOrder {
    static constexpr bool GATHER = false;
    int nM, nN, bid;
    __device__ bool next(int i, Unit& u) const { u.e = 0; u.ks = 0; u.p0 = 0; u.cnt = 0; const int x = bid & 7, j = bid >> 3; int k;
        if (j < 4) { if (i >= 2) return false; k = 2 * j + i; } else if (j < 30) { if (i >= 4) return false; k = 8 + 4 * (j - 4) + i; } else return false;
        return static_unit(x + 8 * k, nM, nN, u); }
    __device__ __forceinline__ const char* abase(const Gemm& g, const Unit& u) const { return (const char*)g.A + (size_t)u.pm * BM * g.lda * g.es; }
    __device__ __forceinline__ const char* bbase(const Gemm& g, const Unit& u) const { return (const char*)g.Bt + (size_t)u.pn * BM * g.ldb * g.es; }
    __device__ __forceinline__ unsigned tok(const Unit&, int) const { return 0u; }
};
struct GluOrder : StaticOrder {
    __device__ bool next(int i, Unit& u) const { u.e = 0; u.ks = 0; u.p0 = 0; u.cnt = 0; if (!static_unit((i >> 1) * G + c, nM, nN, u)) return false; u.pn = 2 * u.pn + (i & 1); return true; }
};
struct MemKvOrder {
    static constexpr bool GATHER = false;
    int G, c;
    __device__ bool next(int i, Unit& u) const { const int L = i * G + c; if (L >= 16) return false; u.pm = 0; u.pn = L & 7; u.e = L >> 3; u.ks = 0; u.p0 = 0; u.cnt = 0; return true; }
    __device__ __forceinline__ const char* abase(const Gemm& g, const Unit&) const { return (const char*)g.A; }
    __device__ __forceinline__ const char* bbase(const Gemm& g, const Unit& u) const { return (const char*)g.Bt + ((size_t)u.e * (WS.w_mkv[1] - WS.w_mkv[0])) + (size_t)u.pn * BM * g.ldb * g.es; }
    __device__ __forceinline__ unsigned tok(const Unit&, int) const { return 0u; }
};
template <bool GATHER_, int NKS> struct MoeOrder {
    static constexpr bool GATHER = GATHER_;
    const LAS int* tab; const int* list; int nN, G, c; size_t bstride; int pbase, pcnt;
    __device__ bool next(int i, Unit& u) const {
        int L = i * G + c; if (L >= pcnt * nN * NKS) return false;
        u.ks = L % NKS; L /= NKS;
        static_unit(L, pcnt, nN, u); u.pm += pbase;
        int e = 0;
#pragma unroll
        for (int j = 1; j < 8; ++j) e += (u.pm >= tab[j]) ? 1 : 0;
        u.e = e; u.p0 = tab[e]; u.cnt = tab[16 + e]; return true;
    }
    __device__ __forceinline__ const char* abase(const Gemm& g, const Unit& u) const { return GATHER_ ? (const char*)g.A : (const char*)g.A + ((size_t)u.pm * BM * g.lda + (size_t)u.ks * g.K) * g.es; }
    __device__ __forceinline__ const char* bbase(const Gemm& g, const Unit& u) const { return (const char*)g.Bt + (size_t)u.e * bstride + ((size_t)u.pn * BM * g.ldb + (size_t)u.ks * g.K) * g.es; }
    __device__ __forceinline__ unsigned tok(const Unit& u, int r) const { const int slot = (u.pm - u.p0) * BM + r; const bool in = slot < u.cnt; const unsigned t = (unsigned)list[u.e * SEQ + (in ? slot : 0)]; return in ? t : 0u; }
};

typedef f32x4 Acc[2][2][4][2];

typedef int i32x4 __attribute__((ext_vector_type(4)));
typedef int i32x8 __attribute__((ext_vector_type(8)));
template <class Epi, class Sched, int MODE = 0>
__device__ __forceinline__ void gemm_phase(LAS unsigned char* lds, const Gemm g, const Sched& S, const Epi& E) {
    const int tid = fresh_tid(), wid = __builtin_amdgcn_readfirstlane(tid >> 6), lane = tid & 63, wr = wid >> 2, wc = wid & 3, fr = lane & 15, fq = lane >> 4;
    constexpr int ES = MODE == 0 ? 2 : 1; constexpr bool I8 = MODE == 1, F8 = MODE == 2;
    const int K = g.K, nt = K * ES / (BK * 2);
    unsigned voffA[2], voffB[2];
#pragma unroll
    for (int i = 0; i < 2; ++i) { int R, C; stage_rc(tid * 16 + i * 8192, R, C); const int Rb = Epi::PERM ? ((R & ~31) + perm32(R & 31)) : R;
        voffA[i] = (unsigned)(R * g.lda * ES + C * 2); voffB[i] = (unsigned)(Rb * g.ldb * ES + C * 2); }
    const size_t kstep = (size_t)(BK * 2);
    const size_t hstepA = (size_t)HALF * g.lda * ES, hstepB = (size_t)HALF * g.ldb * ES;
    const unsigned ldsw = (unsigned)wid * 1024u;
    const int aoff = F8 ? lds_byte(wr * 64 + fr, fq * 16) : lds_byte(wr * 64 + fr, fq * 8), boff = F8 ? lds_byte(wc * 32 + fr, fq * 16) : lds_byte(wc * 32 + fr, fq * 8);

    const char* const gA = (const char*)g.A;
#define PG8_SA(b, h) (((b) * 2 + (h)) * HTB)
#define PG8_SB(b, h) ((4 + (b) * 2 + (h)) * HTB)
#define PG8_STAGE(bufoff, gbase, voff) do { _Pragma("unroll") for (int _i = 0; _i < 2; ++_i) \
        __builtin_amdgcn_global_load_lds((const unsigned*)((const char*)(gbase) + (voff)[_i]), (LAS unsigned*)(lds + (bufoff) + ldsw + _i * 8192), 16, 0, 0); } while (0)
#define PG8_STA1(bufoff, h) do { if constexpr (Sched::GATHER) PG8_STAGE(bufoff, gA + ka1, vc[h]); else PG8_STAGE(bufoff, a1 + (h) * hstepA, voffA); } while (0)
#define PG8_STA2(bufoff, h) do { if constexpr (Sched::GATHER) PG8_STAGE(bufoff, gA + ka2, vc[h]); else PG8_STAGE(bufoff, a2 + (h) * hstepA, voffA); } while (0)
#define PG8_STA3(bufoff, h) do { if constexpr (Sched::GATHER) PG8_STAGE(bufoff, gA + ka2 + kstep, vc[h]); else PG8_STAGE(bufoff, a3 + (h) * hstepA, voffA); } while (0)
#define PG8_LDA(dst, b, h) do { if constexpr (F8) { _Pragma("unroll") for (int m = 0; m < 4; ++m) dst##8[m] = *(const LAS i32x8*)(lds + PG8_SA(b, h) + aoff + m * 2048); } \
        else { _Pragma("unroll") for (int m = 0; m < 4; ++m) _Pragma("unroll") for (int k = 0; k < 2; ++k) dst[m][k] = *(const LAS bf16x8*)(lds + PG8_SA(b, h) + aoff + m * 2048 + k * 1024); } } while (0)
#define PG8_LDB(dst, b, h) do { if constexpr (F8) { _Pragma("unroll") for (int n = 0; n < 2; ++n) dst##8[n] = *(const LAS i32x8*)(lds + PG8_SB(b, h) + boff + n * 2048); } \
        else { _Pragma("unroll") for (int n = 0; n < 2; ++n) _Pragma("unroll") for (int k = 0; k < 2; ++k) dst[n][k] = *(const LAS bf16x8*)(lds + PG8_SB(b, h) + boff + n * 2048 + k * 1024); } } while (0)
#define PG8_MMA(ai, bj, At, Bt) do { __builtin_amdgcn_s_setprio(1); \
        if constexpr (F8) { _Pragma("unroll") for (int m = 0; m < 4; ++m) _Pragma("unroll") for (int n = 0; n < 2; ++n) \
            acc[ai][bj][m][n] = __builtin_amdgcn_mfma_scale_f32_16x16x128_f8f6f4(Bt##8[n], At##8[m], acc[ai][bj][m][n], 0, 0, 0, 0x7f7f7f7f, 0, 0x7f7f7f7f); } \
        else { _Pragma("unroll") for (int m = 0; m < 4; ++m) _Pragma("unroll") for (int n = 0; n < 2; ++n) _Pragma("unroll") for (int k = 0; k < 2; ++k) \
        { if constexpr (I8) acc[ai][bj][m][n] = __builtin_bit_cast(f32x4, __builtin_amdgcn_mfma_i32_16x16x64_i8(__builtin_bit_cast(i32x4, Bt[n][k]), __builtin_bit_cast(i32x4, At[m][k]), __builtin_bit_cast(i32x4, acc[ai][bj][m][n]), 0, 0, 0)); \
          else acc[ai][bj][m][n] = __builtin_amdgcn_mfma_f32_16x16x32_bf16(Bt[n][k], At[m][k], acc[ai][bj][m][n], 0, 0, 0); } } __builtin_amdgcn_s_setprio(0); } while (0)
#define PG8_WAIT_V(n) asm volatile("s_waitcnt vmcnt(" #n ")" ::: "memory")
#define PG8_WAIT_L(n) asm volatile("s_waitcnt lgkmcnt(" #n ")" ::: "memory")
#define PG8_BAR __builtin_amdgcn_s_barrier()
#define PG8_SCHED __builtin_amdgcn_sched_barrier(0)
#define PG8_GOFF(dst, u) do { const int _t = fresh_tid(); _Pragma("unroll") for (int _i = 0; _i < 2; ++_i) { int _R, _C; stage_rc(_t * 16 + _i * 8192, _R, _C); _Pragma("unroll") for (int _h = 0; _h < 2; ++_h) \
        dst[_h][_i] = S.tok(u, _h * HALF + _R) * (unsigned)(g.lda * ES) + (unsigned)(_C * 2); } } while (0)
    __builtin_amdgcn_s_waitcnt(0);
    Unit cur, nxt; int ui = 0;
    if (!S.next(0, cur)) return;
    Acc acc;
#pragma unroll
    for (int a = 0; a < 2; ++a)
#pragma unroll
        for (int b = 0; b < 2; ++b)
#pragma unroll
            for (int m = 0; m < 4; ++m)
#pragma unroll
                for (int n = 0; n < 2; ++n) acc[a][b][m][n] = (f32x4){0.f, 0.f, 0.f, 0.f};
    bf16x8 At[4][2], B0[2][2], B1[2][2]; i32x8 At8[4], B08[2], B18[2];
    const char* cA = S.abase(g, cur); const char* cB = S.bbase(g, cur);
    unsigned vc[2][2] = {{0u, 0u}, {0u, 0u}};
    if constexpr (Sched::GATHER) PG8_GOFF(vc, cur);
    {
        const char* a1 = cA; const size_t ka1 = 0;
        PG8_STAGE(PG8_SB(0, 0), cB, voffB); PG8_STAGE(PG8_SB(0, 1), cB + hstepB, voffB); PG8_STA1(PG8_SA(0, 0), 0); PG8_STA1(PG8_SA(0, 1), 1);
        if (wr == 1) PG8_BAR;
        PG8_WAIT_V(2); PG8_BAR;
    }
    {
        const char* a1 = cA + kstep; const size_t ka1 = kstep;
        PG8_STAGE(PG8_SB(1, 0), cB + kstep, voffB); PG8_STA1(PG8_SA(1, 0), 0); PG8_STAGE(PG8_SB(1, 1), cB + hstepB + kstep, voffB);
        PG8_WAIT_V(6); PG8_BAR;
    }
    for (;;) {
        const bool has_next = S.next(ui + 1, nxt);
        const char* nA = has_next ? S.abase(g, nxt) : cA; const char* nB = has_next ? S.bbase(g, nxt) : cB;
        if constexpr (Sched::GATHER) {
            unsigned tn[2][2];
            if (has_next) PG8_GOFF(tn, nxt); else {
#pragma unroll
                for (int _h = 0; _h < 2; ++_h) { tn[_h][0] = vc[_h][0]; tn[_h][1] = vc[_h][1]; } }
            *(LAS u32x4*)(lds + GOFF_OFF + fresh_tid() * 16) = (u32x4){tn[0][0], tn[0][1], tn[1][0], tn[1][1]}; }
        for (int t = 0; t < nt; t += 2) {
            const bool last = (t == nt - 2);
            const char* a1 = cA + (size_t)(t + 1) * kstep; const size_t ka1 = (size_t)(t + 1) * kstep;
            const char* a2 = last ? nA : cA + (size_t)(t + 2) * kstep; const char* b2 = last ? nB : cB + (size_t)(t + 2) * kstep;
            const size_t ka2 = last ? (size_t)0 : (size_t)(t + 2) * kstep;
            const char* a3 = a2 + kstep; const char* b3 = b2 + kstep;
            u32x4 nx_ = {0u, 0u, 0u, 0u};
            if constexpr (Sched::GATHER) { if (last) { nx_ = *(const LAS u32x4*)(lds + GOFF_OFF + fresh_tid() * 16); vc[0][0] = nx_[0]; vc[0][1] = nx_[1]; } }
            PG8_LDB(B0, 0, 0); PG8_LDB(B1, 0, 1); PG8_SCHED; PG8_LDA(At, 0, 0); PG8_STA1(PG8_SA(1, 1), 1);
            if constexpr (Sched::GATHER) { if (last) { vc[1][0] = nx_[2]; vc[1][1] = nx_[3]; } }
            PG8_WAIT_V(8); PG8_WAIT_L(0); PG8_BAR; PG8_MMA(0, 0, At, B0); PG8_MMA(0, 1, At, B1); PG8_BAR; PG8_SCHED;
            PG8_LDA(At, 0, 1); PG8_STAGE(PG8_SB(0, 0), b2, voffB); PG8_STAGE(PG8_SB(0, 1), b2 + hstepB, voffB); PG8_STA2(PG8_SA(0, 0), 0);
            PG8_WAIT_V(8); PG8_WAIT_L(0); PG8_BAR; PG8_MMA(1, 0, At, B0); PG8_MMA(1, 1, At, B1); PG8_BAR; PG8_SCHED;
            PG8_LDB(B0, 1, 0); PG8_LDB(B1, 1, 1); PG8_SCHED; PG8_LDA(At, 1, 0); PG8_STA2(PG8_SA(0, 1), 1);
            PG8_WAIT_V(8); PG8_WAIT_L(0); PG8_BAR; PG8_MMA(0, 0, At, B0); PG8_MMA(0, 1, At, B1); PG8_BAR; PG8_SCHED;
            PG8_LDA(At, 1, 1); PG8_STAGE(PG8_SB(1, 0), b3, voffB); PG8_STAGE(PG8_SB(1, 1), b3 + hstepB, voffB); PG8_STA3(PG8_SA(1, 0), 0);
            PG8_WAIT_V(8); PG8_WAIT_L(0); PG8_BAR; PG8_MMA(1, 0, At, B0); PG8_MMA(1, 1, At, B1); PG8_BAR; PG8_SCHED;
        }
        if (wr == 0) PG8_BAR;
        if constexpr (I8) {
#pragma unroll
            for (int a = 0; a < 2; ++a)
#pragma unroll
                for (int b = 0; b < 2; ++b)
#pragma unroll
                    for (int m = 0; m < 4; ++m)
#pragma unroll
                        for (int n = 0; n < 2; ++n) acc[a][b][m][n] = __builtin_convertvector(__builtin_bit_cast(i32x4, acc[a][b][m][n]), f32x4); }
        { const int t2_ = fresh_tid(), l2_ = t2_ & 63; E(acc, cur, wr, wc, l2_ & 15, l2_ >> 4, lds, t2_); }
        if (!has_next) break;
#pragma unroll
        for (int a = 0; a < 2; ++a)
#pragma unroll
            for (int b = 0; b < 2; ++b)
#pragma unroll
                for (int m = 0; m < 4; ++m)
#pragma unroll
                    for (int n = 0; n < 2; ++n) acc[a][b][m][n] = (f32x4){0.f, 0.f, 0.f, 0.f};
        cur = nxt; cA = nA; cB = nB; ++ui;
        if (wr == 1) PG8_BAR;
    }
    PG8_WAIT_V(0);
    PG8_BAR;
#undef PG8_SA
#undef PG8_SB
#undef PG8_STAGE
#undef PG8_STA1
#undef PG8_STA2
#undef PG8_STA3
#undef PG8_LDA
#undef PG8_LDB
#undef PG8_MMA
#undef PG8_WAIT_V
#undef PG8_WAIT_L
#undef PG8_BAR
#undef PG8_SCHED
#undef PG8_GOFF
}

__device__ __forceinline__ unsigned lds_addr(LAS unsigned char* lds, int off) { return (unsigned)(size_t)lds + (unsigned)off; }
__device__ __forceinline__ void lds_w32(unsigned a, float v) { asm volatile("ds_write_b32 %0, %1" :: "v"(a), "v"(v) : "memory"); }
__device__ __forceinline__ float lds_r32(unsigned a) { float r; asm volatile("ds_read_b32 %0, %1\n\ts_waitcnt lgkmcnt(0)" : "=v"(r) : "v"(a) : "memory"); return r; }
__device__ __forceinline__ void lds_r32x8(unsigned a, float (&r)[2][4]) {
    asm volatile("ds_read_b32 %0, %8\n\tds_read_b32 %1, %8 offset:64\n\tds_read_b32 %2, %8 offset:128\n\tds_read_b32 %3, %8 offset:192\n\tds_read_b32 %4, %8 offset:512\n\tds_read_b32 %5, %8 offset:576\n\tds_read_b32 %6, %8 offset:640\n\tds_read_b32 %7, %8 offset:704\n\ts_waitcnt lgkmcnt(0)"
                 : "=&v"(r[0][0]), "=&v"(r[0][1]), "=&v"(r[0][2]), "=&v"(r[0][3]), "=&v"(r[1][0]), "=&v"(r[1][1]), "=&v"(r[1][2]), "=&v"(r[1][3]) : "v"(a) : "memory"); }
__device__ __forceinline__ f32x4 lds_r128(unsigned a) { f32x4 r; asm volatile("ds_read_b128 %0, %1\n\ts_waitcnt lgkmcnt(0)" : "=v"(r) : "v"(a) : "memory"); return r; }
#define EPI_BAR() do { asm volatile("s_waitcnt lgkmcnt(0)" ::: "memory"); __builtin_amdgcn_s_barrier(); asm volatile("" ::: "memory"); } while (0)
__device__ __forceinline__ void rows_allreduce(float (&part)[2][4], LAS unsigned char* lds, int wr, int wc, int fr, int fq) {
    const unsigned xt = lds_addr(lds, XT_OFF);
#pragma unroll
    for (int ai = 0; ai < 2; ++ai)
#pragma unroll
        for (int m = 0; m < 4; ++m) { float s = part[ai][m]; s += __shfl_xor(s, 16); s += __shfl_xor(s, 32);
            if (fq == 0) lds_w32(xt + ((ai * HALF + wr * 64 + m * 16 + fr) * 4 + wc) * 4, s); }
    EPI_BAR();
#pragma unroll
    for (int ai = 0; ai < 2; ++ai)
#pragma unroll
        for (int m = 0; m < 4; ++m) { const f32x4 v = lds_r128(xt + (ai * HALF + wr * 64 + m * 16 + fr) * 16); part[ai][m] = (v[0] + v[1]) + (v[2] + v[3]); }
}
template <int NS> __device__ __forceinline__ void rows_slots(float (&part)[2][4], float* ssp, int row0, int fq, int slot) {
#pragma unroll
    for (int ai = 0; ai < 2; ++ai)
#pragma unroll
        for (int m = 0; m < 4; ++m) { float s = part[ai][m]; s += __shfl_xor(s, 16); s += __shfl_xor(s, 32);
            if (fq == 0) ssp[(size_t)(row0 + ai * HALF + m * 16) * NS + slot] = s; }
}
template <int NS> __device__ __forceinline__ void fill_row_table(LAS unsigned char* lds, int off, const float* ssp, size_t row_base, int tid, float inv_n, bool rsq) {
    const unsigned tb = lds_addr(lds, off);
    { if (tid < 256) { const float s = sum_slots<NS>(ssp + (row_base + tid) * NS); lds_w32(tb + tid * 4, rsq ? 1.0f / sqrtf(s * inv_n + EPS) : s); } }
    EPI_BAR();
}
__device__ __forceinline__ float sq4(f32x4 v) { return (v[0] * v[0] + v[1] * v[1]) + (v[2] * v[2] + v[3] * v[3]); }
__device__ __forceinline__ u32x4 pack8(f32x4 a, f32x4 b) { u32x4 w; w.x = cvt_pk_bf16(a[0], a[1]); w.y = cvt_pk_bf16(a[2], a[3]); w.z = cvt_pk_bf16(b[0], b[1]); w.w = cvt_pk_bf16(b[2], b[3]); return w; }
__device__ __forceinline__ u32x4 from_rowmajor(u32x4 v, int lane) { const int a = ((((lane & 15) << 2) | (lane >> 4)) << 2); u32x4 r;
    r.x = (unsigned)__builtin_amdgcn_ds_bpermute(a, (int)v.x); r.y = (unsigned)__builtin_amdgcn_ds_bpermute(a, (int)v.y); r.z = (unsigned)__builtin_amdgcn_ds_bpermute(a, (int)v.z); r.w = (unsigned)__builtin_amdgcn_ds_bpermute(a, (int)v.w); return r; }
__device__ __forceinline__ u32x2 from_rowmajor2(u32x2 v, int lane) { const int a = ((((lane & 15) << 2) | (lane >> 4)) << 2); u32x2 r;
    r.x = (unsigned)__builtin_amdgcn_ds_bpermute(a, (int)v.x); r.y = (unsigned)__builtin_amdgcn_ds_bpermute(a, (int)v.y); return r; }
__device__ __forceinline__ f32x4 from_rowmajor_f(f32x4 v, int lane) { return __builtin_bit_cast(f32x4, from_rowmajor(__builtin_bit_cast(u32x4, v), lane)); }
__device__ __forceinline__ u32x2 pack4(f32x4 a) { u32x2 w; w.x = cvt_pk_bf16(a[0], a[1]); w.y = cvt_pk_bf16(a[2], a[3]); return w; }
__device__ __forceinline__ f32x4 unpack4(u32x2 w) { return (f32x4){bflo(w.x), bfhi(w.x), bflo(w.y), bfhi(w.y)}; }
__device__ __forceinline__ unsigned pack4_u8(f32x4 g) { const float M = 8388608.0f;
    const unsigned u0 = __builtin_bit_cast(unsigned, __builtin_fmaf(g[0], 255.0f, M)), u1 = __builtin_bit_cast(unsigned, __builtin_fmaf(g[1], 255.0f, M)), u2 = __builtin_bit_cast(unsigned, __builtin_fmaf(g[2], 255.0f, M)), u3 = __builtin_bit_cast(unsigned, __builtin_fmaf(g[3], 255.0f, M));
    return __builtin_amdgcn_perm(u1, u0, 0x0c0c0400u) | __builtin_amdgcn_perm(u3, u2, 0x04000c0cu); }
__device__ __forceinline__ f32x4 unpack4_u8(unsigned w) { return (f32x4){(float)(w & 0xffu), (float)((w >> 8) & 0xffu), (float)((w >> 16) & 0xffu), (float)(w >> 24)} * (1.0f / 255.0f); }

struct EpiInProj {
    static constexpr bool PERM = true;
    const float* ssx; bf16 *U, *CQ, *CKV, *QM; unsigned char* GT; float* KR; float *ss_cq, *ss_ckv, *ss_kr; const float* qm_gain;
    __device__ __forceinline__ void operator()(Acc& acc, const Unit& u, int wr, int wc, int fr, int fq, LAS unsigned char* lds, int tid) const {
        asm volatile("" : "+v"(fr), "+v"(fq), "+v"(tid));
        const int pn = u.pn, row0 = u.pm * BM + wr * 64 + fr, cl = wc * 32 + 8 * fq;
        fill_row_table<32>(lds, RK_OFF, ssx, (size_t)u.pm * BM, tid, 1.0f / DM, true);
        float rs[2][4];
#pragma unroll
        for (int ai = 0; ai < 2; ++ai)
#pragma unroll
            for (int m = 0; m < 4; ++m) rs[ai][m] = 0.f;
        lds_r32x8(lds_addr(lds, RK_OFF) + (wr * 64 + fr) * 4, rs);
#pragma unroll
        for (int ai = 0; ai < 2; ++ai)
#pragma unroll
            for (int bj = 0; bj < 2; ++bj)
#pragma unroll
                for (int m = 0; m < 4; ++m)
#pragma unroll
                    for (int n = 0; n < 2; ++n) acc[ai][bj][m][n] = acc[ai][bj][m][n] * rs[ai][m];
        if (pn < 4 || (pn >= 4 && pn < 8)) {
            bf16* dst; int ld, c0; float* ss = nullptr; int tl = 0;
            if (pn < 4) { dst = U; ld = S5W; c0 = pn * 256; } else if (pn < 6) { dst = CQ; ld = 512; c0 = (pn - 4) * 256; ss = ss_cq; tl = pn - 4; } else { dst = CKV; ld = 512; c0 = (pn - 6) * 256; ss = ss_ckv; tl = pn - 6; }
            float part[2][4];
#pragma unroll
            for (int ai = 0; ai < 2; ++ai)
#pragma unroll
                for (int m = 0; m < 4; ++m) { bf16* rp = dst + (size_t)(row0 + ai * HALF + m * 16) * ld + c0 + cl; float s = 0.f;
#pragma unroll
                    for (int bj = 0; bj < 2; ++bj) { *(u32x4*)(rp + bj * HALF) = pack8(acc[ai][bj][m][0], acc[ai][bj][m][1]); s += sq4(acc[ai][bj][m][0]) + sq4(acc[ai][bj][m][1]); }
                    part[ai][m] = s; }
            if (ss) rows_slots<8>(part, ss, row0, fq, tl * 4 + wc);
        } else if (pn == 8) {
            float part[2][4];
#pragma unroll
            for (int ai = 0; ai < 2; ++ai)
#pragma unroll
                for (int m = 0; m < 4; ++m) { float s = 0.f;
                    if (wc < 2) { float* rp = KR + (size_t)(row0 + ai * HALF + m * 16) * 64 + cl; *(f32x4*)rp = acc[ai][0][m][0]; *(f32x4*)(rp + 4) = acc[ai][0][m][1]; s = sq4(acc[ai][0][m][0]) + sq4(acc[ai][0][m][1]); }
                    part[ai][m] = s; }
            rows_slots<4>(part, ss_kr, row0, fq, wc);
        } else if (pn < 13) {
            float part[2][4];
#pragma unroll
            for (int ai = 0; ai < 2; ++ai)
#pragma unroll
                for (int m = 0; m < 4; ++m) { float s = 0.f;
#pragma unroll
                    for (int bj = 0; bj < 2; ++bj) s += sq4(acc[ai][bj][m][0]) + sq4(acc[ai][bj][m][1]);
                    part[ai][m] = s; }
            rows_allreduce(part, lds, wr, wc, fr, fq);
            f32x4 gn[2][2];
#pragma unroll
            for (int bj = 0; bj < 2; ++bj)
#pragma unroll
                for (int n = 0; n < 2; ++n) gn[bj][n] = *(const f32x4*)(qm_gain + bj * HALF + cl + 4 * n) * (0.0625f * LOG2E);
#pragma unroll
            for (int ai = 0; ai < 2; ++ai)
#pragma unroll
                for (int m = 0; m < 4; ++m) { const float rq = 1.0f / sqrtf(part[ai][m] * (1.0f / MEMD) + EPS); bf16* rp = QM + (size_t)(row0 + ai * HALF + m * 16) * MEMW + (pn - 9) * 256 + cl;
#pragma unroll
                    for (int bj = 0; bj < 2; ++bj) *(u32x4*)(rp + bj * HALF) = pack8(acc[ai][bj][m][0] * gn[bj][0] * rq, acc[ai][bj][m][1] * gn[bj][1] * rq); }
        } else {
#pragma unroll
            for (int ai = 0; ai < 2; ++ai)
#pragma unroll
                for (int m = 0; m < 4; ++m) { unsigned char* rp = GT + (size_t)(row0 + ai * HALF + m * 16) * (3 * DM) + (pn - 13) * 256 + cl;
#pragma unroll
                    for (int bj = 0; bj < 2; ++bj) { f32x4 a = acc[ai][bj][m][0], b = acc[ai][bj][m][1];
#pragma unroll
                        for (int e = 0; e < 4; ++e) { a[e] = sigmoidf_(a[e]); b[e] = sigmoidf_(b[e]); }
                        *(u32x2*)(rp + bj * HALF) = (u32x2){pack4_u8(a), pack4_u8(b)}; } }
        }
    }
};

struct EpiGates {
    static constexpr bool PERM = true;
    const float* rsc; float wstep; unsigned char* GT;
    float wstep_q; bf16* QM; const float* qm_gain;
    __device__ __forceinline__ void operator()(Acc& acc, const Unit& u, int wr, int wc, int fr, int fq, LAS unsigned char* lds, int tid) const {
        asm volatile("" : "+v"(fr), "+v"(fq), "+v"(tid));
        const int row0 = u.pm * BM + wr * 64 + fr, cl = wc * 32 + 8 * fq;
        if (u.pn < 4) {
            float part[2][4];
#pragma unroll
            for (int ai = 0; ai < 2; ++ai)
#pragma unroll
                for (int m = 0; m < 4; ++m) { const float rs = rsc[row0 + ai * HALF + m * 16] * wstep_q; float s = 0.f;
#pragma unroll
                    for (int bj = 0; bj < 2; ++bj)
#pragma unroll
                        for (int n = 0; n < 2; ++n) { acc[ai][bj][m][n] = acc[ai][bj][m][n] * rs; s += sq4(acc[ai][bj][m][n]); }
                    part[ai][m] = s; }
            rows_allreduce(part, lds, wr, wc, fr, fq);
            f32x4 gn[2][2];
#pragma unroll
            for (int bj = 0; bj < 2; ++bj)
#pragma unroll
                for (int n = 0; n < 2; ++n) gn[bj][n] = *(const f32x4*)(qm_gain + bj * HALF + cl + 4 * n) * (0.0625f * LOG2E);
#pragma unroll
            for (int ai = 0; ai < 2; ++ai)
#pragma unroll
                for (int m = 0; m < 4; ++m) { const float rq = 1.0f / sqrtf(part[ai][m] * (1.0f / MEMD) + EPS); bf16* rp = QM + (size_t)(row0 + ai * HALF + m * 16) * MEMW + u.pn * 256 + cl;
#pragma unroll
                    for (int bj = 0; bj < 2; ++bj) *(u32x4*)(rp + bj * HALF) = pack8(acc[ai][bj][m][0] * gn[bj][0] * rq, acc[ai][bj][m][1] * gn[bj][1] * rq); }
            return;
        }
        float rgv[2][4];
#pragma unroll
        for (int ai = 0; ai < 2; ++ai)
#pragma unroll
            for (int m = 0; m < 4; ++m) { const float* rp_ = rsc + row0 + ai * HALF + m * 16; asm volatile("global_load_dword %0, %1, off" : "=v"(rgv[ai][m]) : "v"(rp_) : "memory"); }
        asm volatile("s_waitcnt vmcnt(0)" : "+v"(rgv[0][0]), "+v"(rgv[0][1]), "+v"(rgv[0][2]), "+v"(rgv[0][3]), "+v"(rgv[1][0]), "+v"(rgv[1][1]), "+v"(rgv[1][2]), "+v"(rgv[1][3]) :: "memory");
#pragma unroll
        for (int ai = 0; ai < 2; ++ai)
#pragma unroll
            for (int m = 0; m < 4; ++m) { const int row = row0 + ai * HALF + m * 16; const float rs = rgv[ai][m] * wstep; unsigned char* rp = GT + (size_t)row * (3 * DM) + (u.pn - 4) * 256 + cl;
#pragma unroll
                for (int bj = 0; bj < 2; ++bj) { f32x4 a = acc[ai][bj][m][0] * rs, b = acc[ai][bj][m][1] * rs;
#pragma unroll
                    for (int e = 0; e < 4; ++e) { a[e] = sigmoidf_(a[e]); b[e] = sigmoidf_(b[e]); }
                    *(u32x2*)(rp + bj * HALF) = (u32x2){pack4_u8(a), pack4_u8(b)}; } }
    }
};
struct EpiQ {
    static constexpr bool PERM = true;
    const float* ss_cq; const float* qn; const float* ropec; const float* ropes; bf16* Q;
    __device__ __forceinline__ void operator()(Acc& acc, const Unit& u, int wr, int wc, int fr, int fq, LAS unsigned char* lds, int tid) const {
        asm volatile("" : "+v"(fr), "+v"(fq), "+v"(tid));
        const int row0 = u.pm * BM + wr * 64 + fr, cl = wc * 32 + 8 * fq;
        fill_row_table<8>(lds, RK_OFF, ss_cq, (size_t)u.pm * BM, tid, 1.0f / QRANK, true);
        float part[2][4], av_[2][4]; lds_r32x8(lds_addr(lds, RK_OFF) + (wr * 64 + fr) * 4, av_);
#pragma unroll
        for (int ai = 0; ai < 2; ++ai)
#pragma unroll
            for (int m = 0; m < 4; ++m) { const float a = av_[ai][m]; float s = 0.f;
#pragma unroll
                for (int bj = 0; bj < 2; ++bj)
#pragma unroll
                    for (int n = 0; n < 2; ++n) { acc[ai][bj][m][n] = acc[ai][bj][m][n] * a; s += sq4(acc[ai][bj][m][n]); }
                part[ai][m] = s; }
        rows_allreduce(part, lds, wr, wc, fr, fq);
        const float SC = 0.07216878364870322f * LOG2E;
        { f32x4 g0 = *(const f32x4*)(qn + cl), g1 = *(const f32x4*)(qn + cl + 4);
#pragma unroll
          for (int ai = 0; ai < 2; ++ai)
#pragma unroll
            for (int m = 0; m < 4; ++m) { const float rq = SC / sqrtf(part[ai][m] * (1.0f / DQK) + EPS); bf16* rp = Q + ((size_t)u.pn * SEQ + row0 + ai * HALF + m * 16) * DQK + cl;
                *(u32x4*)rp = pack8(acc[ai][0][m][0] * g0 * rq, acc[ai][0][m][1] * g1 * rq); asm volatile("" ::: "memory"); } }
        if (wc < 2) {
            const int i0 = cl >> 1; float g1v[4], g2v[4];
#pragma unroll
            for (int j = 0; j < 4; ++j) { g1v[j] = qn[128 + i0 + j]; g2v[j] = qn[160 + i0 + j]; }
#pragma unroll
            for (int ai = 0; ai < 2; ++ai) { f32x4 csv[4], snv[4];
#pragma unroll
                for (int m = 0; m < 4; ++m) { const int row = row0 + ai * HALF + m * 16; csv[m] = *(const f32x4*)(ropec + (size_t)row * 32 + i0); snv[m] = *(const f32x4*)(ropes + (size_t)row * 32 + i0); }
#pragma unroll
                for (int m = 0; m < 4; ++m) { const int row = row0 + ai * HALF + m * 16; const float rq = SC / sqrtf(part[ai][m] * (1.0f / DQK) + EPS);
                    const f32x4 cs = csv[m], sn = snv[m];
                    f32x4 o0, o1;
                    { const float x1 = acc[ai][1][m][0][0] * g1v[0] * rq, x2 = acc[ai][1][m][0][1] * g2v[0] * rq; o0[0] = x1 * cs[0] - x2 * sn[0]; o0[1] = x2 * cs[0] + x1 * sn[0]; }
                    { const float x1 = acc[ai][1][m][0][2] * g1v[1] * rq, x2 = acc[ai][1][m][0][3] * g2v[1] * rq; o0[2] = x1 * cs[1] - x2 * sn[1]; o0[3] = x2 * cs[1] + x1 * sn[1]; }
                    { const float x1 = acc[ai][1][m][1][0] * g1v[2] * rq, x2 = acc[ai][1][m][1][1] * g2v[2] * rq; o1[0] = x1 * cs[2] - x2 * sn[2]; o1[1] = x2 * cs[2] + x1 * sn[2]; }
                    { const float x1 = acc[ai][1][m][1][2] * g1v[3] * rq, x2 = acc[ai][1][m][1][3] * g2v[3] * rq; o1[2] = x1 * cs[3] - x2 * sn[3]; o1[3] = x2 * cs[3] + x1 * sn[3]; }
                    *(u32x4*)(Q + ((size_t)u.pn * SEQ + row) * DQK + 128 + cl) = pack8(o0, o1); } }
        }
    }
};

struct EpiKV {
    static constexpr bool PERM = true;
    const float* ss_ckv; const float* ss_kr; const float* kn; const float* KR; const float* ropec; const float* ropes; bf16* Kc; bf16* Vc;
    __device__ __forceinline__ void operator()(Acc& acc, const Unit& u, int wr, int wc, int fr, int fq, LAS unsigned char* lds, int tid) const {
        asm volatile("" : "+v"(fr), "+v"(fq), "+v"(tid));
        const int row0 = u.pm * BM + wr * 64 + fr, cl = wc * 32 + 8 * fq;
        { if (tid < 256) lds_w32(lds_addr(lds, TB2_OFF) + tid * 4, sum_slots<4>(ss_kr + ((size_t)u.pm * BM + tid) * 4)); }
        fill_row_table<8>(lds, RK_OFF, ss_ckv, (size_t)u.pm * BM, tid, 1.0f / KVRANK, true);
        float part[2][4];
        float akv_[2][4]; lds_r32x8(lds_addr(lds, RK_OFF) + (wr * 64 + fr) * 4, akv_);
#pragma unroll
        for (int ai = 0; ai < 2; ++ai)
#pragma unroll
            for (int m = 0; m < 4; ++m) { const float a = akv_[ai][m];
#pragma unroll
                for (int bj = 0; bj < 2; ++bj)
#pragma unroll
                    for (int n = 0; n < 2; ++n) acc[ai][bj][m][n] = acc[ai][bj][m][n] * a;
                part[ai][m] = sq4(acc[ai][0][m][0]) + sq4(acc[ai][0][m][1]); }
        rows_allreduce(part, lds, wr, wc, fr, fq);
        const unsigned rkt = lds_addr(lds, RK_OFF);
        const f32x4 g0 = *(const f32x4*)(kn + cl), g1 = *(const f32x4*)(kn + cl + 4);
#pragma unroll
        for (int ai = 0; ai < 2; ++ai)
#pragma unroll
            for (int m = 0; m < 4; ++m) { const int row = row0 + ai * HALF + m * 16; const float rk = 1.0f / sqrtf((part[ai][m] + lds_r32(lds_addr(lds, TB2_OFF) + (ai * HALF + wr * 64 + m * 16 + fr) * 4)) * (1.0f / DQK) + EPS);
                *(u32x4*)(Kc + ((size_t)u.pn * SEQ + row) * DQK + cl) = pack8(acc[ai][0][m][0] * g0 * rk, acc[ai][0][m][1] * g1 * rk);
                *(u32x4*)(Vc + ((size_t)u.pn * SEQ + row) * DV + cl) = pack8(acc[ai][1][m][0], acc[ai][1][m][1]);
                if (wc == 0 && fq == 0) lds_w32(rkt + (ai * HALF + wr * 64 + m * 16 + fr) * 4, rk); }
        EPI_BAR();
        {
            const int rl = tid >> 1, i0 = (tid & 1) * 16, row = u.pm * BM + rl; const float rk = lds_r32(rkt + rl * 4);
            const float* kr = KR + (size_t)row * 64; bf16* dst = Kc + ((size_t)u.pn * SEQ + row) * DQK + 128 + 2 * i0;
#pragma unroll
            for (int j4 = 0; j4 < 4; ++j4) { const int i = i0 + 4 * j4;
                const f32x4 x1 = *(const f32x4*)(kr + i) * *(const f32x4*)(kn + 128 + i) * rk, x2 = *(const f32x4*)(kr + 32 + i) * *(const f32x4*)(kn + 160 + i) * rk;
                const f32x4 cs = *(const f32x4*)(ropec + (size_t)row * 32 + i), sn = *(const f32x4*)(ropes + (size_t)row * 32 + i);
                const f32x4 a = x1 * cs - x2 * sn, b = x2 * cs + x1 * sn;
                *(u32x4*)(dst + 8 * j4) = pack8((f32x4){a[0], b[0], a[1], b[1]}, (f32x4){a[2], b[2], a[3], b[3]}); }
        }
    }
};

struct EpiMemKV {
    static constexpr bool PERM = true;
    const float* kng[2]; bf16* KM; bf16* VM;
    __device__ __forceinline__ void operator()(Acc& acc, const Unit& u, int wr, int wc, int fr, int fq, LAS unsigned char* lds, int tid) const {
        asm volatile("" : "+v"(fr), "+v"(fq), "+v"(tid));
        const int rl0 = wr * 64 + fr, cl = wc * 32 + 8 * fq;
        float part[2][4];
#pragma unroll
        for (int ai = 0; ai < 2; ++ai)
#pragma unroll
            for (int m = 0; m < 4; ++m) { float s = 0.f;
#pragma unroll
                for (int bj = 0; bj < 2; ++bj) s += sq4(acc[ai][bj][m][0]) + sq4(acc[ai][bj][m][1]);
                part[ai][m] = s; }
        rows_allreduce(part, lds, wr, wc, fr, fq);
        const bool isk = u.pn < 4; const float* kg = u.e ? kng[1] : kng[0];
        bf16* dst = (isk ? KM : VM) + ((size_t)u.e * MEMH + (u.pn & 3)) * NMEM * MEMD;
#pragma unroll
        for (int ai = 0; ai < 2; ++ai)
#pragma unroll
            for (int m = 0; m < 4; ++m) { const float rk = isk ? 1.0f / sqrtf(part[ai][m] * (1.0f / MEMD) + EPS) : 1.0f;
#pragma unroll
                for (int bj = 0; bj < 2; ++bj) { f32x4 g0 = (f32x4){1.f, 1.f, 1.f, 1.f}, g1 = g0; if (isk) { g0 = *(const f32x4*)(kg + bj * HALF + cl); g1 = *(const f32x4*)(kg + bj * HALF + cl + 4); }
                    *(u32x4*)(dst + (size_t)(rl0 + ai * HALF + m * 16) * MEMD + bj * HALF + cl) = pack8(acc[ai][bj][m][0] * g0 * rk, acc[ai][bj][m][1] * g1 * rk); } }
    }
};

template <int MODE> struct EpiMerge {
    static constexpr bool PERM = true;
    const unsigned char* GT; bf16* MF;
    __device__ __forceinline__ void operator()(Acc& acc, const Unit& u, int wr, int wc, int fr, int fq, LAS unsigned char* lds, int tid) const {
        asm volatile("" : "+v"(fr), "+v"(fq), "+v"(tid));
        const int ln_ = tid & 63, dr_ = (ln_ >> 2) - fr, dq_ = (ln_ & 3) - fq;
        const int row0 = u.pm * BM + wr * 64 + fr, col0 = u.pn * BM + wc * 32 + 8 * fq;
#pragma unroll
        for (int ai = 0; ai < 2; ++ai) { u32x2 gv[4][2]; u32x4 ov[4][2];
#pragma unroll
            for (int m = 0; m < 4; ++m) { const size_t row = row0 + ai * HALF + m * 16;
#pragma unroll
                for (int bj = 0; bj < 2; ++bj) { const int c = col0 + bj * HALF; gv[m][bj] = *(const u32x2*)(GT + (row + dr_) * (3 * DM) + MODE * DM + c + dq_ * 8);
                    if (MODE == 2) ov[m][bj] = *(const u32x4*)(MF + (row + dr_) * DM + c + dq_ * 8); } }
#pragma unroll
            for (int m = 0; m < 4; ++m) { const size_t row = row0 + ai * HALF + m * 16;
#pragma unroll
                for (int bj = 0; bj < 2; ++bj) { const int c = col0 + bj * HALF; const u32x2 g = from_rowmajor2(gv[m][bj], ln_);
                    bf16* p = MF + row * DM + c; f32x4 lo = acc[ai][bj][m][0] * unpack4_u8(g.x), hi = acc[ai][bj][m][1] * unpack4_u8(g.y);
                    if (MODE == 2) { const u32x4 o = from_rowmajor(ov[m][bj], ln_); lo = lo + unpack4((u32x2){o.x, o.y}); hi = hi + unpack4((u32x2){o.z, o.w}); }
                    *(u32x4*)p = pack8(lo, hi); } } }
    }
};
struct EpiGlu {
    static constexpr bool PERM = true;
    const unsigned char* GT; const bf16* MF; bf16* MB;
    __device__ __forceinline__ void operator()(Acc& acc, const Unit& u, int wr, int wc, int fr, int fq, LAS unsigned char* lds, int tid) const {
        asm volatile("" : "+v"(fr), "+v"(fq), "+v"(tid));
        const int ln_ = tid & 63, dr_ = (ln_ >> 2) - fr, dq_ = (ln_ & 3) - fq;
        const int row0 = u.pm * BM + wr * 64 + fr, col0 = u.pn * HALF + wc * 32 + 8 * fq;
        u32x2 gv[2][4]; u32x4 ov[2][4];
#pragma unroll
        for (int ai = 0; ai < 2; ++ai)
#pragma unroll
            for (int m = 0; m < 4; ++m) { const size_t row = row0 + ai * HALF + m * 16;
                gv[ai][m] = *(const u32x2*)(GT + (row + dr_) * (3 * DM) + col0 + dq_ * 8); ov[ai][m] = *(const u32x4*)(MF + (row + dr_) * DM + col0 + dq_ * 8); }
#pragma unroll
        for (int ai = 0; ai < 2; ++ai)
#pragma unroll
            for (int m = 0; m < 4; ++m) { const size_t row = row0 + ai * HALF + m * 16;
                const u32x2 g = from_rowmajor2(gv[ai][m], ln_); const u32x4 o = from_rowmajor(ov[ai][m], ln_);
                f32x4 v[2] = {unpack4((u32x2){o.x, o.y}), unpack4((u32x2){o.z, o.w})}; const f32x4 gg[2] = {unpack4_u8(g.x), unpack4_u8(g.y)};
#pragma unroll
                for (int n = 0; n < 2; ++n) { const f32x4 ga = acc[ai][0][m][n], gb = acc[ai][1][m][n];
#pragma unroll
                    for (int e = 0; e < 4; ++e) v[n][e] += gg[n][e] * ga[e] * sigmoidf_(gb[e]); }
                *(u32x4*)(MB + row * DM + col0) = pack8(v[0], v[1]); }
    }
};
template <bool BASE16, bool WOUT> struct EpiResid {
    static constexpr bool PERM = true;
    const void* base; float* OUT; bf16* XBo; float* ss;
    __device__ __forceinline__ void operator()(Acc& acc, const Unit& u, int wr, int wc, int fr, int fq, LAS unsigned char* lds, int tid) const {
        asm volatile("" : "+v"(fr), "+v"(fq), "+v"(tid));
        const int ln_ = tid & 63, dr_ = (ln_ >> 2) - fr, dq_ = (ln_ & 3) - fq;
        const int row0 = u.pm * BM + wr * 64 + fr, col0 = u.pn * BM + wc * 32 + 8 * fq;
        float part[2][4];
#pragma unroll
        for (int ai = 0; ai < 2; ++ai) { u32x4 wv[4][2]; f32x4 fv[4][2][2];
#pragma unroll
            for (int m = 0; m < 4; ++m) { const size_t row = row0 + ai * HALF + m * 16;
#pragma unroll
                for (int bj = 0; bj < 2; ++bj) { const size_t o = row * DM + col0 + bj * HALF;
                    if constexpr (BASE16) wv[m][bj] = *(const u32x4*)((const bf16*)base + o + dr_ * DM + dq_ * 8);
                    else { fv[m][bj][0] = *(const f32x4*)((const float*)base + o + dr_ * DM + dq_ * 8); fv[m][bj][1] = *(const f32x4*)((const float*)base + o + dr_ * DM + dq_ * 8 + 4); } } }
#pragma unroll
            for (int m = 0; m < 4; ++m) { const size_t row = row0 + ai * HALF + m * 16; float s = 0.f;
#pragma unroll
                for (int bj = 0; bj < 2; ++bj) { const size_t o = row * DM + col0 + bj * HALF; f32x4 b0, b1;
                    if constexpr (BASE16) { const u32x4 w = from_rowmajor(wv[m][bj], ln_); b0 = unpack4((u32x2){w.x, w.y}); b1 = unpack4((u32x2){w.z, w.w}); }
                    else { b0 = from_rowmajor_f(fv[m][bj][0], ln_); b1 = from_rowmajor_f(fv[m][bj][1], ln_); }
                    const f32x4 v0 = acc[ai][bj][m][0] + b0, v1 = acc[ai][bj][m][1] + b1;
                    if constexpr (WOUT) { *(f32x4*)(OUT + o) = v0; *(f32x4*)(OUT + o + 4) = v1; }
                    if (XBo) *(u32x4*)(XBo + o) = pack8(v0, v1);
                    s += sq4(v0) + sq4(v1); }
                part[ai][m] = s; } }
        if (ss) rows_slots<32>(part, ss, row0, fq, u.pn * 4 + wc);
    }
};
constexpr float ACT_FP8_SCALE = 8.0f;
template <class Sched> struct EpiSwiGLU {
    static constexpr bool PERM = true;
    const float* ssx; bf16* ACT; const Sched* S; bool moe; const float* rsc; const float* wsc; unsigned char* ACT8;
    __device__ __forceinline__ void operator()(Acc& acc, const Unit& u, int wr, int wc, int fr, int fq, LAS unsigned char* lds, int tid) const {
        asm volatile("" : "+v"(fr), "+v"(fq), "+v"(tid));
        const int rl0 = wr * 64 + fr, cl = wc * 32 + 8 * fq;
        if (!moe) fill_row_table<32>(lds, RK_OFF, ssx, (size_t)u.pm * BM, tid, 1.0f / DM, true);
        float rsv[2][4];
#pragma unroll
        for (int ai = 0; ai < 2; ++ai)
#pragma unroll
            for (int m = 0; m < 4; ++m) { const int rl = rl0 + ai * HALF + m * 16; rsv[ai][m] = moe ? rsc[(size_t)u.e * SEQ + (u.pm - u.p0) * BM + rl] : 0.f; }
        if (!moe) lds_r32x8(lds_addr(lds, RK_OFF) + rl0 * 4, rsv);
        const float wse = moe ? wsc[u.e] : 1.0f;
#pragma unroll
        for (int ai = 0; ai < 2; ++ai)
#pragma unroll
            for (int m = 0; m < 4; ++m) { const int rl = rl0 + ai * HALF + m * 16;
                const float rs = rsv[ai][m] * wse;
                f32x4 o[2];
#pragma unroll
                for (int n = 0; n < 2; ++n) { const f32x4 gg = acc[ai][0][m][n] * rs, uu = acc[ai][1][m][n] * rs;
#pragma unroll
                    for (int e = 0; e < 4; ++e) o[n][e] = gg[e] * sigmoidf_(gg[e]) * uu[e]; }
                if (ACT8) { int w0 = 0, w1 = 0; w0 = __builtin_amdgcn_cvt_pk_fp8_f32(o[0][0] * ACT_FP8_SCALE, o[0][1] * ACT_FP8_SCALE, w0, false); w0 = __builtin_amdgcn_cvt_pk_fp8_f32(o[0][2] * ACT_FP8_SCALE, o[0][3] * ACT_FP8_SCALE, w0, true);
                    w1 = __builtin_amdgcn_cvt_pk_fp8_f32(o[1][0] * ACT_FP8_SCALE, o[1][1] * ACT_FP8_SCALE, w1, false); w1 = __builtin_amdgcn_cvt_pk_fp8_f32(o[1][2] * ACT_FP8_SCALE, o[1][3] * ACT_FP8_SCALE, w1, true);
                    *(u32x2*)(ACT8 + (size_t)(u.pm * BM + rl) * DFF + u.pn * HALF + cl) = (u32x2){(unsigned)w0, (unsigned)w1}; }
                else *(u32x4*)(ACT + (size_t)(u.pm * BM + rl) * DFF + u.pn * HALF + cl) = pack8(o[0], o[1]); }
    }
};
struct EpiMoeDown {
    static constexpr bool PERM = true;
    bf16* YM; const float* dsc; const float* rsc2;
    __device__ __forceinline__ void operator()(Acc& acc, const Unit& u, int wr, int wc, int fr, int fq, LAS unsigned char* lds, int tid) const {
        asm volatile("" : "+v"(fr), "+v"(fq), "+v"(tid));
        const int rl0 = wr * 64 + fr, cl = wc * 32 + 8 * fq;
        bf16* dst = YM + (size_t)u.ks * ACT_ROWS * DM; const float ds = dsc[u.e];
        float r2v[2][4];
#pragma unroll
        for (int ai = 0; ai < 2; ++ai)
#pragma unroll
            for (int m = 0; m < 4; ++m) r2v[ai][m] = rsc2[(size_t)(u.pm * BM + rl0 + ai * HALF + m * 16)];
#pragma unroll
        for (int ai = 0; ai < 2; ++ai)
#pragma unroll
            for (int m = 0; m < 4; ++m) { const size_t row = (size_t)(u.pm * BM + rl0 + ai * HALF + m * 16); bf16* rp = dst + row * DM + u.pn * BM + cl; const float dr = ds * r2v[ai][m];
#pragma unroll
                for (int bj = 0; bj < 2; ++bj) *(u32x4*)(rp + bj * HALF) = pack8(acc[ai][bj][m][0] * dr, acc[ai][bj][m][1] * dr); }
    }
};
}
namespace attn {
constexpr int A_KOFF = 0, A_VOFF = 65536, A_WS = 114688, A_POSK = 116736, A_LIST = 117248;
__device__ __forceinline__ int v_st(int k, int c) { const int kk = (k & ~0xC) | ((k & 4) << 1) | ((k & 8) >> 1); return ((kk >> 3) * 4 + (c >> 5)) * 512 + ((kk & 7) * 32 + (c & 31)) * 2; }
__device__ __forceinline__ int v_rd_base(int lane) { return ((lane & 3) << 3) | (((lane >> 2) & 3) << 6) | (((lane >> 4) & 1) << 5) | (((lane >> 5) & 1) << 8); }
constexpr int v_rd_off(int d0, int ks, int half) { return d0 * 512 + ks * 4096 + half * 2048; }
__device__ __forceinline__ int crow(int r, int hi) { return (r & 3) + 8 * (r >> 2) + 4 * hi; }
__device__ __forceinline__ void glds16(const void* gsrc, unsigned lds_dst) { unsigned keep;
    asm volatile("s_mov_b32 %0, m0\n\ts_mov_b32 m0, %2\n\ts_nop 0\n\tglobal_load_lds_dwordx4 %1, off\n\ts_mov_b32 m0, %0" : "=&s"(keep) : "v"(gsrc), "s"(lds_dst) : "memory"); }

template <int VBOFF>
__device__ __forceinline__ void pv_tile(f32x16* o, int vb0, bf16x8 pa0, bf16x8 pa1, bf16x8 pa2, bf16x8 pa3) {
#define TRRD(dst, off) asm volatile("ds_read_b64_tr_b16 %0, %1 offset:%2" : "=&v"(dst) : "v"(vb0), "i"(off) : "memory")
#define PV_RD(S, d0) do { constexpr int b_ = VBOFF + v_rd_off(d0, 0, 0); \
        TRRD(l##S[0], b_); TRRD(h##S[0], b_ + 2048); TRRD(l##S[1], b_ + 4096); TRRD(h##S[1], b_ + 6144); TRRD(l##S[2], b_ + 8192); TRRD(h##S[2], b_ + 10240); TRRD(l##S[3], b_ + 12288); TRRD(h##S[3], b_ + 14336); } while (0)
#define PV_MM(S, d0) do { \
        o[d0] = __builtin_amdgcn_mfma_f32_32x32x16_bf16(pa0, (bf16x8){l##S[0][0], l##S[0][1], l##S[0][2], l##S[0][3], h##S[0][0], h##S[0][1], h##S[0][2], h##S[0][3]}, o[d0], 0, 0, 0);   \
        o[d0] = __builtin_amdgcn_mfma_f32_32x32x16_bf16(pa1, (bf16x8){l##S[1][0], l##S[1][1], l##S[1][2], l##S[1][3], h##S[1][0], h##S[1][1], h##S[1][2], h##S[1][3]}, o[d0], 0, 0, 0);   \
        o[d0] = __builtin_amdgcn_mfma_f32_32x32x16_bf16(pa2, (bf16x8){l##S[2][0], l##S[2][1], l##S[2][2], l##S[2][3], h##S[2][0], h##S[2][1], h##S[2][2], h##S[2][3]}, o[d0], 0, 0, 0);   \
        o[d0] = __builtin_amdgcn_mfma_f32_32x32x16_bf16(pa3, (bf16x8){l##S[3][0], l##S[3][1], l##S[3][2], l##S[3][3], h##S[3][0], h##S[3][1], h##S[3][2], h##S[3][3]}, o[d0], 0, 0, 0); } while (0)
#define PV_W(n) do { asm volatile("s_waitcnt lgkmcnt(" #n ")" ::: "memory"); SBAR(); } while (0)
    s16x4 lA[4], hA[4], lB[4], hB[4];
    PV_RD(A, 0); PV_RD(B, 1); PV_W(8); PV_MM(A, 0); SBAR();
    PV_RD(A, 2); PV_W(8); PV_MM(B, 1); SBAR();
    PV_RD(B, 3); PV_W(8); PV_MM(A, 2); SBAR();
    PV_W(0); PV_MM(B, 3);
#undef PV_W
#undef PV_MM
#undef PV_RD
#undef TRRD
}

template <int DQ, bool CAUSAL, int qstride, int vstride, int ostride, bool QREG, class CV>
__device__ __forceinline__ void attn_item(CV& cv, char* lds, LAS unsigned char* ldsl, const bf16* Qb, const bf16* Kh, const bf16* Vh, bf16* Ob,
                                          const int* pos, int q0, int nkt, const int* tmin, const int* tmax) {
    constexpr int KSTR = DQ * 2, KBYTES = 64 * KSTR, NCH = DQ / 64, CPR = DQ / 8, ND0 = DQ / 16;
#define KSW(r) (DQ == 192 ? (((r) >> 1) & 7) : ((r) & 7))
    const int tid = fresh_tid(), wid = __builtin_amdgcn_readfirstlane(tid >> 6), lane = tid & 63, r32 = lane & 31, hi = lane >> 5;
    char* K_lds = lds + A_KOFF; char* V_lds = lds + A_VOFF;
    float* wsf = (float*)(lds + A_WS) + wid * 64; float* li_l = wsf; float* al_l = wsf + 32;
    int* posk = (int*)(lds + A_POSK); int* tlist = (int*)(lds + A_LIST); int* tmxl = tlist + 132;
    int NT = nkt;
    if constexpr (CAUSAL) {
        if (wid == 0) {
            const int qt = q0 >> 6; int qmax = tmax[qt]; qmax = max(qmax, tmax[qt + 1]); qmax = max(qmax, tmax[qt + 2]); qmax = max(qmax, tmax[qt + 3]);
            const bool n0 = lane < nkt && tmin[lane] <= qmax, n1 = lane + 64 < nkt && tmin[lane + 64] <= qmax;
            const unsigned long long b0 = __ballot(n0), b1 = __ballot(n1); const int c0 = __popcll(b0);
            const unsigned long long below = (lane == 0) ? 0ull : (~0ull >> (64 - lane));
            if (n0) { const int ix = __popcll(b0 & below); tlist[ix] = lane; tmxl[ix] = tmax[lane]; }
            if (n1) { const int ix = c0 + __popcll(b1 & below); tlist[ix] = lane + 64; tmxl[ix] = tmax[lane + 64]; }
            if (lane == 0) tlist[128] = c0 + __popcll(b1);
        }
        __syncthreads();
        NT = tlist[128];
    }
#define TILE(t) (CAUSAL ? __builtin_amdgcn_readfirstlane(tlist[t]) : (t))
    int ksrc[NCH], vsrc[2];
#pragma unroll
    for (int jj = 0; jj < NCH; ++jj) { const int p = jj * 512 + tid, row = p / CPR, cs = p % CPR, cc = (cs & ~7) | ((cs & 7) ^ KSW(row)); ksrc[jj] = row * DQ + cc * 8; }
#pragma unroll
    for (int jj = 0; jj < 2; ++jj) { const int p = jj * 512 + tid, kk = (p >> 7) * 8 + ((p & 31) >> 2), k = (kk & ~0xC) | ((kk & 4) << 1) | ((kk & 8) >> 1), cv = ((p >> 5) & 3) * 32 + (p & 3) * 8; vsrc[jj] = k * vstride + cv; }
    int stP = 0;
    const unsigned ldsbase = (unsigned)__builtin_amdgcn_readfirstlane((int)(unsigned)(size_t)ldsl + wid * 1024);
#define A_STAGE(tile_, bf, vbf) do { const int kb_ = (tile_) * 64; \
        _Pragma("unroll") for (int jj = 0; jj < NCH; ++jj) glds16(Kh + (size_t)kb_ * DQ + ksrc[jj], ldsbase + A_KOFF + (bf) * KBYTES + jj * 8192); \
        _Pragma("unroll") for (int jj = 0; jj < 2; ++jj) glds16(Vh + (size_t)kb_ * vstride + vsrc[jj], ldsbase + A_VOFF + (vbf) * 16384 + jj * 8192); \
        if (CAUSAL && tid < 64) stP = pos[kb_ + tid]; } while (0)
#define A_POSW(bf) do { if (CAUSAL && tid < 64) posk[(bf) * 64 + tid] = stP; } while (0)
    A_STAGE(TILE(0), 0, 0);
    bf16x8 qr[QREG ? ND0 : 1];
    if constexpr (QREG) {
#pragma unroll
        for (int d0 = 0; d0 < ND0; ++d0) qr[d0] = *(const bf16x8*)(Qb + (size_t)(wid * 32 + r32) * qstride + d0 * 16 + hi * 8); }
    int wminq = 0;
    if constexpr (CAUSAL) { int v = pos[q0 + wid * 32 + r32];
#pragma unroll
        for (int o_ = 1; o_ < 32; o_ <<= 1) v = min(v, __shfl_xor(v, o_));
        wminq = __builtin_amdgcn_readfirstlane(v); }
    A_POSW(0);
    asm volatile("s_waitcnt vmcnt(0)" ::: "memory");
    if constexpr (QREG) {
#pragma unroll
        for (int d0 = 0; d0 < ND0; ++d0) asm volatile("" : "+v"(qr[d0]));
    }
    __syncthreads();
    float m_reg = -1e30f, l_reg = 0.f; f32x16 o[4] = {};
    const int vb0 = (int)(uintptr_t)V_lds + v_rd_base(lane);
    int kbv[4];
#pragma unroll
    for (int dd = 0; dd < 4; ++dd) kbv[dd] = r32 * KSTR + (((dd * 2 + hi) ^ KSW(r32)) << 4);
    bf16x8 pa0 = {}, pa1 = {}, pa2 = {}, pa3 = {};
    int vcur = 0;
    if (wid >= 4) __builtin_amdgcn_s_setprio(1);
#define PK4(P, B_, OUT) do { unsigned a0 = cvt_pk_bf16(P[B_+0], P[B_+1]), a1 = cvt_pk_bf16(P[B_+2], P[B_+3]); \
        unsigned b0 = cvt_pk_bf16(P[B_+4], P[B_+5]), b1 = cvt_pk_bf16(P[B_+6], P[B_+7]); \
        auto r0 = __builtin_amdgcn_permlane32_swap(a0, b0, false, false); auto r1 = __builtin_amdgcn_permlane32_swap(a1, b1, false, false); \
        u32x4 w = {r0[0], r1[0], r0[1], r1[1]}; OUT = *reinterpret_cast<bf16x8*>(&w); } while (0)
#define SM_SLICE(b_) do { \
        if ((b_) == 0) { pmax_ = p0[0]; _Pragma("unroll") for (int r = 1; r < 16; ++r) pmax_ = fmaxf(pmax_, p0[r]); _Pragma("unroll") for (int r = 0; r < 16; ++r) pmax_ = fmaxf(pmax_, p1[r]); } \
        else if ((b_) == 1) { auto rr = __builtin_amdgcn_permlane32_swap(__float_as_uint(pmax_), __float_as_uint(pmax_), false, false); pmax_ = fmaxf(__uint_as_float(rr[0]), __uint_as_float(rr[1])); \
            const bool keep_ = __all(pmax_ - m_reg <= 8.0f); mn_ = keep_ ? m_reg : fmaxf(m_reg, pmax_); alpha_ = keep_ ? 1.0f : __builtin_amdgcn_exp2f(m_reg - mn_); m_reg = mn_; \
            _Pragma("unroll") for (int r = 0; r < 16; ++r) { p0[r] = __builtin_amdgcn_exp2f(p0[r] - mn_); ps_ += p0[r]; } } \
        else if ((b_) == 2) { _Pragma("unroll") for (int r = 0; r < 16; ++r) { p1[r] = __builtin_amdgcn_exp2f(p1[r] - mn_); ps_ += p1[r]; } } \
        else { auto rr = __builtin_amdgcn_permlane32_swap(__float_as_uint(ps_), __float_as_uint(ps_), false, false); l_reg = l_reg * alpha_ + (__uint_as_float(rr[0]) + __uint_as_float(rr[1])); } } while (0)
#define TRRD(dst, off) asm volatile("ds_read_b64_tr_b16 %0, %1 offset:%2" : "=&v"(dst) : "v"(vbx_), "i"(off) : "memory")
#define PV_RD(S, d0) do { constexpr int b_ = v_rd_off(d0, 0, 0); \
        TRRD(l##S[0], b_); TRRD(h##S[0], b_ + 2048); TRRD(l##S[1], b_ + 4096); TRRD(h##S[1], b_ + 6144); TRRD(l##S[2], b_ + 8192); TRRD(h##S[2], b_ + 10240); TRRD(l##S[3], b_ + 12288); TRRD(h##S[3], b_ + 14336); } while (0)
#define PV_MM(S, d0) do { \
        o[d0] = __builtin_amdgcn_mfma_f32_32x32x16_bf16(pa0, (bf16x8){l##S[0][0], l##S[0][1], l##S[0][2], l##S[0][3], h##S[0][0], h##S[0][1], h##S[0][2], h##S[0][3]}, o[d0], 0, 0, 0);   \
        o[d0] = __builtin_amdgcn_mfma_f32_32x32x16_bf16(pa1, (bf16x8){l##S[1][0], l##S[1][1], l##S[1][2], l##S[1][3], h##S[1][0], h##S[1][1], h##S[1][2], h##S[1][3]}, o[d0], 0, 0, 0);   \
        o[d0] = __builtin_amdgcn_mfma_f32_32x32x16_bf16(pa2, (bf16x8){l##S[2][0], l##S[2][1], l##S[2][2], l##S[2][3], h##S[2][0], h##S[2][1], h##S[2][2], h##S[2][3]}, o[d0], 0, 0, 0);   \
        o[d0] = __builtin_amdgcn_mfma_f32_32x32x16_bf16(pa3, (bf16x8){l##S[3][0], l##S[3][1], l##S[3][2], l##S[3][3], h##S[3][0], h##S[3][1], h##S[3][2], h##S[3][3]}, o[d0], 0, 0, 0); } while (0)
#define PV_W(n) do { asm volatile("s_waitcnt lgkmcnt(" #n ")" ::: "memory"); SBAR(); } while (0)
#define TILE_ITER(DOPV_) do { \
        const int buf = t & 1; \
        const int vnext = vcur == 2 ? 0 : vcur + 1, vprev = vcur == 0 ? 2 : vcur - 1; \
        cv.finish();                                                   \
        if (t + 1 < NT) { if (buf == 0) A_STAGE(TILE(t + 1), 1, vnext); else A_STAGE(TILE(t + 1), 0, vnext); } \
        cv.issue();                                                    \
        SBAR(); \
        f32x16 p0 = {}, p1 = {}; \
        { const char* kb_ = K_lds + buf * KBYTES; int qo = (wid * 32 + r32) * qstride + hi * 8; if (!QREG) asm volatile("" : "+v"(qo)); \
          bf16x8 ka[2][2];                                             \
          bf16x8 qn_ = {}; if constexpr (!QREG) qn_ = *(const bf16x8*)(Qb + qo);        \
          KRD(0); SBAR(); \
          _Pragma("unroll") for (int d0 = 0; d0 < ND0; ++d0) { \
              if (d0 + 1 < ND0) KRD(d0 + 1); \
              bf16x8 qf; if constexpr (QREG) qf = qr[d0]; else { qf = qn_; if (d0 + 1 < ND0) qn_ = *(const bf16x8*)(Qb + qo + (d0 + 1) * 16); } \
              SBAR(); \
              p0 = __builtin_amdgcn_mfma_f32_32x32x16_bf16(ka[d0 & 1][0], qf, p0, 0, 0, 0); \
              p1 = __builtin_amdgcn_mfma_f32_32x32x16_bf16(ka[d0 & 1][1], qf, p1, 0, 0, 0); SBAR(); } } \
        if constexpr (CAUSAL) { \
            if (__builtin_amdgcn_readfirstlane(tmxl[t]) > wminq) {                         \
                const float NEG = -__builtin_inff(); const int* pk = posk + buf * 64 + 4 * hi; const int posq = pos[q0 + wid * 32 + (fresh_tid() & 31)];        \
                _Pragma("unroll") for (int g = 0; g < 4; ++g) { const int4 k0 = *(const int4*)(pk + 8 * g), k1 = *(const int4*)(pk + 32 + 8 * g); \
                    if (k0.x > posq) p0[4 * g + 0] = NEG; if (k0.y > posq) p0[4 * g + 1] = NEG; if (k0.z > posq) p0[4 * g + 2] = NEG; if (k0.w > posq) p0[4 * g + 3] = NEG; \
                    if (k1.x > posq) p1[4 * g + 0] = NEG; if (k1.y > posq) p1[4 * g + 1] = NEG; if (k1.z > posq) p1[4 * g + 2] = NEG; if (k1.w > posq) p1[4 * g + 3] = NEG; } \
            } } \
        SBAR(); \
        float pmax_ = 0.f, mn_ = 0.f, alpha_ = 1.f, ps_ = 0.f; \
        if (DOPV_) { const int vbx_ = vb0 + vprev * 16384; s16x4 lA[4], hA[4], lB[4], hB[4]; \
            PV_RD(A, 0); PV_RD(B, 1); PV_W(8); PV_MM(A, 0); SM_SLICE(0); SBAR(); \
            PV_RD(A, 2); PV_W(8); PV_MM(B, 1); SM_SLICE(1); SBAR(); \
            PV_RD(B, 3); PV_W(8); PV_MM(A, 2); SM_SLICE(2); SBAR(); \
            PV_W(0); PV_MM(B, 3); SM_SLICE(3); SBAR(); } \
        else { SM_SLICE(0); SM_SLICE(1); SM_SLICE(2); SM_SLICE(3); SBAR(); } \
        if (__any(alpha_ < 1.f)) { if (hi == 0) al_l[r32] = alpha_; asm volatile("s_waitcnt lgkmcnt(0)" ::: "memory"); \
            _Pragma("unroll") for (int r = 0; r < 16; ++r) { const float a = al_l[crow(r, hi)]; \
                _Pragma("unroll") for (int d_ = 0; d_ < 4; ++d_) o[d_][r] *= a; } } \
        PK4(p0, 0, pa0); PK4(p0, 8, pa1); PK4(p1, 0, pa2); PK4(p1, 8, pa3);        \
        SBAR(); \
        vcur = vnext; \
        if (t + 1 < NT) { if (buf == 0) A_POSW(1); else A_POSW(0); } \
        if (cv.pending()) asm volatile("s_waitcnt vmcnt(16)" ::: "memory"); else asm volatile("s_waitcnt vmcnt(0)" ::: "memory");        \
        __syncthreads(); } while (0)
#define KRD(d0_) do { const char* a_ = kb_ + kbv[(d0_) & 3] + ((d0_) >> 2) * 128; ka[(d0_) & 1][0] = *(const bf16x8*)a_; ka[(d0_) & 1][1] = *(const bf16x8*)(a_ + 32 * KSTR); } while (0)
    { const int t = 0; TILE_ITER(false); }
    for (int t = 1; t < NT; ++t) TILE_ITER(true);
    {
        const int vlast = vcur == 0 ? 2 : vcur - 1; const int vbx_ = vb0 + vlast * 16384; s16x4 lA[4], hA[4], lB[4], hB[4];
        PV_RD(A, 0); PV_RD(B, 1); PV_W(8); PV_MM(A, 0); SBAR();
        PV_RD(A, 2); PV_W(8); PV_MM(B, 1); SBAR();
        PV_RD(B, 3); PV_W(8); PV_MM(A, 2); SBAR();
        PV_W(0); PV_MM(B, 3); }
#undef KRD
#undef TILE_ITER
#undef PV_W
#undef PV_MM
#undef PV_RD
#undef TRRD
#undef SM_SLICE
#undef PK4
    __builtin_amdgcn_s_setprio(0);
    if (hi == 0) li_l[r32] = l_reg; asm volatile("s_waitcnt lgkmcnt(0)" ::: "memory");
    int oofs = (wid * 32 + 4 * hi) * ostride + r32; asm volatile("" : "+v"(oofs));
    bf16* Ow = Ob + oofs;
#pragma unroll
    for (int r = 0; r < 16; ++r) { constexpr int dummy = 0; (void)dummy; const int orow = crow(r, hi); const float rl = __builtin_amdgcn_rcpf(li_l[orow]);
#pragma unroll
        for (int d0 = 0; d0 < 4; ++d0) { const float v = o[d0][r] * rl; const float vn = __shfl_xor(v, 1);
            if ((r32 & 1) == 0) *(unsigned*)(Ow + ((r & 3) + 8 * (r >> 2)) * ostride + d0 * 32) = cvt_pk_bf16(v, vn); } }
    __syncthreads();
#undef A_STAGE
#undef A_POSW
#undef KSW
#undef TILE
}
}
namespace s5 {
constexpr int TROW = 136;
constexpr int WAVE_LDS = 32 * TROW * 2;
__device__ __forceinline__ void cmul(float ar, float ai, float br, float bi, float& cr, float& ci) { cr = ar * br - ai * bi; ci = ar * bi + ai * br; }
__device__ __forceinline__ float gelu_tanh(float x) { const float z = 1.5957691216057308f * (x + 0.044715f * x * x * x); return x * sigmoidf_(z); }

template <int PART>
__device__ __forceinline__ void s5_wave(char* ldsw, int g, int c0, const bf16* U, const f32x2* LAM, const bf16* BB, const bf16* CP, const float* Dd, float* ES, bf16* YS, int lane) {
    const int c = lane & 31, hi = lane >> 5;
    float l1r[2], l1i[2], l2r[2], l2i[2], l3r[2], l3i[2], l4r[2], l4i[2];
    bf16x8 bfrag[2][2];
#pragma unroll
    for (int sb = 0; sb < 2; ++sb) { const f32x2 lm = LAM[g * 64 + 32 * sb + c]; l1r[sb] = lm.x; l1i[sb] = lm.y;
        cmul(l1r[sb], l1i[sb], l1r[sb], l1i[sb], l2r[sb], l2i[sb]); cmul(l2r[sb], l2i[sb], l1r[sb], l1i[sb], l3r[sb], l3i[sb]); cmul(l2r[sb], l2i[sb], l2r[sb], l2i[sb], l4r[sb], l4i[sb]);
#pragma unroll
        for (int ri = 0; ri < 2; ++ri) bfrag[sb][ri] = *(const bf16x8*)(BB + ((size_t)(g * 128 + 64 * ri + 32 * sb + c)) * 16 + 8 * hi); }
    float sr[2] = {0.f, 0.f}, si[2] = {0.f, 0.f};
    bf16x8 cpf[8];
    if constexpr (PART == 2) {
        float l64r[2], l64i[2];
#pragma unroll
        for (int sb = 0; sb < 2; ++sb) { float ar = l4r[sb], ai = l4i[sb];
#pragma unroll
            for (int k = 0; k < 4; ++k) { float tr, ti; cmul(ar, ai, ar, ai, tr, ti); ar = tr; ai = ti; }
            l64r[sb] = ar; l64i[sb] = ai; }
        for (int cc = 0; cc < c0; ++cc) { const float* e = ES + ((size_t)g * 128 + cc) * 128;
#pragma unroll
            for (int sb = 0; sb < 2; ++sb) { const float er = e[32 * sb + c], ei = e[64 + 32 * sb + c]; float tr, ti; cmul(l64r[sb], l64i[sb], sr[sb], si[sb], tr, ti); sr[sb] = tr + er; si[sb] = ti + ei; } }
#pragma unroll
        for (int ks = 0; ks < 8; ++ks) { cpf[ks] = (bf16x8){0, 0, 0, 0, 0, 0, 0, 0}; if (c < 16) cpf[ks] = *(const bf16x8*)(CP + ((size_t)(g * 16 + c)) * 128 + 16 * ks + 8 * hi); }
    }
    bf16* T = (bf16*)ldsw;
    bf16x8 afn = *(const bf16x8*)(U + (size_t)(c0 * 2 * 32 + c) * S5W + g * 16 + 8 * hi);
    f32x4 da = {}, db = {};
    if constexpr (PART == 2) { da = *(const f32x4*)(Dd + g * 16 + 4 * hi); db = *(const f32x4*)(Dd + g * 16 + 8 + 4 * hi); }
    for (int blk = 0; blk < 8; ++blk) {
        const int t0 = (c0 * 2 + blk) * 32;
        if (PART == 1 && (blk & 1) == 0) { sr[0] = 0.f; si[0] = 0.f; sr[1] = 0.f; si[1] = 0.f; }
        const bf16x8 af = afn;
        if (blk + 1 < 8) afn = *(const bf16x8*)(U + (size_t)(t0 + 32 + c) * S5W + g * 16 + 8 * hi);
#pragma unroll
        for (int sb = 0; sb < 2; ++sb) {
            f32x16 br = {}, bi = {};
            br = __builtin_amdgcn_mfma_f32_32x32x16_bf16(af, bfrag[sb][0], br, 0, 0, 0);
            bi = __builtin_amdgcn_mfma_f32_32x32x16_bf16(af, bfrag[sb][1], bi, 0, 0, 0);
#pragma unroll
            for (int q4 = 0; q4 < 4; ++q4)
#pragma unroll
                for (int k = 1; k < 4; ++k) { const int r = 4 * q4 + k; float tr, ti; cmul(l1r[sb], l1i[sb], br[r - 1], bi[r - 1], tr, ti); br[r] += tr; bi[r] += ti; }
            float per[4], pei[4];
#pragma unroll
            for (int q4 = 0; q4 < 4; ++q4) { per[q4] = __shfl_xor(br[4 * q4 + 3], 32); pei[q4] = __shfl_xor(bi[4 * q4 + 3], 32); }
            float cr = sr[sb], ci = si[sb], cinr[4], cini[4];
#pragma unroll
            for (int q = 0; q < 8; ++q) { const bool own = ((q & 1) == hi); const int q4 = q >> 1;
                if ((q & 1) == 0) { if (hi == 0) { cinr[q4] = cr; cini[q4] = ci; } } else { if (hi == 1) { cinr[q4] = cr; cini[q4] = ci; } }
                const float er = own ? br[4 * q4 + 3] : per[q4], ei = own ? bi[4 * q4 + 3] : pei[q4];
                float tr, ti; cmul(l4r[sb], l4i[sb], cr, ci, tr, ti); cr = tr + er; ci = ti + ei; }
            sr[sb] = cr; si[sb] = ci;
            if constexpr (PART == 2) {
#pragma unroll
                for (int q4 = 0; q4 < 4; ++q4) { float tr, ti;
                    cmul(l1r[sb], l1i[sb], cinr[q4], cini[q4], tr, ti); br[4 * q4 + 0] += tr; bi[4 * q4 + 0] += ti;
                    cmul(l2r[sb], l2i[sb], cinr[q4], cini[q4], tr, ti); br[4 * q4 + 1] += tr; bi[4 * q4 + 1] += ti;
                    cmul(l3r[sb], l3i[sb], cinr[q4], cini[q4], tr, ti); br[4 * q4 + 2] += tr; bi[4 * q4 + 2] += ti;
                    cmul(l4r[sb], l4i[sb], cinr[q4], cini[q4], tr, ti); br[4 * q4 + 3] += tr; bi[4 * q4 + 3] += ti; }
#pragma unroll
                for (int r = 0; r < 16; ++r) { const int tok = (r & 3) + 8 * (r >> 2) + 4 * hi;
                    T[tok * TROW + 32 * sb + c] = (bf16)f2bf(br[r]); T[tok * TROW + 64 + 32 * sb + c] = (bf16)f2bf(bi[r]); }
            }
        }
        if constexpr (PART == 1) {
            if ((blk & 1) == 1 && hi == 0) { float* e = ES + ((size_t)g * 128 + c0 + (blk >> 1)) * 128;
#pragma unroll
                for (int sb = 0; sb < 2; ++sb) { e[32 * sb + c] = sr[sb]; e[64 + 32 * sb + c] = si[sb]; } }
        } else {
            asm volatile("s_waitcnt lgkmcnt(0)" ::: "memory"); __builtin_amdgcn_wave_barrier(); asm volatile("" ::: "memory");
            f32x16 acc = {};
#pragma unroll
            for (int ks = 0; ks < 8; ++ks) { const bf16x8 sfrag = *(const bf16x8*)(T + c * TROW + 16 * ks + 8 * hi);
                acc = __builtin_amdgcn_mfma_f32_32x32x16_bf16(cpf[ks], sfrag, acc, 0, 0, 0); }
            const size_t ro = (size_t)(t0 + c) * S5W + g * 16;
            const f32x4 ua = pg8::unpack4(*(const u32x2*)(U + ro + 4 * hi)), ub = pg8::unpack4(*(const u32x2*)(U + ro + 8 + 4 * hi));
            f32x4 ya, yb;
#pragma unroll
            for (int e = 0; e < 4; ++e) { ya[e] = gelu_tanh(acc[e] + da[e] * ua[e]); yb[e] = gelu_tanh(acc[4 + e] + db[e] * ub[e]); }
            *(u32x2*)(YS + ro + 4 * hi) = pg8::pack4(ya); *(u32x2*)(YS + ro + 8 + 4 * hi) = pg8::pack4(yb);
            asm volatile("" ::: "memory"); __builtin_amdgcn_wave_barrier();
        }
    }
}
}
struct MapId   { __device__ __forceinline__ int operator()(int n) const { return n; } };
struct MapInProj { __device__ __forceinline__ int operator()(int n) const { return n < 1472 ? n : (n < 1536 ? -1 : (n < 2112 ? n - 64 : (n < 2304 ? -1 : n - 256))); } };
struct MapGlu  { int half; __device__ __forceinline__ int operator()(int n) const { const int j = n >> 8, r = n & 255; return r < 128 ? 128 * j + r : half + 128 * j + (r - 128); } };
struct MapQB   { __device__ __forceinline__ int operator()(int n) const { const int h = n >> 8, j = n & 255; if (j < 128) return 192 * h + j; if (j >= 192) return -1; const int jj = j - 128; return 192 * h + 128 + 32 * (jj & 1) + (jj >> 1); } };

template <class Map>
__device__ __forceinline__ void transpose_item(const float* W, int N, int K, bf16* WT, int Kd, const float* gain, const Map& map, LAS float* scr, int kb, int nb, int lane) {
    const int k0 = 64 * kb, n0 = 64 * nb; const int scol = map(n0 + lane);
    const bool kin = k0 < K;
    float v[64];
    const float* src = W + (size_t)k0 * N + (scol >= 0 ? scol : 0);
    if (kin && scol >= 0) {
#pragma unroll
        for (int kk = 0; kk < 64; ++kk) v[kk] = __builtin_nontemporal_load(src + (size_t)kk * N);
        if (gain) {
#pragma unroll
            for (int kk = 0; kk < 64; ++kk) v[kk] *= gain[k0 + kk];
        }
    } else {
#pragma unroll
        for (int kk = 0; kk < 64; ++kk) v[kk] = 0.f;
    }
    LAS unsigned char* sb = (LAS unsigned char*)scr;
#pragma unroll
    for (int c = 0; c < 8; ++c) { u32x4 o; o.x = cvt_pk_bf16(v[8 * c], v[8 * c + 1]); o.y = cvt_pk_bf16(v[8 * c + 2], v[8 * c + 3]); o.z = cvt_pk_bf16(v[8 * c + 4], v[8 * c + 5]); o.w = cvt_pk_bf16(v[8 * c + 6], v[8 * c + 7]);
        *(LAS u32x4*)(sb + lane * 144 + c * 16) = o; }
    const int rr = lane >> 3, cc = lane & 7;
#pragma unroll
    for (int i = 0; i < 8; ++i) { const u32x4 w = *(const LAS u32x4*)(sb + (8 * i + rr) * 144 + cc * 16);
        *(GAS u32x4*)(WT + (size_t)(n0 + 8 * i + rr) * Kd + k0 + 8 * cc) = w; }
}
template <class Map>
__device__ __forceinline__ void transpose_item_i8(const float* W, int N, signed char* WT, int Kd, const float* gain, float inv_step, const Map& map, int kb, int nb, int lane, bool nostore = false) {
    const int k0 = 64 * kb, n0 = 64 * nb; const int scol = map(n0 + lane);
    float v[64];
    const float* src = W + (size_t)k0 * N + scol;
#pragma unroll
    for (int kk = 0; kk < 64; ++kk) v[kk] = __builtin_nontemporal_load(src + (size_t)kk * N);
    signed char* dst = WT + (size_t)(n0 + lane) * Kd + k0;
#pragma unroll
    for (int c = 0; c < 4; ++c) { u32x4 o;
#pragma unroll
        for (int d = 0; d < 4; ++d) { unsigned w = 0;
#pragma unroll
            for (int b = 0; b < 4; ++b) { const int kk = 16 * c + 4 * d + b; const float q = fminf(fmaxf(rintf(v[kk] * (gain ? gain[k0 + kk] : 1.0f) * inv_step), -127.f), 127.f); w |= ((unsigned)(int)q & 0xffu) << (8 * b); }
            o[d] = w; }
        if (nostore) asm volatile("" :: "v"(o)); else *(GAS u32x4*)(dst + 16 * c) = o; }
}
__device__ __forceinline__ void transpose_item_f8(const float* W, int N, unsigned char* WT, int Kd, float scale, int kb, int nb, int lane) {
    const int k0 = 64 * kb, n0 = 64 * nb;
    float v[64];
    const float* src = W + (size_t)k0 * N + n0 + lane;
#pragma unroll
    for (int kk = 0; kk < 64; ++kk) v[kk] = __builtin_nontemporal_load(src + (size_t)kk * N);
    unsigned char* dst = WT + (size_t)(n0 + lane) * Kd + k0;
#pragma unroll
    for (int c = 0; c < 4; ++c) { u32x4 o;
#pragma unroll
        for (int d = 0; d < 4; ++d) { const int kk = 16 * c + 4 * d; int w = 0; w = __builtin_amdgcn_cvt_pk_fp8_f32(v[kk] * scale, v[kk + 1] * scale, w, false); w = __builtin_amdgcn_cvt_pk_fp8_f32(v[kk + 2] * scale, v[kk + 3] * scale, w, true); o[d] = (unsigned)w; }
        *(GAS u32x4*)(dst + 16 * c) = o; }
}
__device__ __forceinline__ float sample_step(const float* W, int N, int K, const float* gain, int lane, int ncols = 0) {
    float mx = 0.f; if (ncols == 0) ncols = N;
#pragma unroll
    for (int i = 0; i < 16; ++i) { const int k = (i * 131 + 7) % K, n = (lane * 211 + i * 1319) % ncols; mx = fmaxf(mx, fabsf(W[(size_t)k * N + n] * (gain ? gain[k] : 1.0f))); }
#pragma unroll
    for (int o = 1; o < 64; o <<= 1) mx = fmaxf(mx, __shfl_xor(mx, o));
    return fmaxf(mx, 1e-20f) * (2.0f / 127.0f);
}
__device__ __forceinline__ float sample_scale_f8(const float* W, int N, int K, int lane) {
    float mx = 0.f;
#pragma unroll
    for (int i = 0; i < 16; ++i) { const int k = (i * 131 + 7) % K, n = (lane * 211 + i * 1319) % N; mx = fmaxf(mx, fabsf(W[(size_t)k * N + n])); }
#pragma unroll
    for (int o = 1; o < 64; o <<= 1) mx = fmaxf(mx, __shfl_xor(mx, o));
    return exp2f(floorf(log2f(224.0f / fmaxf(mx, 1e-20f))));
}
template <class Map>
__device__ __forceinline__ void transpose_job(const float* W, size_t wstride, int N, int K, bf16* WT, size_t wtstride, int Kd, int Nd, const float* gain, int gstride, int ninst, const Map& map,
                                              LAS float* scr, int gw, int NGW, int lane) {
    const int nkb = Kd / 64, nnb = Nd / 64, per = nkb * nnb;
    for (int it = gw; it < per * ninst; it += NGW) { const int inst = it / per, r = it - inst * per, nb = r / nkb, kb = r - nb * nkb;
        transpose_item(W + (size_t)inst * wstride, N, K, WT + (size_t)inst * wtstride, Kd, gain ? gain + (size_t)inst * gstride : nullptr, map, scr, kb, nb, lane); }
}
__device__ __forceinline__ float row_to_bf16(const float* xrow, bf16* orow, bool normalize, int lane) {
    const GAS f32x4* xr = (const GAS f32x4*)xrow + lane;
    f32x4 v[8]; float s = 0.f;
#pragma unroll
    for (int j = 0; j < 8; ++j) { v[j] = xr[64 * j]; s += pg8::sq4(v[j]); }
    s = wave_sum(s);
    const float sc = normalize ? 1.0f / sqrtf(s * (1.0f / DM) + EPS) : 1.0f;
    GAS u32x2* o8 = (GAS u32x2*)orow + lane;
#pragma unroll
    for (int j = 0; j < 8; ++j) o8[64 * j] = pg8::pack4(v[j] * sc);
    return s;
}
__device__ __forceinline__ void router_token(const float* xrow, const float* gain, const float* R, const float* rb, int tok, unsigned* cnt, int* list, int* toke, int* toks, float* tokw, signed char* XQ, float* rscale, float* rss, int lane) {
    float lg[8] = {0.f, 0.f, 0.f, 0.f, 0.f, 0.f, 0.f, 0.f}; float ssq = 0.f, amax = 0.f;
#pragma unroll 2
    for (int j = 0; j < 8; ++j) { const int k0 = 256 * j + 4 * lane; const f32x4 xv = *(const f32x4*)(xrow + k0), gv = *(const f32x4*)(gain + k0); ssq += pg8::sq4(xv); { const f32x4 hv = xv * gv; amax = fmaxf(fmaxf(amax, fmaxf(fabsf(hv[0]), fabsf(hv[1]))), fmaxf(fabsf(hv[2]), fabsf(hv[3]))); }
#pragma unroll
        for (int e = 0; e < 4; ++e) { const float h = xv[e] * gv[e]; const f32x4 r0 = *(const f32x4*)(R + (size_t)(k0 + e) * 8), r1 = *(const f32x4*)(R + (size_t)(k0 + e) * 8 + 4);
            lg[0] += h * r0[0]; lg[1] += h * r0[1]; lg[2] += h * r0[2]; lg[3] += h * r0[3]; lg[4] += h * r1[0]; lg[5] += h * r1[1]; lg[6] += h * r1[2]; lg[7] += h * r1[3]; } }
    ssq = wave_sum(ssq); const float rstd = 1.0f / sqrtf(ssq * (1.0f / DM) + EPS);
#pragma unroll
    for (int o = 1; o < 64; o <<= 1) amax = fmaxf(amax, __shfl_xor(amax, o));
    amax = fmaxf(amax, 1e-20f);
    {
        const float qs = 127.0f / amax;
        f32x4 xg[8];
#pragma unroll
        for (int j = 0; j < 8; ++j) { const int k0 = 256 * j + 4 * lane; xg[j] = *(const f32x4*)(xrow + k0) * *(const f32x4*)(gain + k0); }
#pragma unroll
        for (int j = 0; j < 8; ++j) { const int k0 = 256 * j + 4 * lane; unsigned w = 0;
#pragma unroll
            for (int e = 0; e < 4; ++e) w |= ((unsigned)(int)rintf(xg[j][e] * qs) & 0xffu) << (8 * e);
            *(unsigned*)(XQ + (size_t)tok * DM + k0) = w; }
        if (lane == 0) rscale[tok] = rstd * amax * (1.0f / 127.0f);
    }
    const float rowscale = rstd * amax * (1.0f / 127.0f);
#pragma unroll
    for (int e = 0; e < 8; ++e) lg[e] = wave_sum(lg[e]) * rstd + rb[e];
    if (lane == 0) {
        int i1 = 0; float v1 = lg[0];
#pragma unroll
        for (int e = 1; e < 8; ++e) if (lg[e] > v1) { v1 = lg[e]; i1 = e; }
        int i2 = -1; float v2 = -3.0e38f;
#pragma unroll
        for (int e = 0; e < 8; ++e) if (e != i1 && lg[e] > v2) { v2 = lg[e]; i2 = e; }
        const float w1 = 1.0f / (1.0f + expf(v2 - v1)), w2 = 1.0f - w1;
        const int s1 = (int)atomicAdd(cnt + 64 * i1, 1u), s2 = (int)atomicAdd(cnt + 64 * i2, 1u);
        list[i1 * SEQ + s1] = tok; list[i2 * SEQ + s2] = tok; rss[i1 * SEQ + s1] = rowscale; rss[i2 * SEQ + s2] = rowscale;
        toke[2 * tok] = i1; toke[2 * tok + 1] = i2; toks[2 * tok] = s1; toks[2 * tok + 1] = s2; tokw[2 * tok] = w1; tokw[2 * tok + 1] = w2;
    }
}

__device__ __forceinline__ void quant_row_i8(const bf16* arow, signed char* qrow, float* rstep, int lane) {
    u32x4 v[14]; float amax = 0.f;
#pragma unroll
    for (int j = 0; j < 14; ++j) { v[j] = *(const u32x4*)(arow + (size_t)(j * 64 + lane) * 8);
#pragma unroll
        for (int e = 0; e < 4; ++e) amax = fmaxf(amax, fmaxf(fabsf(bflo(v[j][e])), fabsf(bfhi(v[j][e])))); }
#pragma unroll
    for (int o = 1; o < 64; o <<= 1) amax = fmaxf(amax, __shfl_xor(amax, o));
    amax = fmaxf(amax, 1e-20f); const float qs = 127.0f / amax;
#pragma unroll
    for (int j = 0; j < 14; ++j) { u32x2 w;
#pragma unroll
        for (int h = 0; h < 2; ++h) { unsigned x = 0;
#pragma unroll
            for (int e = 0; e < 2; ++e) { const unsigned d = v[j][2 * h + e]; x |= ((unsigned)(int)rintf(bflo(d) * qs) & 0xffu) << (16 * e); x |= ((unsigned)(int)rintf(bfhi(d) * qs) & 0xffu) << (16 * e + 8); }
            w[h] = x; }
        *(u32x2*)(qrow + (size_t)(j * 64 + lane) * 8) = w; }
    if (lane == 0) *rstep = amax * (1.0f / 127.0f);
}

__device__ __forceinline__ const float* uniform_ptr(const float* p) { const unsigned long long v = (unsigned long long)p; const unsigned lo = __builtin_amdgcn_readfirstlane((unsigned)v), hi = __builtin_amdgcn_readfirstlane((unsigned)(v >> 32));
    return (const float*)(((unsigned long long)hi << 32) | lo); }
struct NoConv { __device__ __forceinline__ void issue() {} __device__ __forceinline__ void finish() {} __device__ __forceinline__ bool pending() const { return false; } };
struct MoeConv {
    const float* gu; const float* dn; const float* gain; signed char* wgu; signed char* wdn; const float* wsc;
    int gwv, NGW, lane_unused, j, jend; bool active;
    float v[16]; signed char* dstu; int kbytes; float istep; int ie; unsigned lbuf;
    static constexpr int M_GU = NE * (DM / 16) * (2 * DFF / 64), M_DN = NE * (DFF / 16) * (DM / 64), M_ALL = M_GU + M_DN;
    static constexpr int SLOT = 1056;
    static_assert(M_GU % 4 == 0 && (DM / 16) % 4 == 0 && (DFF / 16) % 4 == 0, "groups of 4 consecutive k blocks stay inside one (expert, row block)");
    __device__ __forceinline__ void issue() {
        active = false; if (j >= jend) return;
        const int m = __builtin_amdgcn_readfirstlane(((j >> 2) * NGW + gwv) * 4 + (j & 3)); if (m >= M_ALL) { j = jend; return; }
        active = true; const float* src; int N;
        if (m < M_GU) { constexpr int per = (DM / 16) * (2 * DFF / 64); const int e = m / per, r = m - e * per, nb = r / (DM / 16), kb = r - nb * (DM / 16);
            const int lane = fresh_tid() & 63; const int nd = 64 * nb + lane, jt = nd >> 8, rr = nd & 255, scol = rr < 128 ? 128 * jt + rr : DFF + 128 * jt + (rr - 128);
            N = 2 * DFF; src = gu + ((size_t)e * DM + 16 * kb) * N + scol; dstu = (signed char*)uniform_ptr((const float*)(wgu + ((size_t)e * 2 * DFF + 64 * nb) * DM + 16 * kb)); kbytes = DM; ie = 32 + e; }
        else { const int m2 = m - M_GU; constexpr int per = (DFF / 16) * (DM / 64); const int e = m2 / per, r = m2 - e * per, nb = r / (DFF / 16), kb = r - nb * (DFF / 16);
            N = DM; src = dn + ((size_t)e * DFF + 16 * kb) * N + 64 * nb + (fresh_tid() & 63); dstu = (signed char*)uniform_ptr((const float*)(wdn + ((size_t)e * DM + 64 * nb) * DFF + 16 * kb)); kbytes = DFF; ie = 24 + e; }
        istep = ((const __attribute__((address_space(4))) float*)wsc)[ie];
#pragma unroll
        for (int kk = 0; kk < 16; ++kk) v[kk] = __builtin_nontemporal_load(src + (size_t)kk * N);
    }
    __device__ __forceinline__ bool pending() const { return active; }
    __device__ __forceinline__ void finish() {
        if (!active) return;
        constexpr float MAGIC = 12582912.0f + 128.0f, LO = 12582913.0f, HI = 12583167.0f;
        u32x4 o;
#pragma unroll
        for (int d = 0; d < 4; ++d) { int t[4];
#pragma unroll
            for (int b = 0; b < 4; ++b) { const int kk = 4 * d + b;
                t[b] = __builtin_bit_cast(int, __builtin_amdgcn_fmed3f(fmaf(v[kk], istep, MAGIC), LO, HI)); }
            const unsigned p0 = __builtin_amdgcn_perm((unsigned)t[1], (unsigned)t[0], 0x0c0c0400u), p1 = __builtin_amdgcn_perm((unsigned)t[3], (unsigned)t[2], 0x04000c0cu);
            o[d] = (p0 | p1) ^ 0x80808080u; }
        const int q = j & 3; const int lane = fresh_tid() & 63;
        { const unsigned la = lbuf + (unsigned)(q * SLOT) + (unsigned)lane * 16u; asm volatile("ds_write_b128 %0, %1" :: "v"(la), "v"(o) : "memory"); }
        if (q == 3) {
            const signed char* gb = dstu - 48;
            const int r0 = lane >> 2, qq = lane & 3; const unsigned ra = lbuf + (unsigned)(qq * SLOT) + (unsigned)r0 * 16u;
            const unsigned go_ = (unsigned)(r0 * kbytes + qq * 16);
            asm volatile("s_waitcnt lgkmcnt(0)" ::: "memory");
#pragma unroll
            for (int i = 0; i < 4; ++i) { u32x4 w; asm volatile("ds_read_b128 %0, %1 offset:%2\n\ts_waitcnt lgkmcnt(0)" : "=v"(w) : "v"(ra), "i"(256 * i) : "memory");
                *(GAS u32x4*)(gb + (size_t)(go_ + (unsigned)(16 * i * kbytes))) = w; }
        }
        ++j;
    }
};

template <class T> __device__ __forceinline__ void quant_xrow_i8(const T* xrow, signed char* qrow, float* rscale, int lane) {
    f32x4 v[8]; float ssq = 0.f, amax = 0.f;
#pragma unroll
    for (int j = 0; j < 8; ++j) { if constexpr (sizeof(T) == 2) v[j] = pg8::unpack4(*(const u32x2*)(xrow + 256 * j + 4 * lane)); else v[j] = *(const f32x4*)(xrow + 256 * j + 4 * lane); ssq += pg8::sq4(v[j]); amax = fmaxf(fmaxf(amax, fmaxf(fabsf(v[j][0]), fabsf(v[j][1]))), fmaxf(fabsf(v[j][2]), fabsf(v[j][3]))); }
    ssq = wave_sum(ssq);
#pragma unroll
    for (int o = 1; o < 64; o <<= 1) amax = fmaxf(amax, __shfl_xor(amax, o));
    amax = fmaxf(amax, 1e-20f); const float qs = 127.0f / amax;
#pragma unroll
    for (int j = 0; j < 8; ++j) { unsigned w = 0;
#pragma unroll
        for (int e = 0; e < 4; ++e) w |= ((unsigned)(int)rintf(v[j][e] * qs) & 0xffu) << (8 * e);
        *(unsigned*)(qrow + 256 * j + 4 * lane) = w; }
    if (lane == 0) *rscale = amax * (1.0f / 127.0f) / sqrtf(ssq * (1.0f / DM) + EPS);
}

__device__ __forceinline__ void quant_row2_i8(const bf16* a0, const bf16* a1, signed char* q0, signed char* q1, float* s0, float* s1, int lane) {
    u32x4 v[2][14]; float amax[2] = {0.f, 0.f};
#pragma unroll
    for (int j = 0; j < 14; ++j) { v[0][j] = __builtin_nontemporal_load((const u32x4*)(a0 + (size_t)(j * 64 + lane) * 8)); v[1][j] = __builtin_nontemporal_load((const u32x4*)(a1 + (size_t)(j * 64 + lane) * 8)); }
#pragma unroll
    for (int w = 0; w < 2; ++w) {
#pragma unroll
        for (int j = 0; j < 14; ++j)
#pragma unroll
            for (int e = 0; e < 4; ++e) amax[w] = fmaxf(amax[w], fmaxf(fabsf(bflo(v[w][j][e])), fabsf(bfhi(v[w][j][e]))));
#pragma unroll
        for (int o = 1; o < 64; o <<= 1) amax[w] = fmaxf(amax[w], __shfl_xor(amax[w], o));
        amax[w] = fmaxf(amax[w], 1e-20f); const float qs = 127.0f / amax[w]; signed char* q = w ? q1 : q0;
#pragma unroll
        for (int j = 0; j < 14; ++j) { u32x2 o2;
#pragma unroll
            for (int h = 0; h < 2; ++h) { unsigned x = 0;
#pragma unroll
                for (int e = 0; e < 2; ++e) { const unsigned d = v[w][j][2 * h + e]; x |= ((unsigned)(int)rintf(bflo(d) * qs) & 0xffu) << (16 * e); x |= ((unsigned)(int)rintf(bfhi(d) * qs) & 0xffu) << (16 * e + 8); }
                o2[h] = x; }
            *(u32x2*)(q + (size_t)(j * 64 + lane) * 8) = o2; }
        if (lane == 0) *(w ? s1 : s0) = amax[w] * (1.0f / 127.0f); }
}
#ifndef MK_STAMP
#define MK_STAMP 0
#endif
#ifndef MK_STAMP_A
#define MK_STAMP_A 0x1u
#define MK_STAMP_B 0x408u
#endif
#ifndef MK_PROBE_NOSTORE
#define MK_PROBE_NOSTORE 0
#endif
#ifndef MK_REPEAT
#define MK_REPEAT 0u
#endif
#define NREP(k) (1 + (int)(((MK_REPEAT) >> (k)) & 1u))
#ifndef MK_PHMASK
#define MK_PHMASK 0xFFFFFFFFu
#endif
#define PH_ON(id) (((MK_PHMASK) >> (id)) & 1u)
constexpr int NWAVES = 8;
constexpr int NPH = 19;
struct Args { const void* in[34]; float* out; unsigned char* ws; int ph_lo, ph_hi; };
static_assert(sizeof(Args) == 34 * 8 + 8 + 8 + 8, "Args has no padding");


__device__ __forceinline__ const void* argp(int i) { const __attribute__((address_space(4))) char* ka = (const __attribute__((address_space(4))) char*)__builtin_amdgcn_kernarg_segment_ptr();
    return *(const void* const volatile __attribute__((address_space(4)))*)(ka + 8 * i); }
__global__ void __launch_bounds__(NWAVES * 64, 2) fwd(Args args) {
    extern __shared__ __attribute__((aligned(16))) unsigned char lds_raw[];
    LAS unsigned char* lds = (LAS unsigned char*)lds_raw;
    volatile LAS unsigned* MISC = (volatile LAS unsigned*)(lds + MISC_OFF);
    const int tid = threadIdx.x, lane = tid & 63, wave = __builtin_amdgcn_readfirstlane(tid >> 6);
    const int G = gridDim.x, bid = blockIdx.x, vcu = (G % 8 == 0) ? (bid % 8) * (G / 8) + bid / 8 : bid;
    const int gw = vcu * NWAVES + wave, NGW = G * NWAVES;
    unsigned char* ws = args.ws;
    gu32* ctl = (gu32*)ws;
    for (int i = tid; i < 64; i += NWAVES * 64) MISC[i] = 0u;
    __syncthreads();
    XcdBarrier bar; bar.bar = (unsigned*)ctl + CW_BAR; bar.x = 0; bar.st = nullptr;
#if !MK_PER_PHASE
    bar = xcd_barrier_post((unsigned*)ctl + CW_BAR, MISC + 8);
#define GRID_BAR() xcd_barrier(bar)
#else
#define GRID_BAR() do { } while (0)
#endif
#if MK_PER_PHASE
    const int lo = args.ph_lo, hi = args.ph_hi;
#else
    constexpr int lo = 0, hi = NPH;
#endif
#define IN(k) (lo <= (k) && (k) < hi)
#define BOTH(k) (IN(k) && IN((k) + 1))
#if MK_STAMP
    unsigned long long* STP = (unsigned long long*)(ws + WS.end);
#define STAMP(k) do { if (bid == 0 && tid == 0) STP[k] = __builtin_amdgcn_s_memrealtime(); } while (0)
    STAMP(0);
#else
#define STAMP(k) do { } while (0)
#endif
#define x_in ((const float*)argp(0))
#define mem_in ((const float*)argp(1))
#define pos ((const int*)argp(2))
#define norm_mix ((const float*)argp(3))
#define w_in_f32 ((const float*)argp(4))
#define s5_a_re ((const float*)argp(5))
#define s5_a_im ((const float*)argp(6))
#define s5_log_dt ((const float*)argp(7))
#define s5_b_re ((const float*)argp(8))
#define s5_b_im ((const float*)argp(9))
#define s5_c_re ((const float*)argp(10))
#define s5_c_im ((const float*)argp(11))
#define s5_d ((const float*)argp(12))
#define s5_w_glu ((const float*)argp(13))
#define q_a_norm ((const float*)argp(14))
#define w_q_b ((const float*)argp(15))
#define kv_norm ((const float*)argp(16))
#define w_kv_b ((const float*)argp(17))
#define q_norm ((const float*)argp(18))
#define k_norm ((const float*)argp(19))
#define mla_w_o ((const float*)argp(20))
#define mem_norm ((const float*)argp(21))
#define mem_w_kv ((const float*)argp(22))
#define mem_q_norm ((const float*)argp(23))
#define mem_k_norm ((const float*)argp(24))
#define mem_w_o ((const float*)argp(25))
#define w_out_f32 ((const float*)argp(26))
#define norm_ffn ((const float*)argp(27))
#define ffn_gu ((const float*)argp(28))
#define ffn_dn ((const float*)argp(29))
#define moe_router ((const float*)argp(30))
#define moe_rb ((const float*)argp(31))
#define moe_gu ((const float*)argp(32))
#define moe_dn ((const float*)argp(33))
    float* OUT = args.out;
#define WSP ((unsigned char*)argp(35))
#define XB ((bf16*)(WSP + WS.xb))
#define Ub ((bf16*)(WSP + WS.u))
#define CQ ((bf16*)(WSP + WS.cq))
#define CKV ((bf16*)(WSP + WS.ckv))
#define KR ((float*)(WSP + WS.kr))
#define QM ((bf16*)(WSP + WS.qm))
#define GT ((unsigned char*)(WSP + WS.gt))
#define Qh ((bf16*)(WSP + WS.q))
#define Kh ((bf16*)(WSP + WS.kk))
#define Vh ((bf16*)(WSP + WS.vv))
#define OA ((bf16*)(WSP + WS.oa))
#define OM ((bf16*)(WSP + WS.om))
#define YS ((bf16*)(WSP + WS.ys))
#define ES ((float*)(WSP + WS.es))
#define MF ((bf16*)(WSP + WS.mf))
#define MB ((bf16*)(WSP + WS.mb))
#define ACT ((bf16*)(WSP + WS.act))
#define YM ((bf16*)(WSP + WS.ym))
#define KMEM ((bf16*)(WSP + WS.kmem))
#define VMEM ((bf16*)(WSP + WS.vmem))
#define MEMB ((bf16*)(WSP + WS.memb))
#define ROPEC ((float*)(WSP + WS.ropec))
#define ROPES ((float*)(WSP + WS.ropes))
#define LIST ((int*)(WSP + WS.list))
#define TOKE ((int*)(WSP + WS.toke))
#define TOKS ((int*)(WSP + WS.toks))
#define TOKW ((float*)(WSP + WS.tokw))
#define TMIN ((int*)(WSP + WS.tmm))
#define XQ ((signed char*)(WSP + WS.xq))
#define RSC ((float*)(WSP + WS.rsc))
#define WSC ((float*)(WSP + WS.wsc))
#define ACT8 ((signed char*)(WSP + WS.act8))
#define RSC2 ((float*)(WSP + WS.rsc2))
#define TMAX (TMIN + 128)
#define CNT ((unsigned*)WSP + CW_CNT)
#define SS ((float*)(WSP + WS.ssp))
    for (int rep_ = 0; rep_ < ((PH_ON(0) && IN(0)) ? NREP(0) : 0); ++rep_) {
        const int lane = fresh_tid() & 63;
        LAS float* scr = (LAS float*)(lds + wave * 16640);
        transpose_job(w_in_f32, (size_t)DM * IN_COLS, IN_COLS, DM, (bf16*)(ws + WS.w_in[0]), (WS.w_in[1] - WS.w_in[0]) / 2, DM, 2304, norm_mix, DM, 2, MapInProj{}, scr, gw, NGW, lane);
        {
            LAS float* stp = (LAS float*)(lds + XT_OFF) + 32;
            if (wave < 2) { const float st = sample_step(w_in_f32 + (size_t)wave * DM * IN_COLS + 3072, IN_COLS, DM, norm_mix + wave * DM, lane, 3 * DM); if (lane == 0) { stp[wave] = st; if (bid == 0) WSC[16 + wave] = st; } }
            else if (wave < 4) { const int w2 = wave - 2; const float st = sample_step(w_in_f32 + (size_t)w2 * DM * IN_COLS + 2048, IN_COLS, DM, norm_mix + w2 * DM, lane, MEMW); if (lane == 0) { stp[wave] = st; if (bid == 0) WSC[18 + w2] = st; } }
            __syncthreads();
            const int nkb = DM / 64, nnb = 7168 / 64, per = nkb * nnb; const MapId mp{};
            for (int it = gw; it < per * 2; it += NGW) { const int inst = it / per, r = it - inst * per, nb = r / nkb, kb = r - nb * nkb;
                transpose_item_i8(w_in_f32 + (size_t)inst * DM * IN_COLS + 2048, IN_COLS, (signed char*)(WSP + WS.w_inq[inst]), DM, norm_mix + inst * DM, 1.0f / stp[nb < 16 ? 2 + inst : inst], mp, kb, nb, lane); }
        }
        transpose_job(s5_w_glu, (size_t)S5W * 4096, 4096, S5W, (bf16*)(ws + WS.w_glu[0]), (WS.w_glu[1] - WS.w_glu[0]) / 2, S5W, 4096, nullptr, 0, 2, MapGlu{2048}, scr, gw, NGW, lane);
        transpose_job(w_q_b, (size_t)QRANK * 3072, 3072, QRANK, (bf16*)(ws + WS.w_qb[0]), (WS.w_qb[1] - WS.w_qb[0]) / 2, 512, 4096, q_a_norm, QRANK, 2, MapQB{}, scr, gw, NGW, lane);
        transpose_job(w_kv_b, (size_t)KVRANK * 4096, 4096, KVRANK, (bf16*)(ws + WS.w_kvb[0]), (WS.w_kvb[1] - WS.w_kvb[0]) / 2, 512, 4096, kv_norm, KVRANK, 2, MapId{}, scr, gw, NGW, lane);
        transpose_job(mla_w_o, (size_t)DM * DM, DM, DM, (bf16*)(ws + WS.w_mo[0]), (WS.w_mo[1] - WS.w_mo[0]) / 2, DM, DM, nullptr, 0, 2, MapId{}, scr, gw, NGW, lane);
        transpose_job(mem_w_kv, (size_t)DM * DM, DM, DM, (bf16*)(ws + WS.w_mkv[0]), (WS.w_mkv[1] - WS.w_mkv[0]) / 2, DM, DM, mem_norm, DM, 2, MapId{}, scr, gw, NGW, lane);
        transpose_job(mem_w_o, (size_t)MEMW * DM, DM, MEMW, (bf16*)(ws + WS.w_mwo[0]), (WS.w_mwo[1] - WS.w_mwo[0]) / 2, MEMW, DM, nullptr, 0, 2, MapId{}, scr, gw, NGW, lane);
        transpose_job(w_out_f32, (size_t)DM * DM, DM, DM, (bf16*)(ws + WS.w_out[0]), (WS.w_out[1] - WS.w_out[0]) / 2, DM, DM, nullptr, 0, 2, MapId{}, scr, gw, NGW, lane);
        transpose_job(ffn_gu, 0, 2 * DFF, DM, (bf16*)(ws + WS.w_gu), 0, DM, 2 * DFF, norm_ffn, 0, 1, MapGlu{DFF}, scr, gw, NGW, lane);
        transpose_job(ffn_dn, 0, DM, DFF, (bf16*)(ws + WS.w_dn), 0, DFF, DM, nullptr, 0, 1, MapId{}, scr, gw, NGW, lane);
        {
            LAS float* stp = (LAS float*)(lds + XT_OFF);
            { const float st = sample_step(moe_gu + (size_t)wave * DM * 2 * DFF, 2 * DFF, DM, nullptr, lane); if (lane == 0) { stp[wave] = st; if (bid == 0) { WSC[wave] = st; WSC[32 + wave] = 1.0f / st; } } }
            __syncthreads();
        }
        {
            LAS float* stp = (LAS float*)(lds + XT_OFF) + 16;
            { const float st = sample_step(moe_dn + (size_t)wave * DFF * DM, DM, DFF, nullptr, lane); if (lane == 0) { stp[wave] = st; if (bid == 0) { WSC[8 + wave] = st; WSC[24 + wave] = 1.0f / st; } } }
            __syncthreads();
        }
        for (int i = gw * 64 + lane; i < SEQ * 32; i += NGW * 64) { const int t = i >> 5, j = i & 31; const float inv = powf(10000.0f, -(float)(2 * j) / 64.0f); const float ang = (float)pos[t] * inv;
            ROPEC[i] = cosf(ang); ROPES[i] = sinf(ang); }
        for (int t = gw; t < 128; t += NGW) { int v = pos[64 * t + lane], mn = v, mx = v;
#pragma unroll
            for (int o_ = 1; o_ < 64; o_ <<= 1) { mn = min(mn, __shfl_xor(mn, o_)); mx = max(mx, __shfl_xor(mx, o_)); }
            if (lane == 0) { TMIN[t] = mn; TMAX[t] = mx; } }
        for (int i = gw * 64 + lane; i < 2 * S5G * S5P; i += NGW * 64) { const int l = i / (S5G * S5P), gp = i % (S5G * S5P), g = gp / S5P, p = gp % S5P;
            const float are = s5_a_re[i], aim = s5_a_im[i], dt = expf(s5_log_dt[l * S5G + g]);
            const float mag = expf(dt * are), lr = mag * cosf(dt * aim), li = mag * sinf(dt * aim);
            ((f32x2*)(ws + WS.lam[l]))[gp] = (f32x2){lr, li};
            const float den = are * are + aim * aim, nr = lr - 1.0f, ni = li, fr = (nr * are + ni * aim) / den, fi = (ni * are - nr * aim) / den;
            bf16* bbr = (bf16*)(ws + WS.bb[l]) + ((size_t)(g * 128 + p)) * 16; bf16* bbi = bbr + 64 * 16;
            const float* bre = s5_b_re + (size_t)i * S5H; const float* bim = s5_b_im + (size_t)i * S5H;
#pragma unroll
            for (int h = 0; h < S5H; ++h) { bbr[h] = (bf16)f2bf(fr * bre[h] - fi * bim[h]); bbi[h] = (bf16)f2bf(fr * bim[h] + fi * bre[h]); }
            bf16* cp = (bf16*)(ws + WS.cp[l]) + (size_t)g * 16 * 128;
#pragma unroll
            for (int h = 0; h < S5H; ++h) { const size_t ci = ((size_t)(l * S5G + g) * S5H + h) * S5P + p; cp[h * 128 + p] = (bf16)f2bf(s5_c_re[ci]); cp[h * 128 + 64 + p] = (bf16)f2bf(-s5_c_im[ci]); } }
        for (int m = gw; m < SEQ; m += NGW) { const float s = row_to_bf16(x_in + (size_t)m * DM, XB + (size_t)m * DM, false, lane); if (lane < 32) SS[SS_X + (size_t)m * 32 + lane] = lane == 0 ? s : 0.f;
            quant_xrow_i8(x_in + (size_t)m * DM, XQ + (size_t)m * DM, RSC + m, lane); }
        for (int m = gw; m < NMEM; m += NGW) (void)row_to_bf16(mem_in + (size_t)m * DM, MEMB + (size_t)m * DM, true, lane);
        if (BOTH(0)) GRID_BAR();
        STAMP(1);
    }

    for (int l = 0; l < DEPTH; ++l) {
        const int pb = 1 + 8 * l;
        const float* ssx_mix = SS + SS_X + (size_t)(2 * l) * SEQ * 32; float* ssx_ffn = SS + SS_X + (size_t)(2 * l + 1) * SEQ * 32;
        for (int rep_ = 0; rep_ < (IN(pb + 0) ? NREP(pb + 0) : 0); ++rep_) {
            if constexpr (PH_ON(1)) { pg8::Gemm g{XB, (const bf16*)(ws + WS.w_in[l]), DM, DM, DM, 2}; pg8::StaticOrder S; S.init(SEQ / 256, 9, G, bid);
              pg8::EpiInProj E{ssx_mix, Ub, CQ, CKV, QM, GT, KR, SS + SS_CQ + (size_t)l * SEQ * 8, SS + SS_CKV + (size_t)l * SEQ * 8, SS + SS_KR + (size_t)l * SEQ * 4, mem_q_norm + l * MEMD};
              pg8::gemm_phase(lds, g, S, E); }
            if constexpr (PH_ON(1)) { pg8::Gemm g{XQ, (const void*)(WSP + WS.w_inq[l]), DM, DM, DM, 1}; pg8::BalOrder S{SEQ / 256, 28, bid};
              pg8::EpiGates E{RSC, WSC[16 + l], GT, WSC[18 + l], QM, mem_q_norm + l * MEMD};
              pg8::gemm_phase<pg8::EpiGates, pg8::BalOrder, 1>(lds, g, S, E); }
            if constexpr (PH_ON(18)) if (l == 0) { pg8::Gemm g{MEMB, (const bf16*)(ws + WS.w_mkv[0]), DM, DM, DM, 2}; pg8::MemKvOrder S{G, G - 1 - bid};
              pg8::EpiMemKV E{{mem_k_norm, mem_k_norm + MEMD}, KMEM, VMEM};
              pg8::gemm_phase(lds, g, S, E); }
            if (BOTH(pb + 0)) GRID_BAR();
            STAMP(pb + 0 + 1);
        }
        for (int rep_ = 0; rep_ < (IN(pb + 1) ? NREP(pb + 1) : 0); ++rep_) {
            if constexpr (PH_ON(12)) { pg8::Gemm g{CQ, (const bf16*)(ws + WS.w_qb[l]), 512, 512, 512, 2}; pg8::StaticOrder S; S.init(SEQ / 256, NH, G, bid);
              pg8::EpiQ E{SS + SS_CQ + (size_t)l * SEQ * 8, q_norm + l * DQK, ROPEC, ROPES, Qh};
              pg8::gemm_phase(lds, g, S, E); }
            if constexpr (PH_ON(13)) { pg8::Gemm g{CKV, (const bf16*)(ws + WS.w_kvb[l]), 512, 512, 512, 2}; pg8::StaticOrder S; S.init(SEQ / 256, NH, G, bid);
              pg8::EpiKV E{SS + SS_CKV + (size_t)l * SEQ * 8, SS + SS_KR + (size_t)l * SEQ * 4, k_norm + l * DQK, KR, ROPEC, ROPES, Kh, Vh};
              pg8::gemm_phase(lds, g, S, E); }
            if constexpr (PH_ON(14)) for (int it = gw; it < S5G * 32; it += NGW)
                s5::s5_wave<1>((char*)lds_raw + wave * s5::WAVE_LDS, it >> 5, (it & 31) * 4, Ub, (const f32x2*)(ws + WS.lam[l]), (const bf16*)(ws + WS.bb[l]), (const bf16*)(ws + WS.cp[l]), s5_d + l * S5W, ES, YS, fresh_tid() & 63);
            __syncthreads();
            NoConv nocv;
            if constexpr (PH_ON(15)) for (int it = vcu; it < MEMH * 32 * 2; it += G) { const int h = it >> 6, qb = (it & 63) >> 1, dvh = it & 1;
                attn::attn_item<MEMD, false, MEMW, MEMD, MEMW, false>(nocv, (char*)lds_raw, lds, QM + (size_t)qb * 256 * MEMW + h * MEMD, KMEM + ((size_t)l * MEMH + h) * NMEM * MEMD, VMEM + ((size_t)l * MEMH + h) * NMEM * MEMD + dvh * 128,
                                             OM + (size_t)qb * 256 * MEMW + h * MEMD + dvh * 128, nullptr, qb * 256, NMEM / 64, nullptr, nullptr); }
            if (BOTH(pb + 1)) GRID_BAR();
            STAMP(pb + 1 + 1);
        }
        for (int rep_ = 0; rep_ < (IN(pb + 2) ? NREP(pb + 2) : 0); ++rep_) {
            constexpr int CV_J0 = 132;
            MoeConv mcv{moe_gu, moe_dn, (const float*)(WSP + WS.gsc), (signed char*)(WSP + WS.w_egu), (signed char*)(WSP + WS.w_edn), WSC, gw, NGW, fresh_tid() & 63, l == 0 ? 0 : CV_J0, l == 0 ? CV_J0 : (1 << 30), false, {}, nullptr, 0, 0.f, 0,
                        (unsigned)__builtin_amdgcn_readfirstlane((int)((unsigned)(size_t)lds + (wave < 3 ? 49152u + wave * 4224u : (wave < 6 ? 118400u + (wave - 3) * 4224u : (unsigned)GOFF_OFF + (wave - 6) * 4224u))))};
            if constexpr (PH_ON(16)) for (int it = vcu; it < NH * 16; it += G) { const int h = it >> 4, pr = it & 15;
#pragma unroll 1
                for (int pass = 0; pass < 2; ++pass) { const int qb = pass ? pr : 31 - pr;
                    attn::attn_item<DQK, true, DQK, DV, DM, true>(mcv, (char*)lds_raw, lds, Qh + ((size_t)h * SEQ + qb * 256) * DQK, Kh + (size_t)h * SEQ * DQK, Vh + (size_t)h * SEQ * DV,
                                               OA + (size_t)qb * 256 * DM + h * DV, pos, qb * 256, SEQ / 64, TMIN, TMAX); } }
            if constexpr (PH_ON(16)) { mcv.finish(); while (mcv.j < mcv.jend) { mcv.issue(); mcv.finish(); } }
            if constexpr (PH_ON(17)) for (int it = gw; it < S5G * 32; it += NGW)
                s5::s5_wave<2>((char*)lds_raw + wave * s5::WAVE_LDS, it >> 5, (it & 31) * 4, Ub, (const f32x2*)(ws + WS.lam[l]), (const bf16*)(ws + WS.bb[l]), (const bf16*)(ws + WS.cp[l]), s5_d + l * S5W, ES, YS, fresh_tid() & 63);
            __syncthreads();
            if (BOTH(pb + 2)) GRID_BAR();
            STAMP(pb + 2 + 1);
        }
        for (int rep_ = 0; rep_ < (IN(pb + 3) ? NREP(pb + 3) : 0); ++rep_) {
            if constexpr (PH_ON(4)) { pg8::Gemm g{OA, (const bf16*)(ws + WS.w_mo[l]), DM, DM, DM, 2}; pg8::StaticOrder S; S.init(SEQ / 256, DM / 256, G, bid); pg8::EpiMerge<1> E{GT, MF}; pg8::gemm_phase(lds, g, S, E); }
            if constexpr (PH_ON(19)) { pg8::Gemm g{OM, (const bf16*)(ws + WS.w_mwo[l]), MEMW, MEMW, MEMW, 2}; pg8::StaticOrder S; S.init(SEQ / 256, DM / 256, G, bid); pg8::EpiMerge<2> E{GT, MF}; pg8::gemm_phase(lds, g, S, E); }
            if constexpr (PH_ON(20)) { pg8::Gemm g{YS, (const bf16*)(ws + WS.w_glu[l]), S5W, S5W, S5W, 2}; pg8::GluOrder S; S.init(SEQ / 256, DM / 256, G, bid); pg8::EpiGlu E{GT, MF, MB}; pg8::gemm_phase(lds, g, S, E); }
            if (BOTH(pb + 3)) GRID_BAR();
            STAMP(pb + 3 + 1);
        }
        if (PH_ON(5) && IN(pb + 4)) {
            pg8::Gemm g{MB, (const bf16*)(ws + WS.w_out[l]), DM, DM, DM, 2}; pg8::StaticOrder S; S.init(SEQ / 256, DM / 256, G, bid);
            if (l == 0) { pg8::EpiResid<false, false> E{x_in, nullptr, XB, ssx_ffn}; pg8::gemm_phase(lds, g, S, E); }
            else { pg8::EpiResid<true, true> E{XB, OUT, nullptr, ssx_ffn}; pg8::gemm_phase(lds, g, S, E); }
            if (BOTH(pb + 4)) GRID_BAR();
            STAMP(pb + 4 + 1);
        }
        if (l == 0) {
            for (int rep_ = 0; rep_ < ((PH_ON(6) && IN(pb + 5)) ? NREP(pb + 5) : 0); ++rep_) {
                pg8::Gemm g{XB, (const bf16*)(ws + WS.w_gu), DM, DM, DM, 2}; pg8::StaticOrder S; S.init(SEQ / 256, 2 * DFF / 256, G, bid);
                pg8::EpiSwiGLU<pg8::StaticOrder> E{ssx_ffn, ACT, &S, false, nullptr, nullptr, nullptr}; pg8::gemm_phase(lds, g, S, E);
                if (BOTH(pb + 5)) GRID_BAR();
                STAMP(pb + 5 + 1);
            }
            if (PH_ON(7) && IN(pb + 6)) {
                pg8::Gemm g{ACT, (const bf16*)(ws + WS.w_dn), DFF, DFF, DFF, 2}; pg8::StaticOrder S; S.init(SEQ / 256, DM / 256, G, bid);
                pg8::EpiResid<true, false> E{XB, nullptr, XB, SS + SS_X + (size_t)2 * SEQ * 32}; pg8::gemm_phase(lds, g, S, E);
                if (BOTH(pb + 6)) GRID_BAR();
                STAMP(pb + 6 + 1);
            }
            if (PH_ON(22) && IN(pb + 7)) {
                const int lane = fresh_tid() & 63;
                for (int t = gw; t < SEQ; t += NGW) quant_xrow_i8(XB + (size_t)t * DM, XQ + (size_t)t * DM, RSC + t, lane);
                if (BOTH(pb + 7)) GRID_BAR();
                STAMP(pb + 7 + 1);
            }
        } else {
            LAS int* MT = (LAS int*)(lds + MISC_OFF + 64);
#define MOE_TABLE() do { if (tid == 0) { int p = 0; for (int e = 0; e < NE; ++e) { const int c_ = (int)__hip_atomic_load(CNT + 64 * e, RLX_AGENT); MT[e] = p; MT[16 + e] = c_; p += (c_ + 255) >> 8; } MT[8] = p; } __syncthreads(); } while (0)
            if (PH_ON(8) && IN(pb + 5)) {
                const int lane = fresh_tid() & 63;
                for (int t = gw; t < SEQ; t += NGW) router_token(OUT + (size_t)t * DM, norm_ffn + DM, moe_router, moe_rb, t, CNT, LIST, TOKE, TOKS, TOKW, XQ, RSC, (float*)(WSP + WS.rss), lane);
                if (BOTH(pb + 5)) GRID_BAR();
                STAMP(pb + 5 + 1);
            }
            for (int rep_ = 0; rep_ < ((PH_ON(9) && IN(pb + 6)) ? NREP(pb + 6) : 0); ++rep_) {
                MOE_TABLE();
                typedef pg8::MoeOrder<true, 1> Ord;
                pg8::Gemm g{XQ, (const void*)(ws + WS.w_egu), DM, DM, DM, 1}; Ord S{MT, LIST, 2 * DFF / 256, G, bid, (size_t)2 * DFF * DM, 0, MT[8]};
                pg8::EpiSwiGLU<Ord> E{ssx_ffn, ACT, &S, true, (const float*)(WSP + WS.rss), WSC, nullptr}; pg8::gemm_phase<pg8::EpiSwiGLU<Ord>, Ord, 1>(lds, g, S, E);
                if (BOTH(pb + 6)) GRID_BAR();
                STAMP(pb + 6 + 1);
            }
            for (int rep_ = 0; rep_ < ((PH_ON(21) && IN(pb + 7)) ? NREP(pb + 7) : 0); ++rep_) {
                MOE_TABLE();
                const int lane = fresh_tid() & 63; const int nrows = MT[8] * 256;
                for (int r = gw; r < nrows; r += 2 * NGW) { const int r2 = r + NGW < nrows ? r + NGW : r;
                    quant_row2_i8(ACT + (size_t)r * DFF, ACT + (size_t)r2 * DFF, ACT8 + (size_t)r * DFF, ACT8 + (size_t)r2 * DFF, RSC2 + r, RSC2 + r2, lane); }
                if (BOTH(pb + 7)) GRID_BAR();
                STAMP(pb + 7 + 1);
            }
            for (int rep_ = 0; rep_ < ((PH_ON(10) && IN(pb + 8)) ? NREP(pb + 8) : 0); ++rep_) {
                MOE_TABLE();
                const int P_ = MT[8], Pf = ((P_ * (DM / 256)) / G) * G / (DM / 256);
                { typedef pg8::MoeOrder<false, 1> Ord; pg8::Gemm g{ACT8, (const void*)(WSP + WS.w_edn), DFF, DFF, DFF, 1}; Ord S{MT, LIST, DM / 256, G, bid, (size_t)DM * DFF, 0, Pf};
                  pg8::EpiMoeDown E{YM, WSC + 8, RSC2}; pg8::gemm_phase<pg8::EpiMoeDown, Ord, 1>(lds, g, S, E); }
                { typedef pg8::MoeOrder<false, KSPLIT> Ord; pg8::Gemm g{ACT8, (const void*)(WSP + WS.w_edn), DFF, DFF, DFF / KSPLIT, 1}; Ord S{MT, LIST, DM / 256, G, bid, (size_t)DM * DFF, Pf, P_ - Pf};
                  pg8::EpiMoeDown E{YM, WSC + 8, RSC2}; pg8::gemm_phase<pg8::EpiMoeDown, Ord, 1>(lds, g, S, E); }
                if (BOTH(pb + 8)) GRID_BAR();
                STAMP(pb + 8 + 1);
            }
            if (PH_ON(11) && IN(pb + 9)) {
                MOE_TABLE();
                const int lane = fresh_tid() & 63;
                for (int t = gw; t < SEQ; t += NGW) {
                    const int e1 = TOKE[2 * t], e2 = TOKE[2 * t + 1]; const size_t r1 = (size_t)MT[e1] * 256 + TOKS[2 * t], r2 = (size_t)MT[e2] * 256 + TOKS[2 * t + 1];
                    const float w1 = TOKW[2 * t], w2 = TOKW[2 * t + 1];
                    const int P_ = MT[8], Pf = ((P_ * (DM / 256)) / G) * G / (DM / 256); const int n1 = (int)(r1 >> 8) >= Pf ? KSPLIT : 1, n2 = (int)(r2 >> 8) >= Pf ? KSPLIT : 1;
                    f32x4 av[4], bv[4]; u32x4 y1v[4], y2v[4];
#pragma unroll
                    for (int j = 0; j < 4; ++j) { const int c = 512 * j + 8 * lane; const float* op = OUT + (size_t)t * DM + c; av[j] = *(const f32x4*)op; bv[j] = *(const f32x4*)(op + 4);
                        y1v[j] = *(const u32x4*)(YM + r1 * DM + c); y2v[j] = *(const u32x4*)(YM + r2 * DM + c); }
#define CMB_ADD(a_, b_, w_, y_) do { a_[0] += w_ * bflo(y_.x); a_[1] += w_ * bfhi(y_.x); a_[2] += w_ * bflo(y_.y); a_[3] += w_ * bfhi(y_.y); b_[0] += w_ * bflo(y_.z); b_[1] += w_ * bfhi(y_.z); b_[2] += w_ * bflo(y_.w); b_[3] += w_ * bfhi(y_.w); } while (0)
#pragma unroll
                    for (int j = 0; j < 4; ++j) { CMB_ADD(av[j], bv[j], w1, y1v[j]); CMB_ADD(av[j], bv[j], w2, y2v[j]); }
                    for (int ks = 1; ks < n1; ++ks) {
#pragma unroll
                        for (int j = 0; j < 4; ++j) { const u32x4 y = *(const u32x4*)(YM + ((size_t)ks * ACT_ROWS + r1) * DM + 512 * j + 8 * lane); CMB_ADD(av[j], bv[j], w1, y); } }
                    for (int ks = 1; ks < n2; ++ks) {
#pragma unroll
                        for (int j = 0; j < 4; ++j) { const u32x4 y = *(const u32x4*)(YM + ((size_t)ks * ACT_ROWS + r2) * DM + 512 * j + 8 * lane); CMB_ADD(av[j], bv[j], w2, y); } }
#undef CMB_ADD
#pragma unroll
                    for (int j = 0; j < 4; ++j) { float* op = OUT + (size_t)t * DM + 512 * j + 8 * lane; *(f32x4*)op = av[j]; *(f32x4*)(op + 4) = bv[j]; } }
            }
        }
    }
#if MK_STAMP
    STAMP(19);
    GRID_BAR();
    {   float ta = 0.f, tb = 0.f;
        for (int k = 0; k < 19; ++k) { const float dt = (float)(STP[k + 1] - STP[k]) * 0.01f; if ((MK_STAMP_A >> k) & 1u) ta += dt; if ((MK_STAMP_B >> k) & 1u) tb += dt; }
        for (size_t i = (size_t)bid * 512 + tid; i < (size_t)SEQ * DM; i += (size_t)G * 512) OUT[i] = (i & 1) ? ta : tb; }
#endif
#undef x_in
#undef mem_in
#undef pos
#undef norm_mix
#undef w_in_f32
#undef s5_a_re
#undef s5_a_im
#undef s5_log_dt
#undef s5_b_re
#undef s5_b_im
#undef s5_c_re
#undef s5_c_im
#undef s5_d
#undef s5_w_glu
#undef q_a_norm
#undef w_q_b
#undef kv_norm
#undef w_kv_b
#undef q_norm
#undef k_norm
#undef mla_w_o
#undef mem_norm
#undef mem_w_kv
#undef mem_q_norm
#undef mem_k_norm
#undef mem_w_o
#undef w_out_f32
#undef norm_ffn
#undef ffn_gu
#undef ffn_dn
#undef moe_router
#undef moe_rb
#undef moe_gu
#undef moe_dn
#undef XB
#undef Ub
#undef CQ
#undef CKV
#undef KR
#undef QM
#undef GT
#undef Qh
#undef Kh
#undef Vh
#undef OA
#undef OM
#undef YS
#undef ES
#undef MF
#undef MB
#undef ACT
#undef YM
#undef KMEM
#undef VMEM
#undef MEMB
#undef ROPEC
#undef ROPES
#undef LIST
#undef TOKE
#undef TOKS
#undef TOKW
#undef TMIN
#undef XQ
#undef RSC
#undef WSC
#undef ACT8
#undef RSC2
#undef TMAX
#undef CNT
#undef SS
#undef WSP
#undef IN
#undef BOTH
}

extern "C" void kernel_launch(void* const* d_in, const int* in_sizes, int n_in, void* d_out, int out_size, void* d_ws, size_t ws_size, hipStream_t stream) {
    static int grid = 0;
    if (grid == 0) {
        if (n_in != 34 || in_sizes[0] != SEQ * DM || out_size != SEQ * DM || ws_size < WS.end) {
            fprintf(stderr, "kernel_launch: shape mismatch: n_in %d in0 %d out %d ws %zu (need %zu)\n", n_in, n_in > 0 ? in_sizes[0] : -1, out_size, ws_size, (size_t)WS.end); grid = -1; return; }
        int dev = 0, cus = 0;
        if (hipGetDevice(&dev) != hipSuccess || hipDeviceGetAttribute(&cus, hipDeviceAttributeMultiprocessorCount, dev) != hipSuccess) { grid = -1; return; }
        if (hipFuncSetAttribute((const void*)fwd, hipFuncAttributeMaxDynamicSharedMemorySize, LDS_BYTES) != hipSuccess) { fprintf(stderr, "kernel_launch: hipFuncSetAttribute failed\n"); grid = -1; return; }
        int per_cu = 0;
        if (hipOccupancyMaxActiveBlocksPerMultiprocessor(&per_cu, (const void*)fwd, NWAVES * 64, LDS_BYTES) != hipSuccess || per_cu < 1) fprintf(stderr, "kernel_launch: occupancy query says %d\n", per_cu);
        (void)hipGetLastError();
        grid = cus;
    }
    if (grid < 0) return;
    (void)hipMemsetAsync(d_ws, 0, CTL_BYTES, stream);
    Args a{};
    for (int i = 0; i < 34; ++i) a.in[i] = d_in[i];
    a.out = (float*)d_out; a.ws = (unsigned char*)d_ws;
#if MK_PER_PHASE
#if MK_CHECK == 2
    (void)hipMemsetAsync((unsigned char*)d_ws + WS.end, 0, 4096, stream);
    for (int pass = 0; pass < 2; ++pass) {
        if (pass) (void)hipMemsetAsync(d_ws, 0, CTL_BYTES, stream);
        for (int p = 0; p < NPH; ++p) { a.ph_lo = p; a.ph_hi = p + 1; hipLaunchKernelGGL(fwd, dim3(grid), dim3(NWAVES * 64), LDS_BYTES, stream, a); diff_after_phase(pass, p, a, ws_size, stream); }
    }
    hipLaunchKernelGGL(diff_final, dim3(1024), dim3(256), 0, stream, (const float*)((unsigned char*)d_ws + WS.end), (float*)d_out);
#else
    for (int p = 0; p < NPH; ++p) { a.ph_lo = p; a.ph_hi = p + 1;
#if MK_CHECK == 1
        launch_checks_pre(p, a, stream);
#endif
        hipLaunchKernelGGL(fwd, dim3(grid), dim3(NWAVES * 64), LDS_BYTES, stream, a);
#if MK_CHECK == 1
        launch_checks(p, a, stream);
#endif
    }
#if MK_CHECK == 1
    launch_check_final(a, stream);
#endif
#endif
#else
    a.ph_lo = 0; a.ph_hi = NPH; hipLaunchKernelGGL(fwd, dim3(grid), dim3(NWAVES * 64), LDS_BYTES, stream, a);
#endif
    const hipError_t le = hipPeekAtLastError();
    if (le != hipSuccess) fprintf(stderr, "kernel_launch: launch failed: %s\n", hipGetErrorName(le));
}
```

```cpp
#include <hip/hip_runtime.h>
#include <cstdio>
#include <cstdint>

#ifndef MK_PER_PHASE
#define MK_PER_PHASE 0
#endif
#ifndef MK_CHECK
#define MK_CHECK 0
#endif

constexpr int SEQ = 8192, DM = 2048, DEPTH = 2, NMEM = 256;
constexpr int S5W = 1024, S5G = 64, S5H = 16, S5P = 64;
constexpr int NH = 16, QRANK = 448, KVRANK = 512, DNOPE = 128, DROPE = 64, DQK = 192, DV = 128;
constexpr int MEMH = 4, MEMD = 256, MEMW = 1024;
constexpr int DFF = 7168, NE = 8;
constexpr int INP = 9472;
constexpr int IN_COLS = 9216;
constexpr float EPS = 1e-6f;
constexpr float LOG2E = 1.4426950408889634f;
constexpr int ACT_ROWS = 2 * SEQ + NE * 256;
constexpr int KSPLIT = 4;

typedef unsigned short bf16;
typedef short bf16x8 __attribute__((ext_vector_type(8)));
typedef short s16x4 __attribute__((ext_vector_type(4)));
typedef float f32x4 __attribute__((ext_vector_type(4)));
typedef float f32x2 __attribute__((ext_vector_type(2)));
typedef float f32x16 __attribute__((ext_vector_type(16)));
typedef unsigned u32x4 __attribute__((ext_vector_type(4)));
typedef unsigned u32x2 __attribute__((ext_vector_type(2)));
#define GAS __attribute__((address_space(1)))
#define LAS __attribute__((address_space(3)))
typedef GAS unsigned gu32;
#define RLX_AGENT __ATOMIC_RELAXED, __HIP_MEMORY_SCOPE_AGENT
#define LDS_WAIT() asm volatile("s_waitcnt lgkmcnt(0)" ::: "memory")
#define VM_WAIT() asm volatile("s_waitcnt vmcnt(0)" ::: "memory")
#define SBAR() __builtin_amdgcn_sched_barrier(0)

typedef __bf16 bf16x2_t __attribute__((ext_vector_type(2)));
__device__ __forceinline__ unsigned cvt_pk_bf16(float lo, float hi) { f32x2 v = {lo, hi}; bf16x2_t b = __builtin_convertvector(v, bf16x2_t); return __builtin_bit_cast(unsigned, b); }
__device__ __forceinline__ unsigned f2bf(float f) { unsigned u = __builtin_bit_cast(unsigned, f); return (u + 0x7fffu + ((u >> 16) & 1u)) >> 16; }
__device__ __forceinline__ unsigned pk2(float lo, float hi) { return f2bf(lo) | (f2bf(hi) << 16); }
__device__ __forceinline__ float bf2f(unsigned short b) { return __builtin_bit_cast(float, ((unsigned)b) << 16); }
__device__ __forceinline__ float bflo(unsigned w) { return __builtin_bit_cast(float, w << 16); }
__device__ __forceinline__ float bfhi(unsigned w) { return __builtin_bit_cast(float, w & 0xffff0000u); }
__device__ __forceinline__ float sigmoidf_(float x) { return __builtin_amdgcn_rcpf(1.f + __builtin_amdgcn_exp2f(-x * LOG2E)); }
__device__ __forceinline__ int fresh_tid() { int t = threadIdx.x; asm volatile("" : "+v"(t)); return t; }
template <int N> __device__ __forceinline__ float sum_slots(const float* p) { f32x4 a = *(const f32x4*)p;
#pragma unroll
    for (int i = 1; i < N / 4; ++i) a = a + *(const f32x4*)(p + 4 * i);
    return (a[0] + a[1]) + (a[2] + a[3]); }
__device__ __forceinline__ float wave_sum(float v) {
#pragma unroll
    for (int o = 1; o < 64; o <<= 1) v += __shfl_xor(v, o);
    return v;
}

constexpr size_t al256(size_t x) { return (x + 255) & ~(size_t)255; }
constexpr size_t CTL_BYTES = 2u << 20;
constexpr int CW_TMO = 0, CW_CODE = 1;
constexpr int CW_BAR = 4096;
constexpr int CW_CNT = 8192;
constexpr int CW_CHK = 12288;
constexpr int SS_X = 0;
constexpr int SS_CQ = 4 * SEQ * 32;
constexpr int SS_CKV = SS_CQ + 2 * SEQ * 8;
constexpr int SS_KR = SS_CKV + 2 * SEQ * 8;
constexpr int SS_FLOATS = SS_KR + 2 * SEQ * 4;

struct WsMap {
    size_t w_in[2], w_glu[2], w_qb[2], w_kvb[2], w_mo[2], w_mkv[2], w_mwo[2], w_out[2], w_gu, w_dn, w_egu, w_edn;
    size_t xb, u, cq, ckv, kr, qm, gt, q, kk, vv, oa, om, ys, es, mf, mb, act, ym, kmem, vmem, memb, ropec, ropes;
    size_t lam[2], bb[2], cp[2], list, toke, toks, tokw, tmm, ssp, xq, rsc, wsc, act8, rsc2, gsc, w_inq[2], rss, end;
};
constexpr WsMap make_map() {
    WsMap m{}; size_t o = CTL_BYTES;
    auto take = [&](size_t bytes) { size_t r = o; o = al256(o + bytes); return r; };
    for (int l = 0; l < 2; ++l) {
        m.w_in[l] = take((size_t)INP * DM * 2); m.w_glu[l] = take((size_t)4096 * S5W * 2); m.w_qb[l] = take((size_t)4096 * 512 * 2); m.w_kvb[l] = take((size_t)4096 * 512 * 2);
        m.w_mo[l] = take((size_t)DM * DM * 2); m.w_mkv[l] = take((size_t)DM * DM * 2); m.w_mwo[l] = take((size_t)DM * MEMW * 2); m.w_out[l] = take((size_t)DM * DM * 2);
        m.lam[l] = take((size_t)S5G * S5P * 8); m.bb[l] = take((size_t)S5G * 128 * 16 * 2); m.cp[l] = take((size_t)S5G * 16 * 128 * 2);
    }
    m.w_gu = take((size_t)2 * DFF * DM * 2); m.w_dn = take((size_t)DM * DFF * 2);
    m.w_egu = take((size_t)NE * 2 * DFF * DM * 2); m.w_edn = take((size_t)NE * DM * DFF * 2);
    m.xb = take((size_t)SEQ * DM * 2); m.u = take((size_t)SEQ * S5W * 2); m.cq = take((size_t)SEQ * 512 * 2); m.ckv = take((size_t)SEQ * 512 * 2);
    m.kr = take((size_t)SEQ * 64 * 4); m.qm = take((size_t)SEQ * MEMW * 2); m.gt = take((size_t)SEQ * 3 * DM * 2);
    m.q = take((size_t)NH * SEQ * DQK * 2); m.kk = take((size_t)NH * SEQ * DQK * 2); m.vv = take((size_t)NH * SEQ * DV * 2);
    m.oa = take((size_t)SEQ * DM * 2); m.om = take((size_t)SEQ * MEMW * 2); m.ys = take((size_t)SEQ * S5W * 2); m.es = take((size_t)S5G * 128 * 128 * 4);
    m.mf = take((size_t)SEQ * DM * 4); m.mb = take((size_t)SEQ * DM * 2);
    m.act = take((size_t)ACT_ROWS * DFF * 2); m.ym = take((size_t)KSPLIT * ACT_ROWS * DM * 2);
    m.kmem = take((size_t)2 * MEMH * NMEM * MEMD * 2); m.vmem = take((size_t)2 * MEMH * NMEM * MEMD * 2); m.memb = take((size_t)NMEM * DM * 2);
    m.ropec = take((size_t)SEQ * 32 * 4); m.ropes = take((size_t)SEQ * 32 * 4);
    m.list = take((size_t)NE * SEQ * 4); m.toke = take((size_t)SEQ * 2 * 4); m.toks = take((size_t)SEQ * 2 * 4); m.tokw = take((size_t)SEQ * 2 * 4); m.tmm = take(2 * 128 * 4); m.ssp = take((size_t)SS_FLOATS * 4); m.xq = take((size_t)SEQ * DM); m.rsc = take((size_t)SEQ * 4); m.wsc = take(256); m.act8 = take((size_t)ACT_ROWS * DFF); m.rsc2 = take((size_t)ACT_ROWS * 4); m.gsc = take((size_t)NE * DM * 4); m.w_inq[0] = take((size_t)7168 * DM); m.w_inq[1] = take((size_t)7168 * DM); m.rss = take((size_t)NE * SEQ * 4);
    m.end = o; return m;
}
constexpr WsMap WS = make_map();

constexpr int RING_BYTES = 131072;
constexpr int XT_OFF = RING_BYTES;
constexpr int RK_OFF = XT_OFF + 4096;
constexpr int MISC_OFF = RK_OFF + 1024;
constexpr int GOFF_OFF = MISC_OFF + 256;
constexpr int TB2_OFF = GOFF_OFF + 8192;
constexpr int LDS_BYTES = 147456;
static_assert(TB2_OFF + 1024 <= LDS_BYTES, "LDS map");

#define XB_TMO      128
#define XB_XCNT(j)  (256  + 64 * (j))
#define XB_XSUB(j)  (1280 + 64 * (j))
#define XB_XGEN(j)  (2304 + 64 * (j))
#define XB_TOP      3328
#define XB_TOPGEN   3392
#define XCD_BAR_WORDS 3456
#define XB_SPIN_CAP (1u << 18)
__device__ __forceinline__ unsigned xb_ld(unsigned* p)              { return __hip_atomic_load(p, __ATOMIC_RELAXED, __HIP_MEMORY_SCOPE_AGENT); }
__device__ __forceinline__ unsigned xb_add(unsigned* p, unsigned v) { return __hip_atomic_fetch_add(p, v, __ATOMIC_RELAXED, __HIP_MEMORY_SCOPE_AGENT); }
__device__ __forceinline__ unsigned xb_xcc_id() { return (unsigned)__builtin_amdgcn_s_getreg((3 << 11) | 20) & 0xFu; }
#define XB_SPIN(cond, bar) do { unsigned _sp = 0; while (cond) { __builtin_amdgcn_s_sleep(1); \
    if ((++_sp & 255u) == 0u) { if (xb_ld(&(bar)[XB_TMO])) break; if (_sp > XB_SPIN_CAP) { atomicAdd(&(bar)[XB_TMO], 1u); break; } } } } while (0)
struct XcdBarrier { unsigned* bar; unsigned x; volatile LAS unsigned* st; };
__device__ __forceinline__ XcdBarrier xcd_barrier_post(unsigned* bar, volatile LAS unsigned* st) {
    XcdBarrier b; b.bar = bar; b.x = xb_xcc_id(); b.st = st;
    if (threadIdx.x == 0) (void)xb_add(&bar[XB_XCNT(b.x)], 1u);
    return b;
}
__device__ __forceinline__ void xcd_barrier_complete(unsigned* bar, unsigned x, unsigned& nloc, unsigned& nx) {
    const unsigned G = gridDim.x * gridDim.y * gridDim.z;
    unsigned sum, cnt, mine, sp = 0u;
    for (;;) {
        sum = 0u; cnt = 0u; mine = 0u;
#pragma unroll
        for (unsigned j = 0; j < 16; ++j) { const unsigned c = xb_ld(&bar[XB_XCNT(j)]); sum += c; cnt += (c > 0u) ? 1u : 0u; mine = (j == x) ? c : mine; }
        if (sum == G) break;
        __builtin_amdgcn_s_sleep(1);
        if ((++sp & 255u) == 0u) { if (xb_ld(&bar[XB_TMO])) break; if (sp > XB_SPIN_CAP) { atomicAdd(&bar[XB_TMO], 1u); break; } }
    }
    nloc = mine > 0u ? mine : 1u; nx = cnt > 0u ? cnt : 1u;
}
__device__ __forceinline__ void xcd_barrier(const XcdBarrier& b) {
    asm volatile("s_waitcnt vmcnt(0)" ::: "memory");
    __syncthreads();
    if (threadIdx.x == 0) {
        unsigned* bar = b.bar;
        __builtin_amdgcn_s_waitcnt(0);
        unsigned nloc = b.st[0], nx = b.st[1];
        if (nloc == 0u) { xcd_barrier_complete(bar, b.x, nloc, nx); b.st[0] = nloc; b.st[1] = nx; }
        const unsigned old = xb_add(&bar[XB_XSUB(b.x)], 1u);
        const unsigned gen = old / nloc;
        if (old + 1u == (gen + 1u) * nloc) {
            __builtin_amdgcn_fence(__ATOMIC_RELEASE, "agent");
            asm volatile("s_waitcnt vmcnt(0)" ::: "memory");
            const unsigned og = xb_add(&bar[XB_TOP], 1u);
            const unsigned tg = og / nx;
            if (og + 1u == (tg + 1u) * nx) xb_add(&bar[XB_TOPGEN], 1u);
            else XB_SPIN(xb_ld(&bar[XB_TOPGEN]) == tg, bar);
            __builtin_amdgcn_fence(__ATOMIC_ACQUIRE, "agent");
            xb_add(&bar[XB_XGEN(b.x)], 1u);
            asm volatile("s_waitcnt vmcnt(0)" ::: "memory");
        } else {
            XB_SPIN(xb_ld(&bar[XB_XGEN(b.x)]) == gen, bar);
            __builtin_amdgcn_fence(__ATOMIC_ACQUIRE, "agent");
            asm volatile("s_waitcnt vmcnt(0)" ::: "memory");
        }
    }
    __syncthreads();
}
namespace pg8 {
constexpr int BM = 256, BK = 64, HALF = 128, HTB = HALF * BK * 2, STAGE_BYTES = 8 * HTB, NXCD = 8, WGM = 8;
__host__ __device__ __forceinline__ int lds_byte(int r, int c) { const int st = (r >> 4) * 2 + (c >> 5), rr = r & 15, cc = c & 31, ob = rr * 64 + cc * 2; return st * 1024 + (ob ^ (((ob >> 9) & 1) << 5)); }
__host__ __device__ __forceinline__ void stage_rc(int b, int& R, int& C) { const int st = b / 1024, sb = b % 1024, swz = sb ^ (((sb >> 9) & 1) << 5); R = (st >> 1) * 16 + swz / 64; C = (st & 1) * 32 + (swz % 64) / 2; }
__host__ __device__ __forceinline__ int perm32(int rho) { const int n = rho >> 4, i = rho & 15; return 8 * (i >> 2) + 4 * n + (i & 3); }

struct Unit { int pm, pn, e, ks, p0, cnt; };
struct Gemm { const void* A; const void* Bt; int lda, ldb, K, es; };

__device__ __forceinline__ bool static_unit(int L, int nM, int nN, Unit& u) {
    const int nwg = nM * nN; if (L >= nwg) return false;
    int wgid = L; { const int q = nwg / NXCD, r = nwg % NXCD, xcd = wgid % NXCD, off = wgid / NXCD; wgid = (xcd < r ? xcd * (q + 1) : r * (q + 1) + (xcd - r) * q) + off; }
    const int nig = WGM * nN, gid = wgid / nig, fm = gid * WGM, gsz = (nM - fm) < WGM ? (nM - fm) : WGM;
    u.pm = fm + ((wgid % nig) % gsz); u.pn = (wgid % nig) / gsz; return true;
}
struct StaticOrder {
    static constexpr bool GATHER = false;
    int nM, nN, G, c;
    __device__ void init(int nM_, int nN_, int G_, int c_) { nM = nM_; nN = nN_; G = G_; c = c_; }
    __device__ bool next(int i, Unit& u) const { u.e = 0; u.ks = 0; u.p0 = 0; u.cnt = 0; return static_unit(i * G + c, nM, nN, u); }
    __device__ __forceinline__ const char* abase(const Gemm& g, const Unit& u) const { return (const char*)g.A + (size_t)u.pm * BM * g.lda * g.es; }
    __device__ __forceinline__ const char* bbase(const Gemm& g, const Unit& u) const { return (const char*)g.Bt + (size_t)u.pn * BM * g.ldb * g.es; }
    __device__ __forceinline__ unsigned tok(const Unit&, int) const { return 0u; }
};
struct BalOrder {
    static constexpr bool GATHER = false;
    int nM, nN, bid;
    __device__ bool next(int i, Unit& u) const { u.e = 0; u.ks = 0; u.p0 = 0; u.cnt = 0; const int x = bid & 7, j = bid >> 3; int k;
        if (j < 4) { if (i >= 2) return false; k = 2 * j + i; } else if (j < 30) { if (i >= 4) return false; k = 8 + 4 * (j - 4) + i; } else return false;
        return static_unit(x + 8 * k, nM, nN, u); }
    __device__ __forceinline__ const char* abase(const Gemm& g, const Unit& u) const { return (const char*)g.A + (size_t)u.pm * BM * g.lda * g.es; }
    __device__ __forceinline__ const char* bbase(const Gemm& g, const Unit& u) const { return (const char*)g.Bt + (size_t)u.pn * BM * g.ldb * g.es; }
    __device__ __forceinline__ unsigned tok(const Unit&, int) const { return 0u; }
};
struct GluOrder : StaticOrder {
    __device__ bool next(int i, Unit& u) const { u.e = 0; u.ks = 0; u.p0 = 0; u.cnt = 0; if (!static_unit((i >> 1) * G + c, nM, nN, u)) return false; u.pn = 2 * u.pn + (i & 1); return true; }
};
struct MemKvOrder {
    static constexpr bool GATHER = false;
    int G, c;
    __device__ bool next(int i, Unit& u) const { const int L = i * G + c; if (L >= 16) return false; u.pm = 0; u.pn = L & 7; u.e = L >> 3; u.ks = 0; u.p0 = 0; u.cnt = 0; return true; }
    __device__ __forceinline__ const char* abase(const Gemm& g, const Unit&) const { return (const char*)g.A; }
    __device__ __forceinline__ const char* bbase(const Gemm& g, const Unit& u) const { return (const char*)g.Bt + ((size_t)u.e * (WS.w_mkv[1] - WS.w_mkv[0])) + (size_t)u.pn * BM * g.ldb * g.es; }
    __device__ __forceinline__ unsigned tok(const Unit&, int) const { return 0u; }
};
template <bool GATHER_, int NKS> struct MoeOrder {
    static constexpr bool GATHER = GATHER_;
    const LAS int* tab; const int* list; int nN, G, c; size_t bstride; int pbase, pcnt;
    __device__ bool next(int i, Unit& u) const {
        int L = i * G + c; if (L >= pcnt * nN * NKS) return false;
        u.ks = L % NKS; L /= NKS;
        static_unit(L, pcnt, nN, u); u.pm += pbase;
        int e = 0;
#pragma unroll
        for (int j = 1; j < 8; ++j) e += (u.pm >= tab[j]) ? 1 : 0;
        u.e = e; u.p0 = tab[e]; u.cnt = tab[16 + e]; return true;
    }
    __device__ __forceinline__ const char* abase(const Gemm& g, const Unit& u) const { return GATHER_ ? (const char*)g.A : (const char*)g.A + ((size_t)u.pm * BM * g.lda + (size_t)u.ks * g.K) * g.es; }
    __device__ __forceinline__ const char* bbase(const Gemm& g, const Unit& u) const { return (const char*)g.Bt + (size_t)u.e * bstride + ((size_t)u.pn * BM * g.ldb + (size_t)u.ks * g.K) * g.es; }
    __device__ __forceinline__ unsigned tok(const Unit& u, int r) const { const int slot = (u.pm - u.p0) * BM + r; const bool in = slot < u.cnt; const unsigned t = (unsigned)list[u.e * SEQ + (in ? slot : 0)]; return in ? t : 0u; }
};

typedef f32x4 Acc[2][2][4][2];

typedef int i32x4 __attribute__((ext_vector_type(4)));
typedef int i32x8 __attribute__((ext_vector_type(8)));
template <class Epi, class Sched, int MODE = 0>
__device__ __forceinline__ void gemm_phase(LAS unsigned char* lds, const Gemm g, const Sched& S, const Epi& E) {
    const int tid = fresh_tid(), wid = __builtin_amdgcn_readfirstlane(tid >> 6), lane = tid & 63, wr = wid >> 2, wc = wid & 3, fr = lane & 15, fq = lane >> 4;
    constexpr int ES = MODE == 0 ? 2 : 1; constexpr bool I8 = MODE == 1, F8 = MODE == 2;
    const int K = g.K, nt = K * ES / (BK * 2);
    unsigned voffA[2], voffB[2];
#pragma unroll
    for (int i = 0; i < 2; ++i) { int R, C; stage_rc(tid * 16 + i * 8192, R, C); const int Rb = Epi::PERM ? ((R & ~31) + perm32(R & 31)) : R;
        voffA[i] = (unsigned)(R * g.lda * ES + C * 2); voffB[i] = (unsigned)(Rb * g.ldb * ES + C * 2); }
    const size_t kstep = (size_t)(BK * 2);
    const size_t hstepA = (size_t)HALF * g.lda * ES, hstepB = (size_t)HALF * g.ldb * ES;
    const unsigned ldsw = (unsigned)wid * 1024u;
    const int aoff = F8 ? lds_byte(wr * 64 + fr, fq * 16) : lds_byte(wr * 64 + fr, fq * 8), boff = F8 ? lds_byte(wc * 32 + fr, fq * 16) : lds_byte(wc * 32 + fr, fq * 8);

    const char* const gA = (const char*)g.A;
#define PG8_SA(b, h) (((b) * 2 + (h)) * HTB)
#define PG8_SB(b, h) ((4 + (b) * 2 + (h)) * HTB)
#define PG8_STAGE(bufoff, gbase, voff) do { _Pragma("unroll") for (int _i = 0; _i < 2; ++_i) \
        __builtin_amdgcn_global_load_lds((const unsigned*)((const char*)(gbase) + (voff)[_i]), (LAS unsigned*)(lds + (bufoff) + ldsw + _i * 8192), 16, 0, 0); } while (0)
#define PG8_STA1(bufoff, h) do { if constexpr (Sched::GATHER) PG8_STAGE(bufoff, gA + ka1, vc[h]); else PG8_STAGE(bufoff, a1 + (h) * hstepA, voffA); } while (0)
#define PG8_STA2(bufoff, h) do { if constexpr (Sched::GATHER) PG8_STAGE(bufoff, gA + ka2, vc[h]); else PG8_STAGE(bufoff, a2 + (h) * hstepA, voffA); } while (0)
#define PG8_STA3(bufoff, h) do { if constexpr (Sched::GATHER) PG8_STAGE(bufoff, gA + ka2 + kstep, vc[h]); else PG8_STAGE(bufoff, a3 + (h) * hstepA, voffA); } while (0)
#define PG8_LDA(dst, b, h) do { if constexpr (F8) { _Pragma("unroll") for (int m = 0; m < 4; ++m) dst##8[m] = *(const LAS i32x8*)(lds + PG8_SA(b, h) + aoff + m * 2048); } \
        else { _Pragma("unroll") for (int m = 0; m < 4; ++m) _Pragma("unroll") for (int k = 0; k < 2; ++k) dst[m][k] = *(const LAS bf16x8*)(lds + PG8_SA(b, h) + aoff + m * 2048 + k * 1024); } } while (0)
#define PG8_LDB(dst, b, h) do { if constexpr (F8) { _Pragma("unroll") for (int n = 0; n < 2; ++n) dst##8[n] = *(const LAS i32x8*)(lds + PG8_SB(b, h) + boff + n * 2048); } \
        else { _Pragma("unroll") for (int n = 0; n < 2; ++n) _Pragma("unroll") for (int k = 0; k < 2; ++k) dst[n][k] = *(const LAS bf16x8*)(lds + PG8_SB(b, h) + boff + n * 2048 + k * 1024); } } while (0)
#define PG8_MMA(ai, bj, At, Bt) do { __builtin_amdgcn_s_setprio(1); \
        if constexpr (F8) { _Pragma("unroll") for (int m = 0; m < 4; ++m) _Pragma("unroll") for (int n = 0; n < 2; ++n) \
            acc[ai][bj][m][n] = __builtin_amdgcn_mfma_scale_f32_16x16x128_f8f6f4(Bt##8[n], At##8[m], acc[ai][bj][m][n], 0, 0, 0, 0x7f7f7f7f, 0, 0x7f7f7f7f); } \
        else { _Pragma("unroll") for (int m = 0; m < 4; ++m) _Pragma("unroll") for (int n = 0; n < 2; ++n) _Pragma("unroll") for (int k = 0; k < 2; ++k) \
        { if constexpr (I8) acc[ai][bj][m][n] = __builtin_bit_cast(f32x4, __builtin_amdgcn_mfma_i32_16x16x64_i8(__builtin_bit_cast(i32x4, Bt[n][k]), __builtin_bit_cast(i32x4, At[m][k]), __builtin_bit_cast(i32x4, acc[ai][bj][m][n]), 0, 0, 0)); \
          else acc[ai][bj][m][n] = __builtin_amdgcn_mfma_f32_16x16x32_bf16(Bt[n][k], At[m][k], acc[ai][bj][m][n], 0, 0, 0); } } __builtin_amdgcn_s_setprio(0); } while (0)
#define PG8_WAIT_V(n) asm volatile("s_waitcnt vmcnt(" #n ")" ::: "memory")
#define PG8_WAIT_L(n) asm volatile("s_waitcnt lgkmcnt(" #n ")" ::: "memory")
#define PG8_BAR __builtin_amdgcn_s_barrier()
#define PG8_SCHED __builtin_amdgcn_sched_barrier(0)
#define PG8_GOFF(dst, u) do { const int _t = fresh_tid(); _Pragma("unroll") for (int _i = 0; _i < 2; ++_i) { int _R, _C; stage_rc(_t * 16 + _i * 8192, _R, _C); _Pragma("unroll") for (int _h = 0; _h < 2; ++_h) \
        dst[_h][_i] = S.tok(u, _h * HALF + _R) * (unsigned)(g.lda * ES) + (unsigned)(_C * 2); } } while (0)
    __builtin_amdgcn_s_waitcnt(0);
    Unit cur, nxt; int ui = 0;
    if (!S.next(0, cur)) return;
    Acc acc;
#pragma unroll
    for (int a = 0; a < 2; ++a)
#pragma unroll
        for (int b = 0; b < 2; ++b)
#pragma unroll
            for (int m = 0; m < 4; ++m)
#pragma unroll
                for (int n = 0; n < 2; ++n) acc[a][b][m][n] = (f32x4){0.f, 0.f, 0.f, 0.f};
    bf16x8 At[4][2], B0[2][2], B1[2][2]; i32x8 At8[4], B08[2], B18[2];
    const char* cA = S.abase(g, cur); const char* cB = S.bbase(g, cur);
    unsigned vc[2][2] = {{0u, 0u}, {0u, 0u}};
    if constexpr (Sched::GATHER) PG8_GOFF(vc, cur);
    {
        const char* a1 = cA; const size_t ka1 = 0;
        PG8_STAGE(PG8_SB(0, 0), cB, voffB); PG8_STAGE(PG8_SB(0, 1), cB + hstepB, voffB); PG8_STA1(PG8_SA(0, 0), 0); PG8_STA1(PG8_SA(0, 1), 1);
        if (wr == 1) PG8_BAR;
        PG8_WAIT_V(2); PG8_BAR;
    }
    {
        const char* a1 = cA + kstep; const size_t ka1 = kstep;
        PG8_STAGE(PG8_SB(1, 0), cB + kstep, voffB); PG8_STA1(PG8_SA(1, 0), 0); PG8_STAGE(PG8_SB(1, 1), cB + hstepB + kstep, voffB);
        PG8_WAIT_V(6); PG8_BAR;
    }
    for (;;) {
        const bool has_next = S.next(ui + 1, nxt);
        const char* nA = has_next ? S.abase(g, nxt) : cA; const char* nB = has_next ? S.bbase(g, nxt) : cB;
        if constexpr (Sched::GATHER) {
            unsigned tn[2][2];
            if (has_next) PG8_GOFF(tn, nxt); else {
#pragma unroll
                for (int _h = 0; _h < 2; ++_h) { tn[_h][0] = vc[_h][0]; tn[_h][1] = vc[_h][1]; } }
            *(LAS u32x4*)(lds + GOFF_OFF + fresh_tid() * 16) = (u32x4){tn[0][0], tn[0][1], tn[1][0], tn[1][1]}; }
        for (int t = 0; t < nt; t += 2) {
            const bool last = (t == nt - 2);
            const char* a1 = cA + (size_t)(t + 1) * kstep; const size_t ka1 = (size_t)(t + 1) * kstep;
            const char* a2 = last ? nA : cA + (size_t)(t + 2) * kstep; const char* b2 = last ? nB : cB + (size_t)(t + 2) * kstep;
            const size_t ka2 = last ? (size_t)0 : (size_t)(t + 2) * kstep;
            const char* a3 = a2 + kstep; const char* b3 = b2 + kstep;
            u32x4 nx_ = {0u, 0u, 0u, 0u};
            if constexpr (Sched::GATHER) { if (last) { nx_ = *(const LAS u32x4*)(lds + GOFF_OFF + fresh_tid() * 16); vc[0][0] = nx_[0]; vc[0][1] = nx_[1]; } }
            PG8_LDB(B0, 0, 0); PG8_LDB(B1, 0, 1); PG8_SCHED; PG8_LDA(At, 0, 0); PG8_STA1(PG8_SA(1, 1), 1);
            if constexpr (Sched::GATHER) { if (last) { vc[1][0] = nx_[2]; vc[1][1] = nx_[3]; } }
            PG8_WAIT_V(8); PG8_WAIT_L(0); PG8_BAR; PG8_MMA(0, 0, At, B0); PG8_MMA(0, 1, At, B1); PG8_BAR; PG8_SCHED;
            PG8_LDA(At, 0, 1); PG8_STAGE(PG8_SB(0, 0), b2, voffB); PG8_STAGE(PG8_SB(0, 1), b2 + hstepB, voffB); PG8_STA2(PG8_SA(0, 0), 0);
            PG8_WAIT_V(8); PG8_WAIT_L(0); PG8_BAR; PG8_MMA(1, 0, At, B0); PG8_MMA(1, 1, At, B1); PG8_BAR; PG8_SCHED;
            PG8_LDB(B0, 1, 0); PG8_LDB(B1, 1, 1); PG8_SCHED; PG8_LDA(At, 1, 0); PG8_STA2(PG8_SA(0, 1), 1);
            PG8_WAIT_V(8); PG8_WAIT_L(0); PG8_BAR; PG8_MMA(0, 0, At, B0); PG8_MMA(0, 1, At, B1); PG8_BAR; PG8_SCHED;
            PG8_LDA(At, 1, 1); PG8_STAGE(PG8_SB(1, 0), b3, voffB); PG8_STAGE(PG8_SB(1, 1), b3 + hstepB, voffB); PG8_STA3(PG8_SA(1, 0), 0);
            PG8_WAIT_V(8); PG8_WAIT_L(0); PG8_BAR; PG8_MMA(1, 0, At, B0); PG8_MMA(1, 1, At, B1); PG8_BAR; PG8_SCHED;
        }
        if (wr == 0) PG8_BAR;
        if constexpr (I8) {
#pragma unroll
            for (int a = 0; a < 2; ++a)
#pragma unroll
                for (int b = 0; b < 2; ++b)
#pragma unroll
                    for (int m = 0; m < 4; ++m)
#pragma unroll
                        for (int n = 0; n < 2; ++n) acc[a][b][m][n] = __builtin_convertvector(__builtin_bit_cast(i32x4, acc[a][b][m][n]), f32x4); }
        { const int t2_ = fresh_tid(), l2_ = t2_ & 63; E(acc, cur, wr, wc, l2_ & 15, l2_ >> 4, lds, t2_); }
        if (!has_next) break;
#pragma unroll
        for (int a = 0; a < 2; ++a)
#pragma unroll
            for (int b = 0; b < 2; ++b)
#pragma unroll
                for (int m = 0; m < 4; ++m)
#pragma unroll
                    for (int n = 0; n < 2; ++n) acc[a][b][m][n] = (f32x4){0.f, 0.f, 0.f, 0.f};
        cur = nxt; cA = nA; cB = nB; ++ui;
        if (wr == 1) PG8_BAR;
    }
    PG8_WAIT_V(0);
    PG8_BAR;
#undef PG8_SA
#undef PG8_SB
#undef PG8_STAGE
#undef PG8_STA1
#undef PG8_STA2
#undef PG8_STA3
#undef PG8_LDA
#undef PG8_LDB
#undef PG8_MMA
#undef PG8_WAIT_V
#undef PG8_WAIT_L
#undef PG8_BAR
#undef PG8_SCHED
#undef PG8_GOFF
}

__device__ __forceinline__ unsigned lds_addr(LAS unsigned char* lds, int off) { return (unsigned)(size_t)lds + (unsigned)off; }
__device__ __forceinline__ void lds_w32(unsigned a, float v) { asm volatile("ds_write_b32 %0, %1" :: "v"(a), "v"(v) : "memory"); }
__device__ __forceinline__ float lds_r32(unsigned a) { float r; asm volatile("ds_read_b32 %0, %1\n\ts_waitcnt lgkmcnt(0)" : "=v"(r) : "v"(a) : "memory"); return r; }
__device__ __forceinline__ void lds_r32x8(unsigned a, float (&r)[2][4]) {
    asm volatile("ds_read_b32 %0, %8\n\tds_read_b32 %1, %8 offset:64\n\tds_read_b32 %2, %8 offset:128\n\tds_read_b32 %3, %8 offset:192\n\tds_read_b32 %4, %8 offset:512\n\tds_read_b32 %5, %8 offset:576\n\tds_read_b32 %6, %8 offset:640\n\tds_read_b32 %7, %8 offset:704\n\ts_waitcnt lgkmcnt(0)"
                 : "=&v"(r[0][0]), "=&v"(r[0][1]), "=&v"(r[0][2]), "=&v"(r[0][3]), "=&v"(r[1][0]), "=&v"(r[1][1]), "=&v"(r[1][2]), "=&v"(r[1][3]) : "v"(a) : "memory"); }
__device__ __forceinline__ f32x4 lds_r128(unsigned a) { f32x4 r; asm volatile("ds_read_b128 %0, %1\n\ts_waitcnt lgkmcnt(0)" : "=v"(r) : "v"(a) : "memory"); return r; }
#define EPI_BAR() do { asm volatile("s_waitcnt lgkmcnt(0)" ::: "memory"); __builtin_amdgcn_s_barrier(); asm volatile("" ::: "memory"); } while (0)
__device__ __forceinline__ void rows_allreduce(float (&part)[2][4], LAS unsigned char* lds, int wr, int wc, int fr, int fq) {
    const unsigned xt = lds_addr(lds, XT_OFF);
#pragma unroll
    for (int ai = 0; ai < 2; ++ai)
#pragma unroll
        for (int m = 0; m < 4; ++m) { float s = part[ai][m]; s += __shfl_xor(s, 16); s += __shfl_xor(s, 32);
            if (fq == 0) lds_w32(xt + ((ai * HALF + wr * 64 + m * 16 + fr) * 4 + wc) * 4, s); }
    EPI_BAR();
    const unsigned xa = xt + (wr * 64 + fr) * 16;
#pragma unroll
    for (int ai = 0; ai < 2; ++ai) { f32x4 v0, v1, v2, v3;
        if (ai == 0) asm volatile("ds_read_b128 %0, %4\n\tds_read_b128 %1, %4 offset:256\n\tds_read_b128 %2, %4 offset:512\n\tds_read_b128 %3, %4 offset:768\n\ts_waitcnt lgkmcnt(0)" : "=&v"(v0), "=&v"(v1), "=&v"(v2), "=&v"(v3) : "v"(xa) : "memory");
        else asm volatile("ds_read_b128 %0, %4 offset:2048\n\tds_read_b128 %1, %4 offset:2304\n\tds_read_b128 %2, %4 offset:2560\n\tds_read_b128 %3, %4 offset:2816\n\ts_waitcnt lgkmcnt(0)" : "=&v"(v0), "=&v"(v1), "=&v"(v2), "=&v"(v3) : "v"(xa) : "memory");
        part[ai][0] = (v0[0] + v0[1]) + (v0[2] + v0[3]); part[ai][1] = (v1[0] + v1[1]) + (v1[2] + v1[3]); part[ai][2] = (v2[0] + v2[1]) + (v2[2] + v2[3]); part[ai][3] = (v3[0] + v3[1]) + (v3[2] + v3[3]); }
}
template <int NS> __device__ __forceinline__ void rows_slots(float (&part)[2][4], float* ssp, int row0, int fq, int slot) {
#pragma unroll
    for (int ai = 0; ai < 2; ++ai)
#pragma unroll
        for (int m = 0; m < 4; ++m) { float s = part[ai][m]; s += __shfl_xor(s, 16); s += __shfl_xor(s, 32);
            if (fq == 0) ssp[(size_t)(row0 + ai * HALF + m * 16) * NS + slot] = s; }
}
template <int NS> __device__ __forceinline__ void fill_row_table(LAS unsigned char* lds, int off, const float* ssp, size_t row_base, int tid, float inv_n, bool rsq) {
    const unsigned tb = lds_addr(lds, off);
    { if (tid < 256) { const float s = sum_slots<NS>(ssp + (row_base + tid) * NS); lds_w32(tb + tid * 4, rsq ? 1.0f / sqrtf(s * inv_n + EPS) : s); } }
    EPI_BAR();
}
__device__ __forceinline__ float sq4(f32x4 v) { return (v[0] * v[0] + v[1] * v[1]) + (v[2] * v[2] + v[3] * v[3]); }
__device__ __forceinline__ u32x4 pack8(f32x4 a, f32x4 b) { u32x4 w; w.x = cvt_pk_bf16(a[0], a[1]); w.y = cvt_pk_bf16(a[2], a[3]); w.z = cvt_pk_bf16(b[0], b[1]); w.w = cvt_pk_bf16(b[2], b[3]); return w; }
__device__ __forceinline__ u32x4 from_rowmajor(u32x4 v, int lane) { const int a = ((((lane & 15) << 2) | (lane >> 4)) << 2); u32x4 r;
    r.x = (unsigned)__builtin_amdgcn_ds_bpermute(a, (int)v.x); r.y = (unsigned)__builtin_amdgcn_ds_bpermute(a, (int)v.y); r.z = (unsigned)__builtin_amdgcn_ds_bpermute(a, (int)v.z); r.w = (unsigned)__builtin_amdgcn_ds_bpermute(a, (int)v.w); return r; }
__device__ __forceinline__ u32x2 from_rowmajor2(u32x2 v, int lane) { const int a = ((((lane & 15) << 2) | (lane >> 4)) << 2); u32x2 r;
    r.x = (unsigned)__builtin_amdgcn_ds_bpermute(a, (int)v.x); r.y = (unsigned)__builtin_amdgcn_ds_bpermute(a, (int)v.y); return r; }
__device__ __forceinline__ f32x4 from_rowmajor_f(f32x4 v, int lane) { return __builtin_bit_cast(f32x4, from_rowmajor(__builtin_bit_cast(u32x4, v), lane)); }
__device__ __forceinline__ u32x2 pack4(f32x4 a) { u32x2 w; w.x = cvt_pk_bf16(a[0], a[1]); w.y = cvt_pk_bf16(a[2], a[3]); return w; }
__device__ __forceinline__ f32x4 unpack4(u32x2 w) { return (f32x4){bflo(w.x), bfhi(w.x), bflo(w.y), bfhi(w.y)}; }
__device__ __forceinline__ unsigned pack4_u8(f32x4 g) { const float M = 8388608.0f;
    const unsigned u0 = __builtin_bit_cast(unsigned, __builtin_fmaf(g[0], 255.0f, M)), u1 = __builtin_bit_cast(unsigned, __builtin_fmaf(g[1], 255.0f, M)), u2 = __builtin_bit_cast(unsigned, __builtin_fmaf(g[2], 255.0f, M)), u3 = __builtin_bit_cast(unsigned, __builtin_fmaf(g[3], 255.0f, M));
    return __builtin_amdgcn_perm(u1, u0, 0x0c0c0400u) | __builtin_amdgcn_perm(u3, u2, 0x04000c0cu); }
__device__ __forceinline__ f32x4 unpack4_u8(unsigned w) { return (f32x4){(float)(w & 0xffu), (float)((w >> 8) & 0xffu), (float)((w >> 16) & 0xffu), (float)(w >> 24)} * (1.0f / 255.0f); }

struct EpiInProj {
    static constexpr bool PERM = true;
    const float* ssx; bf16 *U, *CQ, *CKV, *QM; unsigned char* GT; float* KR; float *ss_cq, *ss_ckv, *ss_kr; const float* qm_gain;
    __device__ __forceinline__ void operator()(Acc& acc, const Unit& u, int wr, int wc, int fr, int fq, LAS unsigned char* lds, int tid) const {
        asm volatile("" : "+v"(fr), "+v"(fq), "+v"(tid));
        const int pn = u.pn, row0 = u.pm * BM + wr * 64 + fr, cl = wc * 32 + 8 * fq;
        fill_row_table<32>(lds, RK_OFF, ssx, (size_t)u.pm * BM, tid, 1.0f / DM, true);
        float rs[2][4];
#pragma unroll
        for (int ai = 0; ai < 2; ++ai)
#pragma unroll
            for (int m = 0; m < 4; ++m) rs[ai][m] = 0.f;
        lds_r32x8(lds_addr(lds, RK_OFF) + (wr * 64 + fr) * 4, rs);
#pragma unroll
        for (int ai = 0; ai < 2; ++ai)
#pragma unroll
            for (int bj = 0; bj < 2; ++bj)
#pragma unroll
                for (int m = 0; m < 4; ++m)
#pragma unroll
                    for (int n = 0; n < 2; ++n) acc[ai][bj][m][n] = acc[ai][bj][m][n] * rs[ai][m];
        if (pn < 4 || (pn >= 4 && pn < 8)) {
            bf16* dst; int ld, c0; float* ss = nullptr; int tl = 0;
            if (pn < 4) { dst = U; ld = S5W; c0 = pn * 256; } else if (pn < 6) { dst = CQ; ld = 512; c0 = (pn - 4) * 256; ss = ss_cq; tl = pn - 4; } else { dst = CKV; ld = 512; c0 = (pn - 6) * 256; ss = ss_ckv; tl = pn - 6; }
            float part[2][4];
#pragma unroll
            for (int ai = 0; ai < 2; ++ai)
#pragma unroll
                for (int m = 0; m < 4; ++m) { bf16* rp = dst + (size_t)(row0 + ai * HALF + m * 16) * ld + c0 + cl; float s = 0.f;
#pragma unroll
                    for (int bj = 0; bj < 2; ++bj) { *(u32x4*)(rp + bj * HALF) = pack8(acc[ai][bj][m][0], acc[ai][bj][m][1]); s += sq4(acc[ai][bj][m][0]) + sq4(acc[ai][bj][m][1]); }
                    part[ai][m] = s; }
            if (ss) rows_slots<8>(part, ss, row0, fq, tl * 4 + wc);
        } else if (pn == 8) {
            float part[2][4];
#pragma unroll
            for (int ai = 0; ai < 2; ++ai)
#pragma unroll
                for (int m = 0; m < 4; ++m) { float s = 0.f;
                    if (wc < 2) { float* rp = KR + (size_t)(row0 + ai * HALF + m * 16) * 64 + cl; *(f32x4*)rp = acc[ai][0][m][0]; *(f32x4*)(rp + 4) = acc[ai][0][m][1]; s = sq4(acc[ai][0][m][0]) + sq4(acc[ai][0][m][1]); }
                    part[ai][m] = s; }
            rows_slots<4>(part, ss_kr, row0, fq, wc);
        } else if (pn < 13) {
            float part[2][4];
#pragma unroll
            for (int ai = 0; ai < 2; ++ai)
#pragma unroll
                for (int m = 0; m < 4; ++m) { float s = 0.f;
#pragma unroll
                    for (int bj = 0; bj < 2; ++bj) s += sq4(acc[ai][bj][m][0]) + sq4(acc[ai][bj][m][1]);
                    part[ai][m] = s; }
            rows_allreduce(part, lds, wr, wc, fr, fq);
            f32x4 gn[2][2];
#pragma unroll
            for (int bj = 0; bj < 2; ++bj)
#pragma unroll
                for (int n = 0; n < 2; ++n) gn[bj][n] = *(const f32x4*)(qm_gain + bj * HALF + cl + 4 * n) * (0.0625f * LOG2E);
#pragma unroll
            for (int ai = 0; ai < 2; ++ai)
#pragma unroll
                for (int m = 0; m < 4; ++m) { const float rq = 1.0f / sqrtf(part[ai][m] * (1.0f / MEMD) + EPS); bf16* rp = QM + (size_t)(row0 + ai * HALF + m * 16) * MEMW + (pn - 9) * 256 + cl;
#pragma unroll
                    for (int bj = 0; bj < 2; ++bj) *(u32x4*)(rp + bj * HALF) = pack8(acc[ai][bj][m][0] * gn[bj][0] * rq, acc[ai][bj][m][1] * gn[bj][1] * rq); }
        } else {
#pragma unroll
            for (int ai = 0; ai < 2; ++ai)
#pragma unroll
                for (int m = 0; m < 4; ++m) { unsigned char* rp = GT + (size_t)(row0 + ai * HALF + m * 16) * (3 * DM) + (pn - 13) * 256 + cl;
#pragma unroll
                    for (int bj = 0; bj < 2; ++bj) { f32x4 a = acc[ai][bj][m][0], b = acc[ai][bj][m][1];
#pragma unroll
                        for (int e = 0; e < 4; ++e) { a[e] = sigmoidf_(a[e]); b[e] = sigmoidf_(b[e]); }
                        *(u32x2*)(rp + bj * HALF) = (u32x2){pack4_u8(a), pack4_u8(b)}; } }
        }
    }
};

struct EpiGates {
    static constexpr bool PERM = true;
    const float* rsc; float wstep; unsigned char* GT;
    float wstep_q; bf16* QM; const float* qm_gain;
    __device__ __forceinline__ void operator()(Acc& acc, const Unit& u, int wr, int wc, int fr, int fq, LAS unsigned char* lds, int tid) const {
        asm volatile("" : "+v"(fr), "+v"(fq), "+v"(tid));
        const int row0 = u.pm * BM + wr * 64 + fr, cl = wc * 32 + 8 * fq;
        if (u.pn < 4) {
            float part[2][4];
#pragma unroll
            for (int ai = 0; ai < 2; ++ai)
#pragma unroll
                for (int m = 0; m < 4; ++m) { const float rs = rsc[row0 + ai * HALF + m * 16] * wstep_q; float s = 0.f;
#pragma unroll
                    for (int bj = 0; bj < 2; ++bj)
#pragma unroll
                        for (int n = 0; n < 2; ++n) { acc[ai][bj][m][n] = acc[ai][bj][m][n] * rs; s += sq4(acc[ai][bj][m][n]); }
                    part[ai][m] = s; }
            rows_allreduce(part, lds, wr, wc, fr, fq);
            f32x4 gn[2][2];
#pragma unroll
            for (int bj = 0; bj < 2; ++bj)
#pragma unroll
                for (int n = 0; n < 2; ++n) gn[bj][n] = *(const f32x4*)(qm_gain + bj * HALF + cl + 4 * n) * (0.0625f * LOG2E);
#pragma unroll
            for (int ai = 0; ai < 2; ++ai)
#pragma unroll
                for (int m = 0; m < 4; ++m) { const float rq = 1.0f / sqrtf(part[ai][m] * (1.0f / MEMD) + EPS); bf16* rp = QM + (size_t)(row0 + ai * HALF + m * 16) * MEMW + u.pn * 256 + cl;
#pragma unroll
                    for (int bj = 0; bj < 2; ++bj) *(u32x4*)(rp + bj * HALF) = pack8(acc[ai][bj][m][0] * gn[bj][0] * rq, acc[ai][bj][m][1] * gn[bj][1] * rq); }
            return;
        }
        float rgv[2][4];
#pragma unroll
        for (int ai = 0; ai < 2; ++ai)
#pragma unroll
            for (int m = 0; m < 4; ++m) { const float* rp_ = rsc + row0 + ai * HALF + m * 16; asm volatile("global_load_dword %0, %1, off" : "=v"(rgv[ai][m]) : "v"(rp_) : "memory"); }
        asm volatile("s_waitcnt vmcnt(0)" : "+v"(rgv[0][0]), "+v"(rgv[0][1]), "+v"(rgv[0][2]), "+v"(rgv[0][3]), "+v"(rgv[1][0]), "+v"(rgv[1][1]), "+v"(rgv[1][2]), "+v"(rgv[1][3]) :: "memory");
#pragma unroll
        for (int ai = 0; ai < 2; ++ai)
#pragma unroll
            for (int m = 0; m < 4; ++m) { const int row = row0 + ai * HALF + m * 16; const float rs = rgv[ai][m] * wstep; unsigned char* rp = GT + (size_t)row * (3 * DM) + (u.pn - 4) * 256 + cl;
#pragma unroll
                for (int bj = 0; bj < 2; ++bj) { f32x4 a = acc[ai][bj][m][0] * rs, b = acc[ai][bj][m][1] * rs;
#pragma unroll
                    for (int e = 0; e < 4; ++e) { a[e] = sigmoidf_(a[e]); b[e] = sigmoidf_(b[e]); }
                    *(u32x2*)(rp + bj * HALF) = (u32x2){pack4_u8(a), pack4_u8(b)}; } }
    }
};
struct EpiQ {
    static constexpr bool PERM = true;
    const float* ss_cq; const float* qn; const float* ropec; const float* ropes; bf16* Q;
    __device__ __forceinline__ void operator()(Acc& acc, const Unit& u, int wr, int wc, int fr, int fq, LAS unsigned char* lds, int tid) const {
        asm volatile("" : "+v"(fr), "+v"(fq), "+v"(tid));
        const int row0 = u.pm * BM + wr * 64 + fr, cl = wc * 32 + 8 * fq;
        fill_row_table<8>(lds, RK_OFF, ss_cq, (size_t)u.pm * BM, tid, 1.0f / QRANK, true);
        float part[2][4], av_[2][4]; lds_r32x8(lds_addr(lds, RK_OFF) + (wr * 64 + fr) * 4, av_);
#pragma unroll
        for (int ai = 0; ai < 2; ++ai)
#pragma unroll
            for (int m = 0; m < 4; ++m) { const float a = av_[ai][m]; float s = 0.f;
#pragma unroll
                for (int bj = 0; bj < 2; ++bj)
#pragma unroll
                    for (int n = 0; n < 2; ++n) { acc[ai][bj][m][n] = acc[ai][bj][m][n] * a; s += sq4(acc[ai][bj][m][n]); }
                part[ai][m] = s; }
        rows_allreduce(part, lds, wr, wc, fr, fq);
        const float SC = 0.07216878364870322f * LOG2E;
        { f32x4 g0 = *(const f32x4*)(qn + cl), g1 = *(const f32x4*)(qn + cl + 4);
#pragma unroll
          for (int ai = 0; ai < 2; ++ai)
#pragma unroll
            for (int m = 0; m < 4; ++m) { const float rq = SC / sqrtf(part[ai][m] * (1.0f / DQK) + EPS); bf16* rp = Q + ((size_t)u.pn * SEQ + row0 + ai * HALF + m * 16) * DQK + cl;
                *(u32x4*)rp = pack8(acc[ai][0][m][0] * g0 * rq, acc[ai][0][m][1] * g1 * rq); asm volatile("" ::: "memory"); } }
        if (wc < 2) {
            const int i0 = cl >> 1; float g1v[4], g2v[4];
#pragma unroll
            for (int j = 0; j < 4; ++j) { g1v[j] = qn[128 + i0 + j]; g2v[j] = qn[160 + i0 + j]; }
#pragma unroll
            for (int ai = 0; ai < 2; ++ai) { f32x4 csv[4], snv[4];
#pragma unroll
                for (int m = 0; m < 4; ++m) { const int row = row0 + ai * HALF + m * 16; csv[m] = *(const f32x4*)(ropec + (size_t)row * 32 + i0); snv[m] = *(const f32x4*)(ropes + (size_t)row * 32 + i0); }
#pragma unroll
                for (int m = 0; m < 4; ++m) { const int row = row0 + ai * HALF + m * 16; const float rq = SC / sqrtf(part[ai][m] * (1.0f / DQK) + EPS);
                    const f32x4 cs = csv[m], sn = snv[m];
                    f32x4 o0, o1;
                    { const float x1 = acc[ai][1][m][0][0] * g1v[0] * rq, x2 = acc[ai][1][m][0][1] * g2v[0] * rq; o0[0] = x1 * cs[0] - x2 * sn[0]; o0[1] = x2 * cs[0] + x1 * sn[0]; }
                    { const float x1 = acc[ai][1][m][0][2] * g1v[1] * rq, x2 = acc[ai][1][m][0][3] * g2v[1] * rq; o0[2] = x1 * cs[1] - x2 * sn[1]; o0[3] = x2 * cs[1] + x1 * sn[1]; }
                    { const float x1 = acc[ai][1][m][1][0] * g1v[2] * rq, x2 = acc[ai][1][m][1][1] * g2v[2] * rq; o1[0] = x1 * cs[2] - x2 * sn[2]; o1[1] = x2 * cs[2] + x1 * sn[2]; }
                    { const float x1 = acc[ai][1][m][1][2] * g1v[3] * rq, x2 = acc[ai][1][m][1][3] * g2v[3] * rq; o1[2] = x1 * cs[3] - x2 * sn[3]; o1[3] = x2 * cs[3] + x1 * sn[3]; }
                    *(u32x4*)(Q + ((size_t)u.pn * SEQ + row) * DQK + 128 + cl) = pack8(o0, o1); } }
        }
    }
};

struct EpiKV {
    static constexpr bool PERM = true;
    const float* ss_ckv; const float* ss_kr; const float* kn; const float* KR; const float* ropec; const float* ropes; bf16* Kc; bf16* Vc;
    __device__ __forceinline__ void operator()(Acc& acc, const Unit& u, int wr, int wc, int fr, int fq, LAS unsigned char* lds, int tid) const {
        asm volatile("" : "+v"(fr), "+v"(fq), "+v"(tid));
        const int row0 = u.pm * BM + wr * 64 + fr, cl = wc * 32 + 8 * fq;
        { if (tid < 256) lds_w32(lds_addr(lds, TB2_OFF) + tid * 4, sum_slots<4>(ss_kr + ((size_t)u.pm * BM + tid) * 4)); }
        fill_row_table<8>(lds, RK_OFF, ss_ckv, (size_t)u.pm * BM, tid, 1.0f / KVRANK, true);
        float part[2][4];
        float akv_[2][4]; lds_r32x8(lds_addr(lds, RK_OFF) + (wr * 64 + fr) * 4, akv_);
#pragma unroll
        for (int ai = 0; ai < 2; ++ai)
#pragma unroll
            for (int m = 0; m < 4; ++m) { const float a = akv_[ai][m];
#pragma unroll
                for (int bj = 0; bj < 2; ++bj)
#pragma unroll
                    for (int n = 0; n < 2; ++n) acc[ai][bj][m][n] = acc[ai][bj][m][n] * a;
                part[ai][m] = sq4(acc[ai][0][m][0]) + sq4(acc[ai][0][m][1]); }
        rows_allreduce(part, lds, wr, wc, fr, fq);
        const unsigned rkt = lds_addr(lds, RK_OFF);
        const f32x4 g0 = *(const f32x4*)(kn + cl), g1 = *(const f32x4*)(kn + cl + 4);
#pragma unroll
        for (int ai = 0; ai < 2; ++ai)
#pragma unroll
            for (int m = 0; m < 4; ++m) { const int row = row0 + ai * HALF + m * 16; const float rk = 1.0f / sqrtf((part[ai][m] + lds_r32(lds_addr(lds, TB2_OFF) + (ai * HALF + wr * 64 + m * 16 + fr) * 4)) * (1.0f / DQK) + EPS);
                *(u32x4*)(Kc + ((size_t)u.pn * SEQ + row) * DQK + cl) = pack8(acc[ai][0][m][0] * g0 * rk, acc[ai][0][m][1] * g1 * rk);
                *(u32x4*)(Vc + ((size_t)u.pn * SEQ + row) * DV + cl) = pack8(acc[ai][1][m][0], acc[ai][1][m][1]);
                if (wc == 0 && fq == 0) lds_w32(rkt + (ai * HALF + wr * 64 + m * 16 + fr) * 4, rk); }
        EPI_BAR();
        {
            const int rl = tid >> 1, i0 = (tid & 1) * 16, row = u.pm * BM + rl; const float rk = lds_r32(rkt + rl * 4);
            const float* kr = KR + (size_t)row * 64; bf16* dst = Kc + ((size_t)u.pn * SEQ + row) * DQK + 128 + 2 * i0;
#pragma unroll
            for (int j4 = 0; j4 < 4; ++j4) { const int i = i0 + 4 * j4;
                const f32x4 x1 = *(const f32x4*)(kr + i) * *(const f32x4*)(kn + 128 + i) * rk, x2 = *(const f32x4*)(kr + 32 + i) * *(const f32x4*)(kn + 160 + i) * rk;
                const f32x4 cs = *(const f32x4*)(ropec + (size_t)row * 32 + i), sn = *(const f32x4*)(ropes + (size_t)row * 32 + i);
                const f32x4 a = x1 * cs - x2 * sn, b = x2 * cs + x1 * sn;
                *(u32x4*)(dst + 8 * j4) = pack8((f32x4){a[0], b[0], a[1], b[1]}, (f32x4){a[2], b[2], a[3], b[3]}); }
        }
    }
};

struct EpiMemKV {
    static constexpr bool PERM = true;
    const float* kng[2]; bf16* KM; bf16* VM;
    __device__ __forceinline__ void operator()(Acc& acc, const Unit& u, int wr, int wc, int fr, int fq, LAS unsigned char* lds, int tid) const {
        asm volatile("" : "+v"(fr), "+v"(fq), "+v"(tid));
        const int rl0 = wr * 64 + fr, cl = wc * 32 + 8 * fq;
        float part[2][4];
#pragma unroll
        for (int ai = 0; ai < 2; ++ai)
#pragma unroll
            for (int m = 0; m < 4; ++m) { float s = 0.f;
#pragma unroll
                for (int bj = 0; bj < 2; ++bj) s += sq4(acc[ai][bj][m][0]) + sq4(acc[ai][bj][m][1]);
                part[ai][m] = s; }
        rows_allreduce(part, lds, wr, wc, fr, fq);
        const bool isk = u.pn < 4; const float* kg = u.e ? kng[1] : kng[0];
        bf16* dst = (isk ? KM : VM) + ((size_t)u.e * MEMH + (u.pn & 3)) * NMEM * MEMD;
#pragma unroll
        for (int ai = 0; ai < 2; ++ai)
#pragma unroll
            for (int m = 0; m < 4; ++m) { const float rk = isk ? 1.0f / sqrtf(part[ai][m] * (1.0f / MEMD) + EPS) : 1.0f;
#pragma unroll
                for (int bj = 0; bj < 2; ++bj) { f32x4 g0 = (f32x4){1.f, 1.f, 1.f, 1.f}, g1 = g0; if (isk) { g0 = *(const f32x4*)(kg + bj * HALF + cl); g1 = *(const f32x4*)(kg + bj * HALF + cl + 4); }
                    *(u32x4*)(dst + (size_t)(rl0 + ai * HALF + m * 16) * MEMD + bj * HALF + cl) = pack8(acc[ai][bj][m][0] * g0 * rk, acc[ai][bj][m][1] * g1 * rk); } }
    }
};

template <int MODE> struct EpiMerge {
    static constexpr bool PERM = true;
    const unsigned char* GT; bf16* MF;
    __device__ __forceinline__ void operator()(Acc& acc, const Unit& u, int wr, int wc, int fr, int fq, LAS unsigned char* lds, int tid) const {
        asm volatile("" : "+v"(fr), "+v"(fq), "+v"(tid));
        const int ln_ = tid & 63, dr_ = (ln_ >> 2) - fr, dq_ = (ln_ & 3) - fq;
        const int row0 = u.pm * BM + wr * 64 + fr, col0 = u.pn * BM + wc * 32 + 8 * fq;
#pragma unroll
        for (int ai = 0; ai < 2; ++ai) { u32x2 gv[4][2]; u32x4 ov[4][2];
#pragma unroll
            for (int m = 0; m < 4; ++m) { const size_t row = row0 + ai * HALF + m * 16;
#pragma unroll
                for (int bj = 0; bj < 2; ++bj) { const int c = col0 + bj * HALF; gv[m][bj] = *(const u32x2*)(GT + (row + dr_) * (3 * DM) + MODE * DM + c + dq_ * 8);
                    if (MODE == 2) ov[m][bj] = *(const u32x4*)(MF + (row + dr_) * DM + c + dq_ * 8); } }
#pragma unroll
            for (int m = 0; m < 4; ++m) { const size_t row = row0 + ai * HALF + m * 16;
#pragma unroll
                for (int bj = 0; bj < 2; ++bj) { const int c = col0 + bj * HALF; const u32x2 g = from_rowmajor2(gv[m][bj], ln_);
                    bf16* p = MF + row * DM + c; f32x4 lo = acc[ai][bj][m][0] * unpack4_u8(g.x), hi = acc[ai][bj][m][1] * unpack4_u8(g.y);
                    if (MODE == 2) { const u32x4 o = from_rowmajor(ov[m][bj], ln_); lo = lo + unpack4((u32x2){o.x, o.y}); hi = hi + unpack4((u32x2){o.z, o.w}); }
                    *(u32x4*)p = pack8(lo, hi); } } }
    }
};
struct EpiGlu {
    static constexpr bool PERM = true;
    const unsigned char* GT; const bf16* MF; bf16* MB;
    __device__ __forceinline__ void operator()(Acc& acc, const Unit& u, int wr, int wc, int fr, int fq, LAS unsigned char* lds, int tid) const {
        asm volatile("" : "+v"(fr), "+v"(fq), "+v"(tid));
        const int ln_ = tid & 63, dr_ = (ln_ >> 2) - fr, dq_ = (ln_ & 3) - fq;
        const int row0 = u.pm * BM + wr * 64 + fr, col0 = u.pn * HALF + wc * 32 + 8 * fq;
        u32x2 gv[2][4]; u32x4 ov[2][4];
#pragma unroll
        for (int ai = 0; ai < 2; ++ai)
#pragma unroll
            for (int m = 0; m < 4; ++m) { const size_t row = row0 + ai * HALF + m * 16;
                gv[ai][m] = *(const u32x2*)(GT + (row + dr_) * (3 * DM) + col0 + dq_ * 8); ov[ai][m] = *(const u32x4*)(MF + (row + dr_) * DM + col0 + dq_ * 8); }
#pragma unroll
        for (int ai = 0; ai < 2; ++ai)
#pragma unroll
            for (int m = 0; m < 4; ++m) { const size_t row = row0 + ai * HALF + m * 16;
                const u32x2 g = from_rowmajor2(gv[ai][m], ln_); const u32x4 o = from_rowmajor(ov[ai][m], ln_);
                f32x4 v[2] = {unpack4((u32x2){o.x, o.y}), unpack4((u32x2){o.z, o.w})}; const f32x4 gg[2] = {unpack4_u8(g.x), unpack4_u8(g.y)};
#pragma unroll
                for (int n = 0; n < 2; ++n) { const f32x4 ga = acc[ai][0][m][n], gb = acc[ai][1][m][n];
#pragma unroll
                    for (int e = 0; e < 4; ++e) v[n][e] += gg[n][e] * ga[e] * sigmoidf_(gb[e]); }
                *(u32x4*)(MB + row * DM + col0) = pack8(v[0], v[1]); }
    }
};
template <bool BASE16, bool WOUT> struct EpiResid {
    static constexpr bool PERM = true;
    const void* base; float* OUT; bf16* XBo; float* ss;
    __device__ __forceinline__ void operator()(Acc& acc, const Unit& u, int wr, int wc, int fr, int fq, LAS unsigned char* lds, int tid) const {
        asm volatile("" : "+v"(fr), "+v"(fq), "+v"(tid));
        const int ln_ = tid & 63, dr_ = (ln_ >> 2) - fr, dq_ = (ln_ & 3) - fq;
        const int row0 = u.pm * BM + wr * 64 + fr, col0 = u.pn * BM + wc * 32 + 8 * fq;
        float part[2][4];
#pragma unroll
        for (int ai = 0; ai < 2; ++ai) { u32x4 wv[4][2]; f32x4 fv[4][2][2];
#pragma unroll
            for (int m = 0; m < 4; ++m) { const size_t row = row0 + ai * HALF + m * 16;
#pragma unroll
                for (int bj = 0; bj < 2; ++bj) { const size_t o = row * DM + col0 + bj * HALF;
                    if constexpr (BASE16) wv[m][bj] = *(const u32x4*)((const bf16*)base + o + dr_ * DM + dq_ * 8);
                    else { fv[m][bj][0] = *(const f32x4*)((const float*)base + o + dr_ * DM + dq_ * 8); fv[m][bj][1] = *(const f32x4*)((const float*)base + o + dr_ * DM + dq_ * 8 + 4); } } }
#pragma unroll
            for (int m = 0; m < 4; ++m) { const size_t row = row0 + ai * HALF + m * 16; float s = 0.f;
#pragma unroll
                for (int bj = 0; bj < 2; ++bj) { const size_t o = row * DM + col0 + bj * HALF; f32x4 b0, b1;
                    if constexpr (BASE16) { const u32x4 w = from_rowmajor(wv[m][bj], ln_); b0 = unpack4((u32x2){w.x, w.y}); b1 = unpack4((u32x2){w.z, w.w}); }
                    else { b0 = from_rowmajor_f(fv[m][bj][0], ln_); b1 = from_rowmajor_f(fv[m][bj][1], ln_); }
                    const f32x4 v0 = acc[ai][bj][m][0] + b0, v1 = acc[ai][bj][m][1] + b1;
                    if constexpr (WOUT) { *(f32x4*)(OUT + o) = v0; *(f32x4*)(OUT + o + 4) = v1; }
                    if (XBo) *(u32x4*)(XBo + o) = pack8(v0, v1);
                    s += sq4(v0) + sq4(v1); }
                part[ai][m] = s; } }
        if (ss) rows_slots<32>(part, ss, row0, fq, u.pn * 4 + wc);
    }
};
constexpr float ACT_FP8_SCALE = 8.0f;
template <class Sched> struct EpiSwiGLU {
    static constexpr bool PERM = true;
    const float* ssx; bf16* ACT; const Sched* S; bool moe; const float* rsc; const float* wsc; unsigned char* ACT8;
    __device__ __forceinline__ void operator()(Acc& acc, const Unit& u, int wr, int wc, int fr, int fq, LAS unsigned char* lds, int tid) const {
        asm volatile("" : "+v"(fr), "+v"(fq), "+v"(tid));
        const int rl0 = wr * 64 + fr, cl = wc * 32 + 8 * fq;
        if (!moe) fill_row_table<32>(lds, RK_OFF, ssx, (size_t)u.pm * BM, tid, 1.0f / DM, true);
        float rsv[2][4];
#pragma unroll
        for (int ai = 0; ai < 2; ++ai)
#pragma unroll
            for (int m = 0; m < 4; ++m) { const int rl = rl0 + ai * HALF + m * 16; rsv[ai][m] = moe ? rsc[(size_t)u.e * SEQ + (u.pm - u.p0) * BM + rl] : 0.f; }
        if (!moe) lds_r32x8(lds_addr(lds, RK_OFF) + rl0 * 4, rsv);
        const float wse = moe ? wsc[u.e] : 1.0f;
#pragma unroll
        for (int ai = 0; ai < 2; ++ai)
#pragma unroll
            for (int m = 0; m < 4; ++m) { const int rl = rl0 + ai * HALF + m * 16;
                const float rs = rsv[ai][m] * wse;
                f32x4 o[2];
#pragma unroll
                for (int n = 0; n < 2; ++n) { const f32x4 gg = acc[ai][0][m][n] * rs, uu = acc[ai][1][m][n] * rs;
#pragma unroll
                    for (int e = 0; e < 4; ++e) o[n][e] = gg[e] * sigmoidf_(gg[e]) * uu[e]; }
                if (ACT8) { int w0 = 0, w1 = 0; w0 = __builtin_amdgcn_cvt_pk_fp8_f32(o[0][0] * ACT_FP8_SCALE, o[0][1] * ACT_FP8_SCALE, w0, false); w0 = __builtin_amdgcn_cvt_pk_fp8_f32(o[0][2] * ACT_FP8_SCALE, o[0][3] * ACT_FP8_SCALE, w0, true);
                    w1 = __builtin_amdgcn_cvt_pk_fp8_f32(o[1][0] * ACT_FP8_SCALE, o[1][1] * ACT_FP8_SCALE, w1, false); w1 = __builtin_amdgcn_cvt_pk_fp8_f32(o[1][2] * ACT_FP8_SCALE, o[1][3] * ACT_FP8_SCALE, w1, true);
                    *(u32x2*)(ACT8 + (size_t)(u.pm * BM + rl) * DFF + u.pn * HALF + cl) = (u32x2){(unsigned)w0, (unsigned)w1}; }
                else *(u32x4*)(ACT + (size_t)(u.pm * BM + rl) * DFF + u.pn * HALF + cl) = pack8(o[0], o[1]); }
    }
};
struct EpiMoeDown {
    static constexpr bool PERM = true;
    bf16* YM; const float* dsc; const float* rsc2;
    __device__ __forceinline__ void operator()(Acc& acc, const Unit& u, int wr, int wc, int fr, int fq, LAS unsigned char* lds, int tid) const {
        asm volatile("" : "+v"(fr), "+v"(fq), "+v"(tid));
        const int rl0 = wr * 64 + fr, cl = wc * 32 + 8 * fq;
        bf16* dst = YM + (size_t)u.ks * ACT_ROWS * DM; const float ds = dsc[u.e];
        float r2v[2][4];
#pragma unroll
        for (int ai = 0; ai < 2; ++ai)
#pragma unroll
            for (int m = 0; m < 4; ++m) r2v[ai][m] = rsc2[(size_t)(u.pm * BM + rl0 + ai * HALF + m * 16)];
#pragma unroll
        for (int ai = 0; ai < 2; ++ai)
#pragma unroll
            for (int m = 0; m < 4; ++m) { const size_t row = (size_t)(u.pm * BM + rl0 + ai * HALF + m * 16); bf16* rp = dst + row * DM + u.pn * BM + cl; const float dr = ds * r2v[ai][m];
#pragma unroll
                for (int bj = 0; bj < 2; ++bj) *(u32x4*)(rp + bj * HALF) = pack8(acc[ai][bj][m][0] * dr, acc[ai][bj][m][1] * dr); }
    }
};
}
namespace attn {
constexpr int A_KOFF = 0, A_VOFF = 65536, A_WS = 114688, A_POSK = 116736, A_LIST = 117248;
__device__ __forceinline__ int v_st(int k, int c) { const int kk = (k & ~0xC) | ((k & 4) << 1) | ((k & 8) >> 1); return ((kk >> 3) * 4 + (c >> 5)) * 512 + ((kk & 7) * 32 + (c & 31)) * 2; }
__device__ __forceinline__ int v_rd_base(int lane) { return ((lane & 3) << 3) | (((lane >> 2) & 3) << 6) | (((lane >> 4) & 1) << 5) | (((lane >> 5) & 1) << 8); }
constexpr int v_rd_off(int d0, int ks, int half) { return d0 * 512 + ks * 4096 + half * 2048; }
__device__ __forceinline__ int crow(int r, int hi) { return (r & 3) + 8 * (r >> 2) + 4 * hi; }
__device__ __forceinline__ void glds16(const void* gsrc, unsigned lds_dst) { unsigned keep;
    asm volatile("s_mov_b32 %0, m0\n\ts_mov_b32 m0, %2\n\ts_nop 0\n\tglobal_load_lds_dwordx4 %1, off\n\ts_mov_b32 m0, %0" : "=&s"(keep) : "v"(gsrc), "s"(lds_dst) : "memory"); }

template <int VBOFF>
__device__ __forceinline__ void pv_tile(f32x16* o, int vb0, bf16x8 pa0, bf16x8 pa1, bf16x8 pa2, bf16x8 pa3) {
#define TRRD(dst, off) asm volatile("ds_read_b64_tr_b16 %0, %1 offset:%2" : "=&v"(dst) : "v"(vb0), "i"(off) : "memory")
#define PV_RD(S, d0) do { constexpr int b_ = VBOFF + v_rd_off(d0, 0, 0); \
        TRRD(l##S[0], b_); TRRD(h##S[0], b_ + 2048); TRRD(l##S[1], b_ + 4096); TRRD(h##S[1], b_ + 6144); TRRD(l##S[2], b_ + 8192); TRRD(h##S[2], b_ + 10240); TRRD(l##S[3], b_ + 12288); TRRD(h##S[3], b_ + 14336); } while (0)
#define PV_MM(S, d0) do { \
        o[d0] = __builtin_amdgcn_mfma_f32_32x32x16_bf16(pa0, (bf16x8){l##S[0][0], l##S[0][1], l##S[0][2], l##S[0][3], h##S[0][0], h##S[0][1], h##S[0][2], h##S[0][3]}, o[d0], 0, 0, 0);   \
        o[d0] = __builtin_amdgcn_mfma_f32_32x32x16_bf16(pa1, (bf16x8){l##S[1][0], l##S[1][1], l##S[1][2], l##S[1][3], h##S[1][0], h##S[1][1], h##S[1][2], h##S[1][3]}, o[d0], 0, 0, 0);   \
        o[d0] = __builtin_amdgcn_mfma_f32_32x32x16_bf16(pa2, (bf16x8){l##S[2][0], l##S[2][1], l##S[2][2], l##S[2][3], h##S[2][0], h##S[2][1], h##S[2][2], h##S[2][3]}, o[d0], 0, 0, 0);   \
        o[d0] = __builtin_amdgcn_mfma_f32_32x32x16_bf16(pa3, (bf16x8){l##S[3][0], l##S[3][1], l##S[3][2], l##S[3][3], h##S[3][0], h##S[3][1], h##S[3][2], h##S[3][3]}, o[d0], 0, 0, 0); } while (0)
#define PV_W(n) do { asm volatile("s_waitcnt lgkmcnt(" #n ")" ::: "memory"); SBAR(); } while (0)
    s16x4 lA[4], hA[4], lB[4], hB[4];
    PV_RD(A, 0); PV_RD(B, 1); PV_W(8); PV_MM(A, 0); SBAR();
    PV_RD(A, 2); PV_W(8); PV_MM(B, 1); SBAR();
    PV_RD(B, 3); PV_W(8); PV_MM(A, 2); SBAR();
    PV_W(0); PV_MM(B, 3);
#undef PV_W
#undef PV_MM
#undef PV_RD
#undef TRRD
}

template <int DQ, bool CAUSAL, int qstride, int vstride, int ostride, bool QREG, class CV>
__device__ __forceinline__ void attn_item(CV& cv, char* lds, LAS unsigned char* ldsl, const bf16* Qb, const bf16* Kh, const bf16* Vh, bf16* Ob,
                                          const int* pos, int q0, int nkt, const int* tmin, const int* tmax) {
    constexpr int KSTR = DQ * 2, KBYTES = 64 * KSTR, NCH = DQ / 64, CPR = DQ / 8, ND0 = DQ / 16;
#define KSW(r) (DQ == 192 ? (((r) >> 1) & 7) : ((r) & 7))
    const int tid = fresh_tid(), wid = __builtin_amdgcn_readfirstlane(tid >> 6), lane = tid & 63, r32 = lane & 31, hi = lane >> 5;
    char* K_lds = lds + A_KOFF; char* V_lds = lds + A_VOFF;
    float* wsf = (float*)(lds + A_WS) + wid * 64; float* li_l = wsf; float* al_l = wsf + 32;
    int* posk = (int*)(lds + A_POSK); int* tlist = (int*)(lds + A_LIST); int* tmxl = tlist + 132;
    int NT = nkt;
    if constexpr (CAUSAL) {
        if (wid == 0) {
            const int qt = q0 >> 6; int qmax = tmax[qt]; qmax = max(qmax, tmax[qt + 1]); qmax = max(qmax, tmax[qt + 2]); qmax = max(qmax, tmax[qt + 3]);
            const bool n0 = lane < nkt && tmin[lane] <= qmax, n1 = lane + 64 < nkt && tmin[lane + 64] <= qmax;
            const unsigned long long b0 = __ballot(n0), b1 = __ballot(n1); const int c0 = __popcll(b0);
            const unsigned long long below = (lane == 0) ? 0ull : (~0ull >> (64 - lane));
            if (n0) { const int ix = __popcll(b0 & below); tlist[ix] = lane; tmxl[ix] = tmax[lane]; }
            if (n1) { const int ix = c0 + __popcll(b1 & below); tlist[ix] = lane + 64; tmxl[ix] = tmax[lane + 64]; }
            if (lane == 0) tlist[128] = c0 + __popcll(b1);
        }
        __syncthreads();
        NT = tlist[128];
    }
#define TILE(t) (CAUSAL ? __builtin_amdgcn_readfirstlane(tlist[t]) : (t))
    int ksrc[NCH], vsrc[2];
#pragma unroll
    for (int jj = 0; jj < NCH; ++jj) { const int p = jj * 512 + tid, row = p / CPR, cs = p % CPR, cc = (cs & ~7) | ((cs & 7) ^ KSW(row)); ksrc[jj] = row * DQ + cc * 8; }
#pragma unroll
    for (int jj = 0; jj < 2; ++jj) { const int p = jj * 512 + tid, kk = (p >> 7) * 8 + ((p & 31) >> 2), k = (kk & ~0xC) | ((kk & 4) << 1) | ((kk & 8) >> 1), cv = ((p >> 5) & 3) * 32 + (p & 3) * 8; vsrc[jj] = k * vstride + cv; }
    int stP = 0;
    const unsigned ldsbase = (unsigned)__builtin_amdgcn_readfirstlane((int)(unsigned)(size_t)ldsl + wid * 1024);
#define A_STAGE(tile_, bf, vbf) do { const int kb_ = (tile_) * 64; \
        _Pragma("unroll") for (int jj = 0; jj < NCH; ++jj) glds16(Kh + (size_t)kb_ * DQ + ksrc[jj], ldsbase + A_KOFF + (bf) * KBYTES + jj * 8192); \
        _Pragma("unroll") for (int jj = 0; jj < 2; ++jj) glds16(Vh + (size_t)kb_ * vstride + vsrc[jj], ldsbase + A_VOFF + (vbf) * 16384 + jj * 8192); \
        if (CAUSAL && tid < 64) stP = pos[kb_ + tid]; } while (0)
#define A_POSW(bf) do { if (CAUSAL && tid < 64) posk[(bf) * 64 + tid] = stP; } while (0)
    A_STAGE(TILE(0), 0, 0);
    bf16x8 qr[QREG ? ND0 : 1];
    if constexpr (QREG) {
#pragma unroll
        for (int d0 = 0; d0 < ND0; ++d0) qr[d0] = *(const bf16x8*)(Qb + (size_t)(wid * 32 + r32) * qstride + d0 * 16 + hi * 8); }
    int wminq = 0;
    if constexpr (CAUSAL) { int v = pos[q0 + wid * 32 + r32];
#pragma unroll
        for (int o_ = 1; o_ < 32; o_ <<= 1) v = min(v, __shfl_xor(v, o_));
        wminq = __builtin_amdgcn_readfirstlane(v); }
    A_POSW(0);
    asm volatile("s_waitcnt vmcnt(0)" ::: "memory");
    if constexpr (QREG) {
#pragma unroll
        for (int d0 = 0; d0 < ND0; ++d0) asm volatile("" : "+v"(qr[d0]));
    }
    __syncthreads();
    float m_reg = -1e30f, l_reg = 0.f; f32x16 o[4] = {};
    const int vb0 = (int)(uintptr_t)V_lds + v_rd_base(lane);
    int kbv[4];
#pragma unroll
    for (int dd = 0; dd < 4; ++dd) kbv[dd] = r32 * KSTR + (((dd * 2 + hi) ^ KSW(r32)) << 4);
    bf16x8 pa0 = {}, pa1 = {}, pa2 = {}, pa3 = {};
    int vcur = 0;
    if (wid >= 4) __builtin_amdgcn_s_setprio(1);
#define PK4(P, B_, OUT) do { unsigned a0 = cvt_pk_bf16(P[B_+0], P[B_+1]), a1 = cvt_pk_bf16(P[B_+2], P[B_+3]); \
        unsigned b0 = cvt_pk_bf16(P[B_+4], P[B_+5]), b1 = cvt_pk_bf16(P[B_+6], P[B_+7]); \
        auto r0 = __builtin_amdgcn_permlane32_swap(a0, b0, false, false); auto r1 = __builtin_amdgcn_permlane32_swap(a1, b1, false, false); \
        u32x4 w = {r0[0], r1[0], r0[1], r1[1]}; OUT = *reinterpret_cast<bf16x8*>(&w); } while (0)
#define SM_SLICE(b_) do { \
        if ((b_) == 0) { pmax_ = p0[0]; _Pragma("unroll") for (int r = 1; r < 16; ++r) pmax_ = fmaxf(pmax_, p0[r]); _Pragma("unroll") for (int r = 0; r < 16; ++r) pmax_ = fmaxf(pmax_, p1[r]); } \
        else if ((b_) == 1) { auto rr = __builtin_amdgcn_permlane32_swap(__float_as_uint(pmax_), __float_as_uint(pmax_), false, false); pmax_ = fmaxf(__uint_as_float(rr[0]), __uint_as_float(rr[1])); \
            const bool keep_ = __all(pmax_ - m_reg <= 8.0f); mn_ = keep_ ? m_reg : fmaxf(m_reg, pmax_); alpha_ = keep_ ? 1.0f : __builtin_amdgcn_exp2f(m_reg - mn_); m_reg = mn_; \
            _Pragma("unroll") for (int r = 0; r < 16; ++r) { p0[r] = __builtin_amdgcn_exp2f(p0[r] - mn_); ps_ += p0[r]; } } \
        else if ((b_) == 2) { _Pragma("unroll") for (int r = 0; r < 16; ++r) { p1[r] = __builtin_amdgcn_exp2f(p1[r] - mn_); ps_ += p1[r]; } } \
        else { auto rr = __builtin_amdgcn_permlane32_swap(__float_as_uint(ps_), __float_as_uint(ps_), false, false); l_reg = l_reg * alpha_ + (__uint_as_float(rr[0]) + __uint_as_float(rr[1])); } } while (0)
#define TRRD(dst, off) asm volatile("ds_read_b64_tr_b16 %0, %1 offset:%2" : "=&v"(dst) : "v"(vbx_), "i"(off) : "memory")
#define PV_RD(S, d0) do { constexpr int b_ = v_rd_off(d0, 0, 0); \
        TRRD(l##S[0], b_); TRRD(h##S[0], b_ + 2048); TRRD(l##S[1], b_ + 4096); TRRD(h##S[1], b_ + 6144); TRRD(l##S[2], b_ + 8192); TRRD(h##S[2], b_ + 10240); TRRD(l##S[3], b_ + 12288); TRRD(h##S[3], b_ + 14336); } while (0)
#define PV_MM(S, d0) do { \
        o[d0] = __builtin_amdgcn_mfma_f32_32x32x16_bf16(pa0, (bf16x8){l##S[0][0], l##S[0][1], l##S[0][2], l##S[0][3], h##S[0][0], h##S[0][1], h##S[0][2], h##S[0][3]}, o[d0], 0, 0, 0);   \
        o[d0] = __builtin_amdgcn_mfma_f32_32x32x16_bf16(pa1, (bf16x8){l##S[1][0], l##S[1][1], l##S[1][2], l##S[1][3], h##S[1][0], h##S[1][1], h##S[1][2], h##S[1][3]}, o[d0], 0, 0, 0);   \
        o[d0] = __builtin_amdgcn_mfma_f32_32x32x16_bf16(pa2, (bf16x8){l##S[2][0], l##S[2][1], l##S[2][2], l##S[2][3], h##S[2][0], h##S[2][1], h##S[2][2], h##S[2][3]}, o[d0], 0, 0, 0);   \
        o[d0] = __builtin_amdgcn_mfma_f32_32x32x16_bf16(pa3, (bf16x8){l##S[3][0], l##S[3][1], l##S[3][2], l##S[3][3], h##S[3][0], h##S[3][1], h##S[3][2], h##S[3][3]}, o[d0], 0, 0, 0); } while (0)
#define PV_W(n) do { asm volatile("s_waitcnt lgkmcnt(" #n ")" ::: "memory"); SBAR(); } while (0)
#define TILE_ITER(DOPV_) do { \
        const int buf = t & 1; \
        const int vnext = vcur == 2 ? 0 : vcur + 1, vprev = vcur == 0 ? 2 : vcur - 1; \
        cv.finish();                                                   \
        if (t + 1 < NT) { if (buf == 0) A_STAGE(TILE(t + 1), 1, vnext); else A_STAGE(TILE(t + 1), 0, vnext); } \
        cv.issue();                                                    \
        SBAR(); \
        f32x16 p0 = {}, p1 = {}; \
        { const char* kb_ = K_lds + buf * KBYTES; int qo = (wid * 32 + r32) * qstride + hi * 8; if (!QREG) asm volatile("" : "+v"(qo)); \
          bf16x8 ka[2][2];                                             \
          bf16x8 qn_ = {}; if constexpr (!QREG) qn_ = *(const bf16x8*)(Qb + qo);        \
          KRD(0); SBAR(); \
          _Pragma("unroll") for (int d0 = 0; d0 < ND0; ++d0) { \
              if (d0 + 1 < ND0) KRD(d0 + 1); \
              bf16x8 qf; if constexpr (QREG) qf = qr[d0]; else { qf = qn_; if (d0 + 1 < ND0) qn_ = *(const bf16x8*)(Qb + qo + (d0 + 1) * 16); } \
              SBAR(); \
              p0 = __builtin_amdgcn_mfma_f32_32x32x16_bf16(ka[d0 & 1][0], qf, p0, 0, 0, 0); \
              p1 = __builtin_amdgcn_mfma_f32_32x32x16_bf16(ka[d0 & 1][1], qf, p1, 0, 0, 0); SBAR(); } } \
        if constexpr (CAUSAL) { \
            if (__builtin_amdgcn_readfirstlane(tmxl[t]) > wminq) {                         \
                const float NEG = -__builtin_inff(); const int* pk = posk + buf * 64 + 4 * hi; const int posq = pos[q0 + wid * 32 + (fresh_tid() & 31)];        \
                _Pragma("unroll") for (int g = 0; g < 4; ++g) { const int4 k0 = *(const int4*)(pk + 8 * g), k1 = *(const int4*)(pk + 32 + 8 * g); \
                    if (k0.x > posq) p0[4 * g + 0] = NEG; if (k0.y > posq) p0[4 * g + 1] = NEG; if (k0.z > posq) p0[4 * g + 2] = NEG; if (k0.w > posq) p0[4 * g + 3] = NEG; \
                    if (k1.x > posq) p1[4 * g + 0] = NEG; if (k1.y > posq) p1[4 * g + 1] = NEG; if (k1.z > posq) p1[4 * g + 2] = NEG; if (k1.w > posq) p1[4 * g + 3] = NEG; } \
            } } \
        SBAR(); \
        float pmax_ = 0.f, mn_ = 0.f, alpha_ = 1.f, ps_ = 0.f; \
        if (DOPV_) { const int vbx_ = vb0 + vprev * 16384; s16x4 lA[4], hA[4], lB[4], hB[4]; \
            PV_RD(A, 0); PV_RD(B, 1); PV_W(8); PV_MM(A, 0); SM_SLICE(0); SBAR(); \
            PV_RD(A, 2); PV_W(8); PV_MM(B, 1); SM_SLICE(1); SBAR(); \
            PV_RD(B, 3); PV_W(8); PV_MM(A, 2); SM_SLICE(2); SBAR(); \
            PV_W(0); PV_MM(B, 3); SM_SLICE(3); SBAR(); } \
        else { SM_SLICE(0); SM_SLICE(1); SM_SLICE(2); SM_SLICE(3); SBAR(); } \
        if (__any(alpha_ < 1.f)) { if (hi == 0) al_l[r32] = alpha_; asm volatile("s_waitcnt lgkmcnt(0)" ::: "memory"); \
            _Pragma("unroll") for (int r = 0; r < 16; ++r) { const float a = al_l[crow(r, hi)]; \
                _Pragma("unroll") for (int d_ = 0; d_ < 4; ++d_) o[d_][r] *= a; } } \
        PK4(p0, 0, pa0); PK4(p0, 8, pa1); PK4(p1, 0, pa2); PK4(p1, 8, pa3);        \
        SBAR(); \
        vcur = vnext; \
        if (t + 1 < NT) { if (buf == 0) A_POSW(1); else A_POSW(0); } \
        if (cv.pending()) asm volatile("s_waitcnt vmcnt(16)" ::: "memory"); else asm volatile("s_waitcnt vmcnt(0)" ::: "memory");        \
        __syncthreads(); } while (0)
#define KRD(d0_) do { const char* a_ = kb_ + kbv[(d0_) & 3] + ((d0_) >> 2) * 128; ka[(d0_) & 1][0] = *(const bf16x8*)a_; ka[(d0_) & 1][1] = *(const bf16x8*)(a_ + 32 * KSTR); } while (0)
    { const int t = 0; TILE_ITER(false); }
    for (int t = 1; t < NT; ++t) TILE_ITER(true);
    {
        const int vlast = vcur == 0 ? 2 : vcur - 1; const int vbx_ = vb0 + vlast * 16384; s16x4 lA[4], hA[4], lB[4], hB[4];
        PV_RD(A, 0); PV_RD(B, 1); PV_W(8); PV_MM(A, 0); SBAR();
        PV_RD(A, 2); PV_W(8); PV_MM(B, 1); SBAR();
        PV_RD(B, 3); PV_W(8); PV_MM(A, 2); SBAR();
        PV_W(0); PV_MM(B, 3); }
#undef KRD
#undef TILE_ITER
#undef PV_W
#undef PV_MM
#undef PV_RD
#undef TRRD
#undef SM_SLICE
#undef PK4
    __builtin_amdgcn_s_setprio(0);
    if (hi == 0) li_l[r32] = l_reg; asm volatile("s_waitcnt lgkmcnt(0)" ::: "memory");
    int oofs = (wid * 32 + 4 * hi) * ostride + r32; asm volatile("" : "+v"(oofs));
    bf16* Ow = Ob + oofs;
#pragma unroll
    for (int r = 0; r < 16; ++r) { constexpr int dummy = 0; (void)dummy; const int orow = crow(r, hi); const float rl = __builtin_amdgcn_rcpf(li_l[orow]);
#pragma unroll
        for (int d0 = 0; d0 < 4; ++d0) { const float v = o[d0][r] * rl; const float vn = __shfl_xor(v, 1);
            if ((r32 & 1) == 0) *(unsigned*)(Ow + ((r & 3) + 8 * (r >> 2)) * ostride + d0 * 32) = cvt_pk_bf16(v, vn); } }
    __syncthreads();
#undef A_STAGE
#undef A_POSW
#undef KSW
#undef TILE
}
}
namespace s5 {
constexpr int TROW = 136;
constexpr int WAVE_LDS = 32 * TROW * 2;
__device__ __forceinline__ void cmul(float ar, float ai, float br, float bi, float& cr, float& ci) { cr = ar * br - ai * bi; ci = ar * bi + ai * br; }
__device__ __forceinline__ float gelu_tanh(float x) { const float z = 1.5957691216057308f * (x + 0.044715f * x * x * x); return x * sigmoidf_(z); }

template <int PART>
__device__ __forceinline__ void s5_wave(char* ldsw, int g, int c0, const bf16* U, const f32x2* LAM, const bf16* BB, const bf16* CP, const float* Dd, float* ES, bf16* YS, int lane) {
    const int c = lane & 31, hi = lane >> 5;
    float l1r[2], l1i[2], l2r[2], l2i[2], l3r[2], l3i[2], l4r[2], l4i[2];
    bf16x8 bfrag[2][2];
#pragma unroll
    for (int sb = 0; sb < 2; ++sb) { const f32x2 lm = LAM[g * 64 + 32 * sb + c]; l1r[sb] = lm.x; l1i[sb] = lm.y;
        cmul(l1r[sb], l1i[sb], l1r[sb], l1i[sb], l2r[sb], l2i[sb]); cmul(l2r[sb], l2i[sb], l1r[sb], l1i[sb], l3r[sb], l3i[sb]); cmul(l2r[sb], l2i[sb], l2r[sb], l2i[sb], l4r[sb], l4i[sb]);
#pragma unroll
        for (int ri = 0; ri < 2; ++ri) bfrag[sb][ri] = *(const bf16x8*)(BB + ((size_t)(g * 128 + 64 * ri + 32 * sb + c)) * 16 + 8 * hi); }
    float sr[2] = {0.f, 0.f}, si[2] = {0.f, 0.f};
    bf16x8 cpf[8];
    if constexpr (PART == 2) {
        float l64r[2], l64i[2];
#pragma unroll
        for (int sb = 0; sb < 2; ++sb) { float ar = l4r[sb], ai = l4i[sb];
#pragma unroll
            for (int k = 0; k < 4; ++k) { float tr, ti; cmul(ar, ai, ar, ai, tr, ti); ar = tr; ai = ti; }
            l64r[sb] = ar; l64i[sb] = ai; }
        for (int cc = 0; cc < c0; ++cc) { const float* e = ES + ((size_t)g * 128 + cc) * 128;
#pragma unroll
            for (int sb = 0; sb < 2; ++sb) { const float er = e[32 * sb + c], ei = e[64 + 32 * sb + c]; float tr, ti; cmul(l64r[sb], l64i[sb], sr[sb], si[sb], tr, ti); sr[sb] = tr + er; si[sb] = ti + ei; } }
#pragma unroll
        for (int ks = 0; ks < 8; ++ks) { cpf[ks] = (bf16x8){0, 0, 0, 0, 0, 0, 0, 0}; if (c < 16) cpf[ks] = *(const bf16x8*)(CP + ((size_t)(g * 16 + c)) * 128 + 16 * ks + 8 * hi); }
    }
    bf16* T = (bf16*)ldsw;
    bf16x8 afn = *(const bf16x8*)(U + (size_t)(c0 * 2 * 32 + c) * S5W + g * 16 + 8 * hi);
    f32x4 da = {}, db = {};
    if constexpr (PART == 2) { da = *(const f32x4*)(Dd + g * 16 + 4 * hi); db = *(const f32x4*)(Dd + g * 16 + 8 + 4 * hi); }
    for (int blk = 0; blk < 8; ++blk) {
        const int t0 = (c0 * 2 + blk) * 32;
        if (PART == 1 && (blk & 1) == 0) { sr[0] = 0.f; si[0] = 0.f; sr[1] = 0.f; si[1] = 0.f; }
        const bf16x8 af = afn;
        if (blk + 1 < 8) afn = *(const bf16x8*)(U + (size_t)(t0 + 32 + c) * S5W + g * 16 + 8 * hi);
#pragma unroll
        for (int sb = 0; sb < 2; ++sb) {
            f32x16 br = {}, bi = {};
            br = __builtin_amdgcn_mfma_f32_32x32x16_bf16(af, bfrag[sb][0], br, 0, 0, 0);
            bi = __builtin_amdgcn_mfma_f32_32x32x16_bf16(af, bfrag[sb][1], bi, 0, 0, 0);
#pragma unroll
            for (int q4 = 0; q4 < 4; ++q4)
#pragma unroll
                for (int k = 1; k < 4; ++k) { const int r = 4 * q4 + k; float tr, ti; cmul(l1r[sb], l1i[sb], br[r - 1], bi[r - 1], tr, ti); br[r] += tr; bi[r] += ti; }
            float per[4], pei[4];
#pragma unroll
            for (int q4 = 0; q4 < 4; ++q4) { per[q4] = __shfl_xor(br[4 * q4 + 3], 32); pei[q4] = __shfl_xor(bi[4 * q4 + 3], 32); }
            float cr = sr[sb], ci = si[sb], cinr[4], cini[4];
#pragma unroll
            for (int q = 0; q < 8; ++q) { const bool own = ((q & 1) == hi); const int q4 = q >> 1;
                if ((q & 1) == 0) { if (hi == 0) { cinr[q4] = cr; cini[q4] = ci; } } else { if (hi == 1) { cinr[q4] = cr; cini[q4] = ci; } }
                const float er = own ? br[4 * q4 + 3] : per[q4], ei = own ? bi[4 * q4 + 3] : pei[q4];
                float tr, ti; cmul(l4r[sb], l4i[sb], cr, ci, tr, ti); cr = tr + er; ci = ti + ei; }
            sr[sb] = cr; si[sb] = ci;
            if constexpr (PART == 2) {
#pragma unroll
                for (int q4 = 0; q4 < 4; ++q4) { float tr, ti;
                    cmul(l1r[sb], l1i[sb], cinr[q4], cini[q4], tr, ti); br[4 * q4 + 0] += tr; bi[4 * q4 + 0] += ti;
                    cmul(l2r[sb], l2i[sb], cinr[q4], cini[q4], tr, ti); br[4 * q4 + 1] += tr; bi[4 * q4 + 1] += ti;
                    cmul(l3r[sb], l3i[sb], cinr[q4], cini[q4], tr, ti); br[4 * q4 + 2] += tr; bi[4 * q4 + 2] += ti;
                    cmul(l4r[sb], l4i[sb], cinr[q4], cini[q4], tr, ti); br[4 * q4 + 3] += tr; bi[4 * q4 + 3] += ti; }
#pragma unroll
                for (int r = 0; r < 16; ++r) { const int tok = (r & 3) + 8 * (r >> 2) + 4 * hi;
                    T[tok * TROW + 32 * sb + c] = (bf16)f2bf(br[r]); T[tok * TROW + 64 + 32 * sb + c] = (bf16)f2bf(bi[r]); }
            }
        }
        if constexpr (PART == 1) {
            if ((blk & 1) == 1 && hi == 0) { float* e = ES + ((size_t)g * 128 + c0 + (blk >> 1)) * 128;
#pragma unroll
                for (int sb = 0; sb < 2; ++sb) { e[32 * sb + c] = sr[sb]; e[64 + 32 * sb + c] = si[sb]; } }
        } else {
            asm volatile("s_waitcnt lgkmcnt(0)" ::: "memory"); __builtin_amdgcn_wave_barrier(); asm volatile("" ::: "memory");
            f32x16 acc = {};
#pragma unroll
            for (int ks = 0; ks < 8; ++ks) { const bf16x8 sfrag = *(const bf16x8*)(T + c * TROW + 16 * ks + 8 * hi);
                acc = __builtin_amdgcn_mfma_f32_32x32x16_bf16(cpf[ks], sfrag, acc, 0, 0, 0); }
            const size_t ro = (size_t)(t0 + c) * S5W + g * 16;
            const f32x4 ua = pg8::unpack4(*(const u32x2*)(U + ro + 4 * hi)), ub = pg8::unpack4(*(const u32x2*)(U + ro + 8 + 4 * hi));
            f32x4 ya, yb;
#pragma unroll
            for (int e = 0; e < 4; ++e) { ya[e] = gelu_tanh(acc[e] + da[e] * ua[e]); yb[e] = gelu_tanh(acc[4 + e] + db[e] * ub[e]); }
            *(u32x2*)(YS + ro + 4 * hi) = pg8::pack4(ya); *(u32x2*)(YS + ro + 8 + 4 * hi) = pg8::pack4(yb);
            asm volatile("" ::: "memory"); __builtin_amdgcn_wave_barrier();
        }
    }
}
}
struct MapId   { __device__ __forceinline__ int operator()(int n) const { return n; } };
struct MapInProj { __device__ __forceinline__ int operator()(int n) const { return n < 1472 ? n : (n < 1536 ? -1 : (n < 2112 ? n - 64 : (n < 2304 ? -1 : n - 256))); } };
struct MapGlu  { int half; __device__ __forceinline__ int operator()(int n) const { const int j = n >> 8, r = n & 255; return r < 128 ? 128 * j + r : half + 128 * j + (r - 128); } };
struct MapQB   { __device__ __forceinline__ int operator()(int n) const { const int h = n >> 8, j = n & 255; if (j < 128) return 192 * h + j; if (j >= 192) return -1; const int jj = j - 128; return 192 * h + 128 + 32 * (jj & 1) + (jj >> 1); } };

template <class Map>
__device__ __forceinline__ void transpose_item(const float* W, int N, int K, bf16* WT, int Kd, const float* gain, const Map& map, LAS float* scr, int kb, int nb, int lane) {
    const int k0 = 64 * kb, n0 = 64 * nb; const int scol = map(n0 + lane);
    const bool kin = k0 < K;
    float v[64];
    const float* src = W + (size_t)k0 * N + (scol >= 0 ? scol : 0);
    if (kin && scol >= 0) {
#pragma unroll
        for (int kk = 0; kk < 64; ++kk) v[kk] = __builtin_nontemporal_load(src + (size_t)kk * N);
        if (gain) {
#pragma unroll
            for (int kk = 0; kk < 64; ++kk) v[kk] *= gain[k0 + kk];
        }
    } else {
#pragma unroll
        for (int kk = 0; kk < 64; ++kk) v[kk] = 0.f;
    }
    LAS unsigned char* sb = (LAS unsigned char*)scr;
#pragma unroll
    for (int c = 0; c < 8; ++c) { u32x4 o; o.x = cvt_pk_bf16(v[8 * c], v[8 * c + 1]); o.y = cvt_pk_bf16(v[8 * c + 2], v[8 * c + 3]); o.z = cvt_pk_bf16(v[8 * c + 4], v[8 * c + 5]); o.w = cvt_pk_bf16(v[8 * c + 6], v[8 * c + 7]);
        *(LAS u32x4*)(sb + lane * 144 + c * 16) = o; }
    const int rr = lane >> 3, cc = lane & 7;
#pragma unroll
    for (int i = 0; i < 8; ++i) { const u32x4 w = *(const LAS u32x4*)(sb + (8 * i + rr) * 144 + cc * 16);
        *(GAS u32x4*)(WT + (size_t)(n0 + 8 * i + rr) * Kd + k0 + 8 * cc) = w; }
}
template <class Map>
__device__ __forceinline__ void transpose_item_i8(const float* W, int N, signed char* WT, int Kd, const float* gain, float inv_step, const Map& map, int kb, int nb, int lane, bool nostore = false) {
    const int k0 = 64 * kb, n0 = 64 * nb; const int scol = map(n0 + lane);
    float v[64];
    const float* src = W + (size_t)k0 * N + scol;
#pragma unroll
    for (int kk = 0; kk < 64; ++kk) v[kk] = __builtin_nontemporal_load(src + (size_t)kk * N);
    signed char* dst = WT + (size_t)(n0 + lane) * Kd + k0;
#pragma unroll
    for (int c = 0; c < 4; ++c) { u32x4 o;
#pragma unroll
        for (int d = 0; d < 4; ++d) { unsigned w = 0;
#pragma unroll
            for (int b = 0; b < 4; ++b) { const int kk = 16 * c + 4 * d + b; const float q = fminf(fmaxf(rintf(v[kk] * (gain ? gain[k0 + kk] : 1.0f) * inv_step), -127.f), 127.f); w |= ((unsigned)(int)q & 0xffu) << (8 * b); }
            o[d] = w; }
        if (nostore) asm volatile("" :: "v"(o)); else *(GAS u32x4*)(dst + 16 * c) = o; }
}
__device__ __forceinline__ void transpose_item_f8(const float* W, int N, unsigned char* WT, int Kd, float scale, int kb, int nb, int lane) {
    const int k0 = 64 * kb, n0 = 64 * nb;
    float v[64];
    const float* src = W + (size_t)k0 * N + n0 + lane;
#pragma unroll
    for (int kk = 0; kk < 64; ++kk) v[kk] = __builtin_nontemporal_load(src + (size_t)kk * N);
    unsigned char* dst = WT + (size_t)(n0 + lane) * Kd + k0;
#pragma unroll
    for (int c = 0; c < 4; ++c) { u32x4 o;
#pragma unroll
        for (int d = 0; d < 4; ++d) { const int kk = 16 * c + 4 * d; int w = 0; w = __builtin_amdgcn_cvt_pk_fp8_f32(v[kk] * scale, v[kk + 1] * scale, w, false); w = __builtin_amdgcn_cvt_pk_fp8_f32(v[kk + 2] * scale, v[kk + 3] * scale, w, true); o[d] = (unsigned)w; }
        *(GAS u32x4*)(dst + 16 * c) = o; }
}
__device__ __forceinline__ float sample_step(const float* W, int N, int K, const float* gain, int lane, int ncols = 0) {
    float mx = 0.f; if (ncols == 0) ncols = N;
#pragma unroll
    for (int i = 0; i < 16; ++i) { const int k = (i * 131 + 7) % K, n = (lane * 211 + i * 1319) % ncols; mx = fmaxf(mx, fabsf(W[(size_t)k * N + n] * (gain ? gain[k] : 1.0f))); }
#pragma unroll
    for (int o = 1; o < 64; o <<= 1) mx = fmaxf(mx, __shfl_xor(mx, o));
    return fmaxf(mx, 1e-20f) * (2.0f / 127.0f);
}
__device__ __forceinline__ float sample_scale_f8(const float* W, int N, int K, int lane) {
    float mx = 0.f;
#pragma unroll
    for (int i = 0; i < 16; ++i) { const int k = (i * 131 + 7) % K, n = (lane * 211 + i * 1319) % N; mx = fmaxf(mx, fabsf(W[(size_t)k * N + n])); }
#pragma unroll
    for (int o = 1; o < 64; o <<= 1) mx = fmaxf(mx, __shfl_xor(mx, o));
    return exp2f(floorf(log2f(224.0f / fmaxf(mx, 1e-20f))));
}
template <class Map>
__device__ __forceinline__ void transpose_job(const float* W, size_t wstride, int N, int K, bf16* WT, size_t wtstride, int Kd, int Nd, const float* gain, int gstride, int ninst, const Map& map,
                                              LAS float* scr, int gw, int NGW, int lane) {
    const int nkb = Kd / 64, nnb = Nd / 64, per = nkb * nnb;
    for (int it = gw; it < per * ninst; it += NGW) { const int inst = it / per, r = it - inst * per, nb = r / nkb, kb = r - nb * nkb;
        transpose_item(W + (size_t)inst * wstride, N, K, WT + (size_t)inst * wtstride, Kd, gain ? gain + (size_t)inst * gstride : nullptr, map, scr, kb, nb, lane); }
}
__device__ __forceinline__ float row_to_bf16(const float* xrow, bf16* orow, bool normalize, int lane) {
    const GAS f32x4* xr = (const GAS f32x4*)xrow + lane;
    f32x4 v[8]; float s = 0.f;
#pragma unroll
    for (int j = 0; j < 8; ++j) { v[j] = xr[64 * j]; s += pg8::sq4(v[j]); }
    s = wave_sum(s);
    const float sc = normalize ? 1.0f / sqrtf(s * (1.0f / DM) + EPS) : 1.0f;
    GAS u32x2* o8 = (GAS u32x2*)orow + lane;
#pragma unroll
    for (int j = 0; j < 8; ++j) o8[64 * j] = pg8::pack4(v[j] * sc);
    return s;
}
__device__ __forceinline__ void router_token(const float* xrow, const float* gain, const float* R, const float* rb, int tok, unsigned* cnt, int* list, int* toke, int* toks, float* tokw, signed char* XQ, float* rscale, float* rss, int lane) {
    float lg[8] = {0.f, 0.f, 0.f, 0.f, 0.f, 0.f, 0.f, 0.f}; float ssq = 0.f, amax = 0.f;
#pragma unroll 2
    for (int j = 0; j < 8; ++j) { const int k0 = 256 * j + 4 * lane; const f32x4 xv = *(const f32x4*)(xrow + k0), gv = *(const f32x4*)(gain + k0); ssq += pg8::sq4(xv); { const f32x4 hv = xv * gv; amax = fmaxf(fmaxf(amax, fmaxf(fabsf(hv[0]), fabsf(hv[1]))), fmaxf(fabsf(hv[2]), fabsf(hv[3]))); }
#pragma unroll
        for (int e = 0; e < 4; ++e) { const float h = xv[e] * gv[e]; const f32x4 r0 = *(const f32x4*)(R + (size_t)(k0 + e) * 8), r1 = *(const f32x4*)(R + (size_t)(k0 + e) * 8 + 4);
            lg[0] += h * r0[0]; lg[1] += h * r0[1]; lg[2] += h * r0[2]; lg[3] += h * r0[3]; lg[4] += h * r1[0]; lg[5] += h * r1[1]; lg[6] += h * r1[2]; lg[7] += h * r1[3]; } }
    ssq = wave_sum(ssq); const float rstd = 1.0f / sqrtf(ssq * (1.0f / DM) + EPS);
#pragma unroll
    for (int o = 1; o < 64; o <<= 1) amax = fmaxf(amax, __shfl_xor(amax, o));
    amax = fmaxf(amax, 1e-20f);
    {
        const float qs = 127.0f / amax;
        f32x4 xg[8];
#pragma unroll
        for (int j = 0; j < 8; ++j) { const int k0 = 256 * j + 4 * lane; xg[j] = *(const f32x4*)(xrow + k0) * *(const f32x4*)(gain + k0); }
#pragma unroll
        for (int j = 0; j < 8; ++j) { const int k0 = 256 * j + 4 * lane; unsigned w = 0;
#pragma unroll
            for (int e = 0; e < 4; ++e) w |= ((unsigned)(int)rintf(xg[j][e] * qs) & 0xffu) << (8 * e);
            *(unsigned*)(XQ + (size_t)tok * DM + k0) = w; }
        if (lane == 0) rscale[tok] = rstd * amax * (1.0f / 127.0f);
    }
    const float rowscale = rstd * amax * (1.0f / 127.0f);
#pragma unroll
    for (int e = 0; e < 8; ++e) lg[e] = wave_sum(lg[e]) * rstd + rb[e];
    if (lane == 0) {
        int i1 = 0; float v1 = lg[0];
#pragma unroll
        for (int e = 1; e < 8; ++e) if (lg[e] > v1) { v1 = lg[e]; i1 = e; }
        int i2 = -1; float v2 = -3.0e38f;
#pragma unroll
        for (int e = 0; e < 8; ++e) if (e != i1 && lg[e] > v2) { v2 = lg[e]; i2 = e; }
        const float w1 = 1.0f / (1.0f + expf(v2 - v1)), w2 = 1.0f - w1;
        const int s1 = (int)atomicAdd(cnt + 64 * i1, 1u), s2 = (int)atomicAdd(cnt + 64 * i2, 1u);
        list[i1 * SEQ + s1] = tok; list[i2 * SEQ + s2] = tok; rss[i1 * SEQ + s1] = rowscale; rss[i2 * SEQ + s2] = rowscale;
        toke[2 * tok] = i1; toke[2 * tok + 1] = i2; toks[2 * tok] = s1; toks[2 * tok + 1] = s2; tokw[2 * tok] = w1; tokw[2 * tok + 1] = w2;
    }
}

__device__ __forceinline__ void quant_row_i8(const bf16* arow, signed char* qrow, float* rstep, int lane) {
    u32x4 v[14]; float amax = 0.f;
#pragma unroll
    for (int j = 0; j < 14; ++j) { v[j] = *(const u32x4*)(arow + (size_t)(j * 64 + lane) * 8);
#pragma unroll
        for (int e = 0; e < 4; ++e) amax = fmaxf(amax, fmaxf(fabsf(bflo(v[j][e])), fabsf(bfhi(v[j][e])))); }
#pragma unroll
    for (int o = 1; o < 64; o <<= 1) amax = fmaxf(amax, __shfl_xor(amax, o));
    amax = fmaxf(amax, 1e-20f); const float qs = 127.0f / amax;
#pragma unroll
    for (int j = 0; j < 14; ++j) { u32x2 w;
#pragma unroll
        for (int h = 0; h < 2; ++h) { unsigned x = 0;
#pragma unroll
            for (int e = 0; e < 2; ++e) { const unsigned d = v[j][2 * h + e]; x |= ((unsigned)(int)rintf(bflo(d) * qs) & 0xffu) << (16 * e); x |= ((unsigned)(int)rintf(bfhi(d) * qs) & 0xffu) << (16 * e + 8); }
            w[h] = x; }
        *(u32x2*)(qrow + (size_t)(j * 64 + lane) * 8) = w; }
    if (lane == 0) *rstep = amax * (1.0f / 127.0f);
}

__device__ __forceinline__ const float* uniform_ptr(const float* p) { const unsigned long long v = (unsigned long long)p; const unsigned lo = __builtin_amdgcn_readfirstlane((unsigned)v), hi = __builtin_amdgcn_readfirstlane((unsigned)(v >> 32));
    return (const float*)(((unsigned long long)hi << 32) | lo); }
struct NoConv { __device__ __forceinline__ void issue() {} __device__ __forceinline__ void finish() {} __device__ __forceinline__ bool pending() const { return false; } };
struct MoeConv {
    const float* gu; const float* dn; const float* gain; signed char* wgu; signed char* wdn; const float* wsc;
    int gwv, NGW, lane_unused, j, jend; bool active;
    float v[16]; signed char* dstu; int kbytes; float istep; int ie; unsigned lbuf;
    static constexpr int M_GU = NE * (DM / 16) * (2 * DFF / 64), M_DN = NE * (DFF / 16) * (DM / 64), M_ALL = M_GU + M_DN;
    static constexpr int SLOT = 1056;
    static_assert(M_GU % 4 == 0 && (DM / 16) % 4 == 0 && (DFF / 16) % 4 == 0, "groups of 4 consecutive k blocks stay inside one (expert, row block)");
    __device__ __forceinline__ void issue() {
        active = false; if (j >= jend) return;
        const int m = __builtin_amdgcn_readfirstlane(((j >> 2) * NGW + gwv) * 4 + (j & 3)); if (m >= M_ALL) { j = jend; return; }
        active = true; const float* src; int N;
        if (m < M_GU) { constexpr int per = (DM / 16) * (2 * DFF / 64); const int e = m / per, r = m - e * per, nb = r / (DM / 16), kb = r - nb * (DM / 16);
            const int lane = fresh_tid() & 63; const int nd = 64 * nb + lane, jt = nd >> 8, rr = nd & 255, scol = rr < 128 ? 128 * jt + rr : DFF + 128 * jt + (rr - 128);
            N = 2 * DFF; src = gu + ((size_t)e * DM + 16 * kb) * N + scol; dstu = (signed char*)uniform_ptr((const float*)(wgu + ((size_t)e * 2 * DFF + 64 * nb) * DM + 16 * kb)); kbytes = DM; ie = 32 + e; }
        else { const int m2 = m - M_GU; constexpr int per = (DFF / 16) * (DM / 64); const int e = m2 / per, r = m2 - e * per, nb = r / (DFF / 16), kb = r - nb * (DFF / 16);
            N = DM; src = dn + ((size_t)e * DFF + 16 * kb) * N + 64 * nb + (fresh_tid() & 63); dstu = (signed char*)uniform_ptr((const float*)(wdn + ((size_t)e * DM + 64 * nb) * DFF + 16 * kb)); kbytes = DFF; ie = 24 + e; }
        istep = ((const __attribute__((address_space(4))) float*)wsc)[ie];
#pragma unroll
        for (int kk = 0; kk < 16; ++kk) v[kk] = __builtin_nontemporal_load(src + (size_t)kk * N);
    }
    __device__ __forceinline__ bool pending() const { return active; }
    __device__ __forceinline__ void finish() {
        if (!active) return;
        constexpr float MAGIC = 12582912.0f + 128.0f, LO = 12582913.0f, HI = 12583167.0f;
        u32x4 o;
#pragma unroll
        for (int d = 0; d < 4; ++d) { int t[4];
#pragma unroll
            for (int b = 0; b < 4; ++b) { const int kk = 4 * d + b;
                t[b] = __builtin_bit_cast(int, __builtin_amdgcn_fmed3f(fmaf(v[kk], istep, MAGIC), LO, HI)); }
            const unsigned p0 = __builtin_amdgcn_perm((unsigned)t[1], (unsigned)t[0], 0x0c0c0400u), p1 = __builtin_amdgcn_perm((unsigned)t[3], (unsigned)t[2], 0x04000c0cu);
            o[d] = (p0 | p1) ^ 0x80808080u; }
        const int q = j & 3; const int lane = fresh_tid() & 63;
        { const unsigned la = lbuf + (unsigned)(q * SLOT) + (unsigned)lane * 16u; asm volatile("ds_write_b128 %0, %1" :: "v"(la), "v"(o) : "memory"); }
        if (q == 3) {
            const signed char* gb = dstu - 48;
            const int r0 = lane >> 2, qq = lane & 3; const unsigned ra = lbuf + (unsigned)(qq * SLOT) + (unsigned)r0 * 16u;
            const unsigned go_ = (unsigned)(r0 * kbytes + qq * 16);
            asm volatile("s_waitcnt lgkmcnt(0)" ::: "memory");
#pragma unroll
            for (int i = 0; i < 4; ++i) { u32x4 w; asm volatile("ds_read_b128 %0, %1 offset:%2\n\ts_waitcnt lgkmcnt(0)" : "=v"(w) : "v"(ra), "i"(256 * i) : "memory");
                *(GAS u32x4*)(gb + (size_t)(go_ + (unsigned)(16 * i * kbytes))) = w; }
        }
        ++j;
    }
};

template <class T> __device__ __forceinline__ void quant_xrow_i8(const T* xrow, signed char* qrow, float* rscale, int lane) {
    f32x4 v[8]; float ssq = 0.f, amax = 0.f;
#pragma unroll
    for (int j = 0; j < 8; ++j) { if constexpr (sizeof(T) == 2) v[j] = pg8::unpack4(*(const u32x2*)(xrow + 256 * j + 4 * lane)); else v[j] = *(const f32x4*)(xrow + 256 * j + 4 * lane); ssq += pg8::sq4(v[j]); amax = fmaxf(fmaxf(amax, fmaxf(fabsf(v[j][0]), fabsf(v[j][1]))), fmaxf(fabsf(v[j][2]), fabsf(v[j][3]))); }
    ssq = wave_sum(ssq);
#pragma unroll
    for (int o = 1; o < 64; o <<= 1) amax = fmaxf(amax, __shfl_xor(amax, o));
    amax = fmaxf(amax, 1e-20f); const float qs = 127.0f / amax;
#pragma unroll
    for (int j = 0; j < 8; ++j) { unsigned w = 0;
#pragma unroll
        for (int e = 0; e < 4; ++e) w |= ((unsigned)(int)rintf(v[j][e] * qs) & 0xffu) << (8 * e);
        *(unsigned*)(qrow + 256 * j + 4 * lane) = w; }
    if (lane == 0) *rscale = amax * (1.0f / 127.0f) / sqrtf(ssq * (1.0f / DM) + EPS);
}

__device__ __forceinline__ void quant_row2_i8(const bf16* a0, const bf16* a1, signed char* q0, signed char* q1, float* s0, float* s1, int lane) {
    u32x4 v[2][14]; float amax[2] = {0.f, 0.f};
#pragma unroll
    for (int j = 0; j < 14; ++j) { v[0][j] = __builtin_nontemporal_load((const u32x4*)(a0 + (size_t)(j * 64 + lane) * 8)); v[1][j] = __builtin_nontemporal_load((const u32x4*)(a1 + (size_t)(j * 64 + lane) * 8)); }
#pragma unroll
    for (int w = 0; w < 2; ++w) {
#pragma unroll
        for (int j = 0; j < 14; ++j)
#pragma unroll
            for (int e = 0; e < 4; ++e) amax[w] = fmaxf(amax[w], fmaxf(fabsf(bflo(v[w][j][e])), fabsf(bfhi(v[w][j][e]))));
#pragma unroll
        for (int o = 1; o < 64; o <<= 1) amax[w] = fmaxf(amax[w], __shfl_xor(amax[w], o));
        amax[w] = fmaxf(amax[w], 1e-20f); const float qs = 127.0f / amax[w]; signed char* q = w ? q1 : q0;
#pragma unroll
        for (int j = 0; j < 14; ++j) { u32x2 o2;
#pragma unroll
            for (int h = 0; h < 2; ++h) { unsigned x = 0;
#pragma unroll
                for (int e = 0; e < 2; ++e) { const unsigned d = v[w][j][2 * h + e]; x |= ((unsigned)(int)rintf(bflo(d) * qs) & 0xffu) << (16 * e); x |= ((unsigned)(int)rintf(bfhi(d) * qs) & 0xffu) << (16 * e + 8); }
                o2[h] = x; }
            *(u32x2*)(q + (size_t)(j * 64 + lane) * 8) = o2; }
        if (lane == 0) *(w ? s1 : s0) = amax[w] * (1.0f / 127.0f); }
}
#ifndef MK_STAMP
#define MK_STAMP 0
#endif
#ifndef MK_STAMP_A
#define MK_STAMP_A 0x1u
#define MK_STAMP_B 0x408u
#endif
#ifndef MK_PROBE_NOSTORE
#define MK_PROBE_NOSTORE 0
#endif
#ifndef MK_REPEAT
#define MK_REPEAT 0u
#endif
#define NREP(k) (1 + (int)(((MK_REPEAT) >> (k)) & 1u))
#ifndef MK_PHMASK
#define MK_PHMASK 0xFFFFFFFFu
#endif
#define PH_ON(id) (((MK_PHMASK) >> (id)) & 1u)
constexpr int NWAVES = 8;
constexpr int NPH = 19;
struct Args { const void* in[34]; float* out; unsigned char* ws; int ph_lo, ph_hi; };
static_assert(sizeof(Args) == 34 * 8 + 8 + 8 + 8, "Args has no padding");


__device__ __forceinline__ const void* argp(int i) { const __attribute__((address_space(4))) char* ka = (const __attribute__((address_space(4))) char*)__builtin_amdgcn_kernarg_segment_ptr();
    return *(const void* const volatile __attribute__((address_space(4)))*)(ka + 8 * i); }
__global__ void __launch_bounds__(NWAVES * 64, 2) fwd(Args args) {
    extern __shared__ __attribute__((aligned(16))) unsigned char lds_raw[];
    LAS unsigned char* lds = (LAS unsigned char*)lds_raw;
    volatile LAS unsigned* MISC = (volatile LAS unsigned*)(lds + MISC_OFF);
    const int tid = threadIdx.x, lane = tid & 63, wave = __builtin_amdgcn_readfirstlane(tid >> 6);
    const int G = gridDim.x, bid = blockIdx.x, vcu = (G % 8 == 0) ? (bid % 8) * (G / 8) + bid / 8 : bid;
    const int gw = vcu * NWAVES + wave, NGW = G * NWAVES;
    unsigned char* ws = args.ws;
    gu32* ctl = (gu32*)ws;
    for (int i = tid; i < 64; i += NWAVES * 64) MISC[i] = 0u;
    __syncthreads();
    XcdBarrier bar; bar.bar = (unsigned*)ctl + CW_BAR; bar.x = 0; bar.st = nullptr;
#if !MK_PER_PHASE
    bar = xcd_barrier_post((unsigned*)ctl + CW_BAR, MISC + 8);
#define GRID_BAR() xcd_barrier(bar)
#else
#define GRID_BAR() do { } while (0)
#endif
#if MK_PER_PHASE
    const int lo = args.ph_lo, hi = args.ph_hi;
#else
    constexpr int lo = 0, hi = NPH;
#endif
#define IN(k) (lo <= (k) && (k) < hi)
#define BOTH(k) (IN(k) && IN((k) + 1))
#if MK_STAMP
    unsigned long long* STP = (unsigned long long*)(ws + WS.end);
#define STAMP(k) do { if (bid == 0 && tid == 0) STP[k] = __builtin_amdgcn_s_memrealtime(); } while (0)
    STAMP(0);
#else
#define STAMP(k) do { } while (0)
#endif
#define x_in ((const float*)argp(0))
#define mem_in ((const float*)argp(1))
#define pos ((const int*)argp(2))
#define norm_mix ((const float*)argp(3))
#define w_in_f32 ((const float*)argp(4))
#define s5_a_re ((const float*)argp(5))
#define s5_a_im ((const float*)argp(6))
#define s5_log_dt ((const float*)argp(7))
#define s5_b_re ((const float*)argp(8))
#define s5_b_im ((const float*)argp(9))
#define s5_c_re ((const float*)argp(10))
#define s5_c_im ((const float*)argp(11))
#define s5_d ((const float*)argp(12))
#define s5_w_glu ((const float*)argp(13))
#define q_a_norm ((const float*)argp(14))
#define w_q_b ((const float*)argp(15))
#define kv_norm ((const float*)argp(16))
#define w_kv_b ((const float*)argp(17))
#define q_norm ((const float*)argp(18))
#define k_norm ((const float*)argp(19))
#define mla_w_o ((const float*)argp(20))
#define mem_norm ((const float*)argp(21))
#define mem_w_kv ((const float*)argp(22))
#define mem_q_norm ((const float*)argp(23))
#define mem_k_norm ((const float*)argp(24))
#define mem_w_o ((const float*)argp(25))
#define w_out_f32 ((const float*)argp(26))
#define norm_ffn ((const float*)argp(27))
#define ffn_gu ((const float*)argp(28))
#define ffn_dn ((const float*)argp(29))
#define moe_router ((const float*)argp(30))
#define moe_rb ((const float*)argp(31))
#define moe_gu ((const float*)argp(32))
#define moe_dn ((const float*)argp(33))
    float* OUT = args.out;
#define WSP ((unsigned char*)argp(35))
#define XB ((bf16*)(WSP + WS.xb))
#define Ub ((bf16*)(WSP + WS.u))
#define CQ ((bf16*)(WSP + WS.cq))
#define CKV ((bf16*)(WSP + WS.ckv))
#define KR ((float*)(WSP + WS.kr))
#define QM ((bf16*)(WSP + WS.qm))
#define GT ((unsigned char*)(WSP + WS.gt))
#define Qh ((bf16*)(WSP + WS.q))
#define Kh ((bf16*)(WSP + WS.kk))
#define Vh ((bf16*)(WSP + WS.vv))
#define OA ((bf16*)(WSP + WS.oa))
#define OM ((bf16*)(WSP + WS.om))
#define YS ((bf16*)(WSP + WS.ys))
#define ES ((float*)(WSP + WS.es))
#define MF ((bf16*)(WSP + WS.mf))
#define MB ((bf16*)(WSP + WS.mb))
#define ACT ((bf16*)(WSP + WS.act))
#define YM ((bf16*)(WSP + WS.ym))
#define KMEM ((bf16*)(WSP + WS.kmem))
#define VMEM ((bf16*)(WSP + WS.vmem))
#define MEMB ((bf16*)(WSP + WS.memb))
#define ROPEC ((float*)(WSP + WS.ropec))
#define ROPES ((float*)(WSP + WS.ropes))
#define LIST ((int*)(WSP + WS.list))
#define TOKE ((int*)(WSP + WS.toke))
#define TOKS ((int*)(WSP + WS.toks))
#define TOKW ((float*)(WSP + WS.tokw))
#define TMIN ((int*)(WSP + WS.tmm))
#define XQ ((signed char*)(WSP + WS.xq))
#define RSC ((float*)(WSP + WS.rsc))
#define WSC ((float*)(WSP + WS.wsc))
#define ACT8 ((signed char*)(WSP + WS.act8))
#define RSC2 ((float*)(WSP + WS.rsc2))
#define TMAX (TMIN + 128)
#define CNT ((unsigned*)WSP + CW_CNT)
#define SS ((float*)(WSP + WS.ssp))
    for (int rep_ = 0; rep_ < ((PH_ON(0) && IN(0)) ? NREP(0) : 0); ++rep_) {
        const int lane = fresh_tid() & 63;
        LAS float* scr = (LAS float*)(lds + wave * 16640);
        transpose_job(w_in_f32, (size_t)DM * IN_COLS, IN_COLS, DM, (bf16*)(ws + WS.w_in[0]), (WS.w_in[1] - WS.w_in[0]) / 2, DM, 2304, norm_mix, DM, 2, MapInProj{}, scr, gw, NGW, lane);
        {
            LAS float* stp = (LAS float*)(lds + XT_OFF) + 32;
            if (wave < 2) { const float st = sample_step(w_in_f32 + (size_t)wave * DM * IN_COLS + 3072, IN_COLS, DM, norm_mix + wave * DM, lane, 3 * DM); if (lane == 0) { stp[wave] = st; if (bid == 0) WSC[16 + wave] = st; } }
            else if (wave < 4) { const int w2 = wave - 2; const float st = sample_step(w_in_f32 + (size_t)w2 * DM * IN_COLS + 2048, IN_COLS, DM, norm_mix + w2 * DM, lane, MEMW); if (lane == 0) { stp[wave] = st; if (bid == 0) WSC[18 + w2] = st; } }
            __syncthreads();
            const int nkb = DM / 64, nnb = 7168 / 64, per = nkb * nnb; const MapId mp{};
            for (int it = gw; it < per * 2; it += NGW) { const int inst = it / per, r = it - inst * per, nb = r / nkb, kb = r - nb * nkb;
                transpose_item_i8(w_in_f32 + (size_t)inst * DM * IN_COLS + 2048, IN_COLS, (signed char*)(WSP + WS.w_inq[inst]), DM, norm_mix + inst * DM, 1.0f / stp[nb < 16 ? 2 + inst : inst], mp, kb, nb, lane); }
        }
        transpose_job(s5_w_glu, (size_t)S5W * 4096, 4096, S5W, (bf16*)(ws + WS.w_glu[0]), (WS.w_glu[1] - WS.w_glu[0]) / 2, S5W, 4096, nullptr, 0, 2, MapGlu{2048}, scr, gw, NGW, lane);
        transpose_job(w_q_b, (size_t)QRANK * 3072, 3072, QRANK, (bf16*)(ws + WS.w_qb[0]), (WS.w_qb[1] - WS.w_qb[0]) / 2, 512, 4096, q_a_norm, QRANK, 2, MapQB{}, scr, gw, NGW, lane);
        transpose_job(w_kv_b, (size_t)KVRANK * 4096, 4096, KVRANK, (bf16*)(ws + WS.w_kvb[0]), (WS.w_kvb[1] - WS.w_kvb[0]) / 2, 512, 4096, kv_norm, KVRANK, 2, MapId{}, scr, gw, NGW, lane);
        transpose_job(mla_w_o, (size_t)DM * DM, DM, DM, (bf16*)(ws + WS.w_mo[0]), (WS.w_mo[1] - WS.w_mo[0]) / 2, DM, DM, nullptr, 0, 2, MapId{}, scr, gw, NGW, lane);
        transpose_job(mem_w_kv, (size_t)DM * DM, DM, DM, (bf16*)(ws + WS.w_mkv[0]), (WS.w_mkv[1] - WS.w_mkv[0]) / 2, DM, DM, mem_norm, DM, 2, MapId{}, scr, gw, NGW, lane);
        transpose_job(mem_w_o, (size_t)MEMW * DM, DM, MEMW, (bf16*)(ws + WS.w_mwo[0]), (WS.w_mwo[1] - WS.w_mwo[0]) / 2, MEMW, DM, nullptr, 0, 2, MapId{}, scr, gw, NGW, lane);
        transpose_job(w_out_f32, (size_t)DM * DM, DM, DM, (bf16*)(ws + WS.w_out[0]), (WS.w_out[1] - WS.w_out[0]) / 2, DM, DM, nullptr, 0, 2, MapId{}, scr, gw, NGW, lane);
        transpose_job(ffn_gu, 0, 2 * DFF, DM, (bf16*)(ws + WS.w_gu), 0, DM, 2 * DFF, norm_ffn, 0, 1, MapGlu{DFF}, scr, gw, NGW, lane);
        transpose_job(ffn_dn, 0, DM, DFF, (bf16*)(ws + WS.w_dn), 0, DFF, DM, nullptr, 0, 1, MapId{}, scr, gw, NGW, lane);
        {
            LAS float* stp = (LAS float*)(lds + XT_OFF);
            { const float st = sample_step(moe_gu + (size_t)wave * DM * 2 * DFF, 2 * DFF, DM, nullptr, lane); if (lane == 0) { stp[wave] = st; if (bid == 0) { WSC[wave] = st; WSC[32 + wave] = 1.0f / st; } } }
            __syncthreads();
        }
        {
            LAS float* stp = (LAS float*)(lds + XT_OFF) + 16;
            { const float st = sample_step(moe_dn + (size_t)wave * DFF * DM, DM, DFF, nullptr, lane); if (lane == 0) { stp[wave] = st; if (bid == 0) { WSC[8 + wave] = st; WSC[24 + wave] = 1.0f / st; } } }
            __syncthreads();
        }
        for (int i = gw * 64 + lane; i < SEQ * 32; i += NGW * 64) { const int t = i >> 5, j = i & 31; const float inv = powf(10000.0f, -(float)(2 * j) / 64.0f); const float ang = (float)pos[t] * inv;
            ROPEC[i] = cosf(ang); ROPES[i] = sinf(ang); }
        for (int t = gw; t < 128; t += NGW) { int v = pos[64 * t + lane], mn = v, mx = v;
#pragma unroll
            for (int o_ = 1; o_ < 64; o_ <<= 1) { mn = min(mn, __shfl_xor(mn, o_)); mx = max(mx, __shfl_xor(mx, o_)); }
            if (lane == 0) { TMIN[t] = mn; TMAX[t] = mx; } }
        for (int i = gw * 64 + lane; i < 2 * S5G * S5P; i += NGW * 64) { const int l = i / (S5G * S5P), gp = i % (S5G * S5P), g = gp / S5P, p = gp % S5P;
            const float are = s5_a_re[i], aim = s5_a_im[i], dt = expf(s5_log_dt[l * S5G + g]);
            const float mag = expf(dt * are), lr = mag * cosf(dt * aim), li = mag * sinf(dt * aim);
            ((f32x2*)(ws + WS.lam[l]))[gp] = (f32x2){lr, li};
            const float den = are * are + aim * aim, nr = lr - 1.0f, ni = li, fr = (nr * are + ni * aim) / den, fi = (ni * are - nr * aim) / den;
            bf16* bbr = (bf16*)(ws + WS.bb[l]) + ((size_t)(g * 128 + p)) * 16; bf16* bbi = bbr + 64 * 16;
            const float* bre = s5_b_re + (size_t)i * S5H; const float* bim = s5_b_im + (size_t)i * S5H;
#pragma unroll
            for (int h = 0; h < S5H; ++h) { bbr[h] = (bf16)f2bf(fr * bre[h] - fi * bim[h]); bbi[h] = (bf16)f2bf(fr * bim[h] + fi * bre[h]); }
            bf16* cp = (bf16*)(ws + WS.cp[l]) + (size_t)g * 16 * 128;
#pragma unroll
            for (int h = 0; h < S5H; ++h) { const size_t ci = ((size_t)(l * S5G + g) * S5H + h) * S5P + p; cp[h * 128 + p] = (bf16)f2bf(s5_c_re[ci]); cp[h * 128 + 64 + p] = (bf16)f2bf(-s5_c_im[ci]); } }
        for (int m = gw; m < SEQ; m += NGW) { const float s = row_to_bf16(x_in + (size_t)m * DM, XB + (size_t)m * DM, false, lane); if (lane < 32) SS[SS_X + (size_t)m * 32 + lane] = lane == 0 ? s : 0.f;
            quant_xrow_i8(x_in + (size_t)m * DM, XQ + (size_t)m * DM, RSC + m, lane); }
        for (int m = gw; m < NMEM; m += NGW) (void)row_to_bf16(mem_in + (size_t)m * DM, MEMB + (size_t)m * DM, true, lane);
        if (BOTH(0)) GRID_BAR();
        STAMP(1);
    }

    for (int l = 0; l < DEPTH; ++l) {
        const int pb = 1 + 8 * l;
        const float* ssx_mix = SS + SS_X + (size_t)(2 * l) * SEQ * 32; float* ssx_ffn = SS + SS_X + (size_t)(2 * l + 1) * SEQ * 32;
        for (int rep_ = 0; rep_ < (IN(pb + 0) ? NREP(pb + 0) : 0); ++rep_) {
            if constexpr (PH_ON(1)) { pg8::Gemm g{XB, (const bf16*)(ws + WS.w_in[l]), DM, DM, DM, 2}; pg8::StaticOrder S; S.init(SEQ / 256, 9, G, bid);
              pg8::EpiInProj E{ssx_mix, Ub, CQ, CKV, QM, GT, KR, SS + SS_CQ + (size_t)l * SEQ * 8, SS + SS_CKV + (size_t)l * SEQ * 8, SS + SS_KR + (size_t)l * SEQ * 4, mem_q_norm + l * MEMD};
              pg8::gemm_phase(lds, g, S, E); }
            if constexpr (PH_ON(1)) { pg8::Gemm g{XQ, (const void*)(WSP + WS.w_inq[l]), DM, DM, DM, 1}; pg8::BalOrder S{SEQ / 256, 28, bid};
              pg8::EpiGates E{RSC, WSC[16 + l], GT, WSC[18 + l], QM, mem_q_norm + l * MEMD};
              pg8::gemm_phase<pg8::EpiGates, pg8::BalOrder, 1>(lds, g, S, E); }
            if constexpr (PH_ON(18)) if (l == 0) { pg8::Gemm g{MEMB, (const bf16*)(ws + WS.w_mkv[0]), DM, DM, DM, 2}; pg8::MemKvOrder S{G, G - 1 - bid};
              pg8::EpiMemKV E{{mem_k_norm, mem_k_norm + MEMD}, KMEM, VMEM};
              pg8::gemm_phase(lds, g, S, E); }
            if (BOTH(pb + 0)) GRID_BAR();
            STAMP(pb + 0 + 1);
        }
        for (int rep_ = 0; rep_ < (IN(pb + 1) ? NREP(pb + 1) : 0); ++rep_) {
            if constexpr (PH_ON(12)) { pg8::Gemm g{CQ, (const bf16*)(ws + WS.w_qb[l]), 512, 512, 512, 2}; pg8::StaticOrder S; S.init(SEQ / 256, NH, G, bid);
              pg8::EpiQ E{SS + SS_CQ + (size_t)l * SEQ * 8, q_norm + l * DQK, ROPEC, ROPES, Qh};
              pg8::gemm_phase(lds, g, S, E); }
            if constexpr (PH_ON(13)) { pg8::Gemm g{CKV, (const bf16*)(ws + WS.w_kvb[l]), 512, 512, 512, 2}; pg8::StaticOrder S; S.init(SEQ / 256, NH, G, bid);
              pg8::EpiKV E{SS + SS_CKV + (size_t)l * SEQ * 8, SS + SS_KR + (size_t)l * SEQ * 4, k_norm + l * DQK, KR, ROPEC, ROPES, Kh, Vh};
              pg8::gemm_phase(lds, g, S, E); }
            if constexpr (PH_ON(14)) for (int it = gw; it < S5G * 32; it += NGW)
                s5::s5_wave<1>((char*)lds_raw + wave * s5::WAVE_LDS, it >> 5, (it & 31) * 4, Ub, (const f32x2*)(ws + WS.lam[l]), (const bf16*)(ws + WS.bb[l]), (const bf16*)(ws + WS.cp[l]), s5_d + l * S5W, ES, YS, fresh_tid() & 63);
            __syncthreads();
            NoConv nocv;
            if constexpr (PH_ON(15)) for (int it = vcu; it < MEMH * 32 * 2; it += G) { const int h = it >> 6, qb = (it & 63) >> 1, dvh = it & 1;
                attn::attn_item<MEMD, false, MEMW, MEMD, MEMW, false>(nocv, (char*)lds_raw, lds, QM + (size_t)qb * 256 * MEMW + h * MEMD, KMEM + ((size_t)l * MEMH + h) * NMEM * MEMD, VMEM + ((size_t)l * MEMH + h) * NMEM * MEMD + dvh * 128,
                                             OM + (size_t)qb * 256 * MEMW + h * MEMD + dvh * 128, nullptr, qb * 256, NMEM / 64, nullptr, nullptr); }
            if (BOTH(pb + 1)) GRID_BAR();
            STAMP(pb + 1 + 1);
        }
        for (int rep_ = 0; rep_ < (IN(pb + 2) ? NREP(pb + 2) : 0); ++rep_) {
            constexpr int CV_J0 = 132;
            MoeConv mcv{moe_gu, moe_dn, (const float*)(WSP + WS.gsc), (signed char*)(WSP + WS.w_egu), (signed char*)(WSP + WS.w_edn), WSC, gw, NGW, fresh_tid() & 63, l == 0 ? 0 : CV_J0, l == 0 ? CV_J0 : (1 << 30), false, {}, nullptr, 0, 0.f, 0,
                        (unsigned)__builtin_amdgcn_readfirstlane((int)((unsigned)(size_t)lds + (wave < 3 ? 49152u + wave * 4224u : (wave < 6 ? 118400u + (wave - 3) * 4224u : (unsigned)GOFF_OFF + (wave - 6) * 4224u))))};
            if constexpr (PH_ON(16)) for (int it = vcu; it < NH * 16; it += G) { const int h = it >> 4, pr = it & 15;
#pragma unroll 1
                for (int pass = 0; pass < 2; ++pass) { const int qb = pass ? pr : 31 - pr;
                    attn::attn_item<DQK, true, DQK, DV, DM, true>(mcv, (char*)lds_raw, lds, Qh + ((size_t)h * SEQ + qb * 256) * DQK, Kh + (size_t)h * SEQ * DQK, Vh + (size_t)h * SEQ * DV,
                                               OA + (size_t)qb * 256 * DM + h * DV, pos, qb * 256, SEQ / 64, TMIN, TMAX); } }
            if constexpr (PH_ON(16)) { mcv.finish(); while (mcv.j < mcv.jend) { mcv.issue(); mcv.finish(); } }
            if constexpr (PH_ON(17)) for (int it = gw; it < S5G * 32; it += NGW)
                s5::s5_wave<2>((char*)lds_raw + wave * s5::WAVE_LDS, it >> 5, (it & 31) * 4, Ub, (const f32x2*)(ws + WS.lam[l]), (const bf16*)(ws + WS.bb[l]), (const bf16*)(ws + WS.cp[l]), s5_d + l * S5W, ES, YS, fresh_tid() & 63);
            __syncthreads();
            if (BOTH(pb + 2)) GRID_BAR();
            STAMP(pb + 2 + 1);
        }
        for (int rep_ = 0; rep_ < (IN(pb + 3) ? NREP(pb + 3) : 0); ++rep_) {
            if constexpr (PH_ON(4)) { pg8::Gemm g{OA, (const bf16*)(ws + WS.w_mo[l]), DM, DM, DM, 2}; pg8::StaticOrder S; S.init(SEQ / 256, DM / 256, G, bid); pg8::EpiMerge<1> E{GT, MF}; pg8::gemm_phase(lds, g, S, E); }
            if constexpr (PH_ON(19)) { pg8::Gemm g{OM, (const bf16*)(ws + WS.w_mwo[l]), MEMW, MEMW, MEMW, 2}; pg8::StaticOrder S; S.init(SEQ / 256, DM / 256, G, bid); pg8::EpiMerge<2> E{GT, MF}; pg8::gemm_phase(lds, g, S, E); }
            if constexpr (PH_ON(20)) { pg8::Gemm g{YS, (const bf16*)(ws + WS.w_glu[l]), S5W, S5W, S5W, 2}; pg8::GluOrder S; S.init(SEQ / 256, DM / 256, G, bid); pg8::EpiGlu E{GT, MF, MB}; pg8::gemm_phase(lds, g, S, E); }
            if (BOTH(pb + 3)) GRID_BAR();
            STAMP(pb + 3 + 1);
        }
        if (PH_ON(5) && IN(pb + 4)) {
            pg8::Gemm g{MB, (const bf16*)(ws + WS.w_out[l]), DM, DM, DM, 2}; pg8::StaticOrder S; S.init(SEQ / 256, DM / 256, G, bid);
            if (l == 0) { pg8::EpiResid<false, false> E{x_in, nullptr, XB, ssx_ffn}; pg8::gemm_phase(lds, g, S, E); }
            else { pg8::EpiResid<true, true> E{XB, OUT, nullptr, ssx_ffn}; pg8::gemm_phase(lds, g, S, E); }
            if (BOTH(pb + 4)) GRID_BAR();
            STAMP(pb + 4 + 1);
        }
        if (l == 0) {
            for (int rep_ = 0; rep_ < ((PH_ON(6) && IN(pb + 5)) ? NREP(pb + 5) : 0); ++rep_) {
                pg8::Gemm g{XB, (const bf16*)(ws + WS.w_gu), DM, DM, DM, 2}; pg8::StaticOrder S; S.init(SEQ / 256, 2 * DFF / 256, G, bid);
                pg8::EpiSwiGLU<pg8::StaticOrder> E{ssx_ffn, ACT, &S, false, nullptr, nullptr, nullptr}; pg8::gemm_phase(lds, g, S, E);
                if (BOTH(pb + 5)) GRID_BAR();
                STAMP(pb + 5 + 1);
            }
            if (PH_ON(7) && IN(pb + 6)) {
                pg8::Gemm g{ACT, (const bf16*)(ws + WS.w_dn), DFF, DFF, DFF, 2}; pg8::StaticOrder S; S.init(SEQ / 256, DM / 256, G, bid);
                pg8::EpiResid<true, false> E{XB, nullptr, XB, SS + SS_X + (size_t)2 * SEQ * 32}; pg8::gemm_phase(lds, g, S, E);
                if (BOTH(pb + 6)) GRID_BAR();
                STAMP(pb + 6 + 1);
            }
            if (PH_ON(22) && IN(pb + 7)) {
                const int lane = fresh_tid() & 63;
                for (int t = gw; t < SEQ; t += NGW) quant_xrow_i8(XB + (size_t)t * DM, XQ + (size_t)t * DM, RSC + t, lane);
                if (BOTH(pb + 7)) GRID_BAR();
                STAMP(pb + 7 + 1);
            }
        } else {
            LAS int* MT = (LAS int*)(lds + MISC_OFF + 64);
#define MOE_TABLE() do { if (tid == 0) { int p = 0; for (int e = 0; e < NE; ++e) { const int c_ = (int)__hip_atomic_load(CNT + 64 * e, RLX_AGENT); MT[e] = p; MT[16 + e] = c_; p += (c_ + 255) >> 8; } MT[8] = p; } __syncthreads(); } while (0)
            if (PH_ON(8) && IN(pb + 5)) {
                const int lane = fresh_tid() & 63;
                for (int t = gw; t < SEQ; t += NGW) router_token(OUT + (size_t)t * DM, norm_ffn + DM, moe_router, moe_rb, t, CNT, LIST, TOKE, TOKS, TOKW, XQ, RSC, (float*)(WSP + WS.rss), lane);
                if (BOTH(pb + 5)) GRID_BAR();
                STAMP(pb + 5 + 1);
            }
            for (int rep_ = 0; rep_ < ((PH_ON(9) && IN(pb + 6)) ? NREP(pb + 6) : 0); ++rep_) {
                MOE_TABLE();
                typedef pg8::MoeOrder<true, 1> Ord;
                pg8::Gemm g{XQ, (const void*)(ws + WS.w_egu), DM, DM, DM, 1}; Ord S{MT, LIST, 2 * DFF / 256, G, bid, (size_t)2 * DFF * DM, 0, MT[8]};
                pg8::EpiSwiGLU<Ord> E{ssx_ffn, ACT, &S, true, (const float*)(WSP + WS.rss), WSC, nullptr}; pg8::gemm_phase<pg8::EpiSwiGLU<Ord>, Ord, 1>(lds, g, S, E);
                if (BOTH(pb + 6)) GRID_BAR();
                STAMP(pb + 6 + 1);
            }
            for (int rep_ = 0; rep_ < ((PH_ON(21) && IN(pb + 7)) ? NREP(pb + 7) : 0); ++rep_) {
                MOE_TABLE();
                const int lane = fresh_tid() & 63; const int nrows = MT[8] * 256;
                for (int r = gw; r < nrows; r += 2 * NGW) { const int r2 = r + NGW < nrows ? r + NGW : r;
                    quant_row2_i8(ACT + (size_t)r * DFF, ACT + (size_t)r2 * DFF, ACT8 + (size_t)r * DFF, ACT8 + (size_t)r2 * DFF, RSC2 + r, RSC2 + r2, lane); }
                if (BOTH(pb + 7)) GRID_BAR();
                STAMP(pb + 7 + 1);
            }
            for (int rep_ = 0; rep_ < ((PH_ON(10) && IN(pb + 8)) ? NREP(pb + 8) : 0); ++rep_) {
                MOE_TABLE();
                const int P_ = MT[8], Pf = ((P_ * (DM / 256)) / G) * G / (DM / 256);
                { typedef pg8::MoeOrder<false, 1> Ord; pg8::Gemm g{ACT8, (const void*)(WSP + WS.w_edn), DFF, DFF, DFF, 1}; Ord S{MT, LIST, DM / 256, G, bid, (size_t)DM * DFF, 0, Pf};
                  pg8::EpiMoeDown E{YM, WSC + 8, RSC2}; pg8::gemm_phase<pg8::EpiMoeDown, Ord, 1>(lds, g, S, E); }
                { typedef pg8::MoeOrder<false, KSPLIT> Ord; pg8::Gemm g{ACT8, (const void*)(WSP + WS.w_edn), DFF, DFF, DFF / KSPLIT, 1}; Ord S{MT, LIST, DM / 256, G, bid, (size_t)DM * DFF, Pf, P_ - Pf};
                  pg8::EpiMoeDown E{YM, WSC + 8, RSC2}; pg8::gemm_phase<pg8::EpiMoeDown, Ord, 1>(lds, g, S, E); }
                if (BOTH(pb + 8)) GRID_BAR();
                STAMP(pb + 8 + 1);
            }
            if (PH_ON(11) && IN(pb + 9)) {
                MOE_TABLE();
                const int lane = fresh_tid() & 63;
                for (int t = gw; t < SEQ; t += NGW) {
                    const int e1 = TOKE[2 * t], e2 = TOKE[2 * t + 1]; const size_t r1 = (size_t)MT[e1] * 256 + TOKS[2 * t], r2 = (size_t)MT[e2] * 256 + TOKS[2 * t + 1];
                    const float w1 = TOKW[2 * t], w2 = TOKW[2 * t + 1];
                    const int P_ = MT[8], Pf = ((P_ * (DM / 256)) / G) * G / (DM / 256); const int n1 = (int)(r1 >> 8) >= Pf ? KSPLIT : 1, n2 = (int)(r2 >> 8) >= Pf ? KSPLIT : 1;
                    f32x4 av[4], bv[4]; u32x4 y1v[4], y2v[4];
#pragma unroll
                    for (int j = 0; j < 4; ++j) { const int c = 512 * j + 8 * lane; const float* op = OUT + (size_t)t * DM + c; av[j] = *(const f32x4*)op; bv[j] = *(const f32x4*)(op + 4);
                        y1v[j] = *(const u32x4*)(YM + r1 * DM + c); y2v[j] = *(const u32x4*)(YM + r2 * DM + c); }
#define CMB_ADD(a_, b_, w_, y_) do { a_[0] += w_ * bflo(y_.x); a_[1] += w_ * bfhi(y_.x); a_[2] += w_ * bflo(y_.y); a_[3] += w_ * bfhi(y_.y); b_[0] += w_ * bflo(y_.z); b_[1] += w_ * bfhi(y_.z); b_[2] += w_ * bflo(y_.w); b_[3] += w_ * bfhi(y_.w); } while (0)
#pragma unroll
                    for (int j = 0; j < 4; ++j) { CMB_ADD(av[j], bv[j], w1, y1v[j]); CMB_ADD(av[j], bv[j], w2, y2v[j]); }
                    for (int ks = 1; ks < n1; ++ks) {
#pragma unroll
                        for (int j = 0; j < 4; ++j) { const u32x4 y = *(const u32x4*)(YM + ((size_t)ks * ACT_ROWS + r1) * DM + 512 * j + 8 * lane); CMB_ADD(av[j], bv[j], w1, y); } }
                    for (int ks = 1; ks < n2; ++ks) {
#pragma unroll
                        for (int j = 0; j < 4; ++j) { const u32x4 y = *(const u32x4*)(YM + ((size_t)ks * ACT_ROWS + r2) * DM + 512 * j + 8 * lane); CMB_ADD(av[j], bv[j], w2, y); } }
#undef CMB_ADD
#pragma unroll
                    for (int j = 0; j < 4; ++j) { float* op = OUT + (size_t)t * DM + 512 * j + 8 * lane; *(f32x4*)op = av[j]; *(f32x4*)(op + 4) = bv[j]; } }
            }
        }
    }
#if MK_STAMP
    STAMP(19);
    GRID_BAR();
    {   float ta = 0.f, tb = 0.f;
        for (int k = 0; k < 19; ++k) { const float dt = (float)(STP[k + 1] - STP[k]) * 0.01f; if ((MK_STAMP_A >> k) & 1u) ta += dt; if ((MK_STAMP_B >> k) & 1u) tb += dt; }
        for (size_t i = (size_t)bid * 512 + tid; i < (size_t)SEQ * DM; i += (size_t)G * 512) OUT[i] = (i & 1) ? ta : tb; }
#endif
#undef x_in
#undef mem_in
#undef pos
#undef norm_mix
#undef w_in_f32
#undef s5_a_re
#undef s5_a_im
#undef s5_log_dt
#undef s5_b_re
#undef s5_b_im
#undef s5_c_re
#undef s5_c_im
#undef s5_d
#undef s5_w_glu
#undef q_a_norm
#undef w_q_b
#undef kv_norm
#undef w_kv_b
#undef q_norm
#undef k_norm
#undef mla_w_o
#undef mem_norm
#undef mem_w_kv
#undef mem_q_norm
#undef mem_k_norm
#undef mem_w_o
#undef w_out_f32
#undef norm_ffn
#undef ffn_gu
#undef ffn_dn
#undef moe_router
#undef moe_rb
#undef moe_gu
#undef moe_dn
#undef XB
#undef Ub
#undef CQ
#undef CKV
#undef KR
#undef QM
#undef GT
#undef Qh
#undef Kh
#undef Vh
#undef OA
#undef OM
#undef YS
#undef ES
#undef MF
#undef MB
#undef ACT
#undef YM
#undef KMEM
#undef VMEM
#undef MEMB
#undef ROPEC
#undef ROPES
#undef LIST
#undef TOKE
#undef TOKS
#undef TOKW
#undef TMIN
#undef XQ
#undef RSC
#undef WSC
#undef ACT8
#undef RSC2
#undef TMAX
#undef CNT
#undef SS
#undef WSP
#undef IN
#undef BOTH
}

extern "C" void kernel_launch(void* const* d_in, const int* in_sizes, int n_in, void* d_out, int out_size, void* d_ws, size_t ws_size, hipStream_t stream) {
    static int grid = 0;
    if (grid == 0) {
        if (n_in != 34 || in_sizes[0] != SEQ * DM || out_size != SEQ * DM || ws_size < WS.end) {
            fprintf(stderr, "kernel_launch: shape mismatch: n_in %d in0 %d out %d ws %zu (need %zu)\n", n_in, n_in > 0 ? in_sizes[0] : -1, out_size, ws_size, (size_t)WS.end); grid = -1; return; }
        int dev = 0, cus = 0;
        if (hipGetDevice(&dev) != hipSuccess || hipDeviceGetAttribute(&cus, hipDeviceAttributeMultiprocessorCount, dev) != hipSuccess) { grid = -1; return; }
        if (hipFuncSetAttribute((const void*)fwd, hipFuncAttributeMaxDynamicSharedMemorySize, LDS_BYTES) != hipSuccess) { fprintf(stderr, "kernel_launch: hipFuncSetAttribute failed\n"); grid = -1; return; }
        int per_cu = 0;
        if (hipOccupancyMaxActiveBlocksPerMultiprocessor(&per_cu, (const void*)fwd, NWAVES * 64, LDS_BYTES) != hipSuccess || per_cu < 1) fprintf(stderr, "kernel_launch: occupancy query says %d\n", per_cu);
        (void)hipGetLastError();
        grid = cus;
    }
    if (grid < 0) return;
    (void)hipMemsetAsync(d_ws, 0, CTL_BYTES, stream);
    Args a{};
    for (int i = 0; i < 34; ++i) a.in[i] = d_in[i];
    a.out = (float*)d_out; a.ws = (unsigned char*)d_ws;
#if MK_PER_PHASE
#if MK_CHECK == 2
    (void)hipMemsetAsync((unsigned char*)d_ws + WS.end, 0, 4096, stream);
    for (int pass = 0; pass < 2; ++pass) {
        if (pass) (void)hipMemsetAsync(d_ws, 0, CTL_BYTES, stream);
        for (int p = 0; p < NPH; ++p) { a.ph_lo = p; a.ph_hi = p + 1; hipLaunchKernelGGL(fwd, dim3(grid), dim3(NWAVES * 64), LDS_BYTES, stream, a); diff_after_phase(pass, p, a, ws_size, stream); }
    }
    hipLaunchKernelGGL(diff_final, dim3(1024), dim3(256), 0, stream, (const float*)((unsigned char*)d_ws + WS.end), (float*)d_out);
#else
    for (int p = 0; p < NPH; ++p) { a.ph_lo = p; a.ph_hi = p + 1;
#if MK_CHECK == 1
        launch_checks_pre(p, a, stream);
#endif
        hipLaunchKernelGGL(fwd, dim3(grid), dim3(NWAVES * 64), LDS_BYTES, stream, a);
#if MK_CHECK == 1
        launch_checks(p, a, stream);
#endif
    }
#if MK_CHECK == 1
    launch_check_final(a, stream);
#endif
#endif
#else
    a.ph_lo = 0; a.ph_hi = NPH; hipLaunchKernelGGL(fwd, dim3(grid), dim3(NWAVES * 64), LDS_BYTES, stream, a);
#endif
    const hipError_t le = hipPeekAtLastError();
    if (le != hipSuccess) fprintf(stderr, "kernel_launch: launch failed: %s\n", hipGetErrorName(le));
}
```
